# Optimizing an MI355X kernel written in HIP

```python
import math
import jax, jax.numpy as jnp
from jax import lax
import numpy as np

D_MODEL = 1024
BATCH = 32
SEQ = 2048
DEPTH = 2

D_MIX = D_MODEL
CONV_CH = D_MIX // 4
CONV_WIDTH = 31
MLA_HEADS = 6
MLA_NOPE = 64
MLA_ROPE = 32
MLA_V = 64
MLA_Q_RANK = 256
MLA_KV_RANK = 128
DIFF_HEADS = 6
DIFF_HD = 32
DIFF_V = 2 * DIFF_HD
IN_COLS = 2 * CONV_CH + MLA_Q_RANK + MLA_KV_RANK + MLA_ROPE + 3 * DIFF_HEADS * DIFF_V
D_FF = 2816
N_EXPERTS = 8
TOP_K = 2
N_DENSE = (DEPTH + 1) // 2
N_MOE = DEPTH // 2
Q_BLOCK = 128
ROPE_THETA = 10000.0
RMS_EPS = 1e-6
LN_EPS = 1e-5

kernel_name = 'hybrid_conv_mla_diffattn_moe'


def rms_norm(x, g, eps=RMS_EPS):
    xf = x.astype(jnp.float32)
    y = xf * lax.rsqrt(jnp.mean(xf * xf, axis=-1, keepdims=True) + eps)
    return (y * g.astype(jnp.float32)).astype(x.dtype)


def layer_norm(x, g, b, eps=LN_EPS):
    xf = x.astype(jnp.float32)
    mu = jnp.mean(xf, axis=-1, keepdims=True)
    var = jnp.mean(jnp.square(xf - mu), axis=-1, keepdims=True)
    y = (xf - mu) * lax.rsqrt(var + eps)
    return (y * g.astype(jnp.float32) + b.astype(jnp.float32)).astype(x.dtype)


def apply_rope(x, pos):
    half = x.shape[-1] // 2
    freq = ROPE_THETA ** (-jnp.arange(half, dtype=jnp.float32) / half)
    ang = pos.astype(jnp.float32)[:, None] * freq[None, :]
    cos = jnp.cos(ang).astype(x.dtype)
    sin = jnp.sin(ang).astype(x.dtype)
    x1, x2 = x[..., :half], x[..., half:]
    return jnp.concatenate([x1 * cos - x2 * sin, x1 * sin + x2 * cos], axis=-1)


def alibi_slopes(n_heads):
    return 2.0 ** (-8.0 * jnp.arange(1, n_heads + 1, dtype=jnp.float32) / n_heads)


def causal_block_scores(q_blk, k_ctx, q_start, scale, slopes=None):
    s = jnp.einsum('bhqd,bhkd->bhqk', q_blk, k_ctx).astype(jnp.float32) * scale
    q_pos = q_start + jnp.arange(q_blk.shape[2])
    k_pos = jnp.arange(k_ctx.shape[2])
    dist = q_pos[:, None] - k_pos[None, :]
    if slopes is not None:
        s = s - slopes[:, None, None] * dist.astype(jnp.float32)[None]
    return jnp.where(dist >= 0, s, -jnp.inf)


def mla_attention(q, k, v):
    S = q.shape[2]
    scale = (MLA_NOPE + MLA_ROPE) ** -0.5
    outs = []
    for i in range(S // Q_BLOCK):
        start, end = i * Q_BLOCK, (i + 1) * Q_BLOCK
        p = jax.nn.softmax(causal_block_scores(q[:, :, start:end], k[:, :, :end], start, scale), axis=-1)
        outs.append(jnp.einsum('bhqk,bhkd->bhqd', p.astype(v.dtype), v[:, :, :end]))
    return jnp.concatenate(outs, axis=2)


def diff_attention(q1, q2, k1, k2, v, lam):
    S = q1.shape[2]
    scale = DIFF_HD ** -0.5
    slopes = alibi_slopes(DIFF_HEADS)
    outs = []
    for i in range(S // Q_BLOCK):
        start, end = i * Q_BLOCK, (i + 1) * Q_BLOCK
        p1 = jax.nn.softmax(causal_block_scores(q1[:, :, start:end], k1[:, :, :end], start, scale, slopes), axis=-1)
        p2 = jax.nn.softmax(causal_block_scores(q2[:, :, start:end], k2[:, :, :end], start, scale, slopes), axis=-1)
        a = p1 - lam * p2
        outs.append(jnp.einsum('bhqk,bhkd->bhqd', a.astype(v.dtype), v[:, :, :end]))
    return jnp.concatenate(outs, axis=2)


def conv_module(a, b_glu, w_dw, b_dw, ln_g, ln_b, w_pw, b_pw):
    a = a + b_glu
    u = a[..., :CONV_CH] * jax.nn.sigmoid(a[..., CONV_CH:])
    c = lax.conv_general_dilated(
        u, w_dw[:, None, :].astype(u.dtype), window_strides=(1,),
        padding=[(CONV_WIDTH - 1, 0)], dimension_numbers=('NWC', 'WIO', 'NWC'),
        feature_group_count=CONV_CH) + b_dw
    c = jax.nn.silu(layer_norm(c, ln_g, ln_b))
    return c @ w_pw + b_pw


def swiglu(h, w_gate, w_up, w_down):
    return (jax.nn.silu(h @ w_gate) * (h @ w_up)) @ w_down


def moe_ffn(h, w_router, w_gate, w_up, w_down):
    B, S, D = h.shape
    hf = h.reshape(B * S, D)
    logits = (hf @ w_router).astype(jnp.float32)
    top_vals, top_idx = lax.top_k(logits, TOP_K)
    top_w = jax.nn.softmax(top_vals, axis=-1)
    gates = jnp.einsum('nk,nke->ne', top_w, jax.nn.one_hot(top_idx, N_EXPERTS, dtype=jnp.float32))
    out = jnp.zeros_like(hf)
    for e in range(N_EXPERTS):
        out = out + gates[:, e:e + 1].astype(hf.dtype) * swiglu(hf, w_gate[e], w_up[e], w_down[e])
    return out.reshape(B, S, D)


def hybrid_mixer(h, layer_idx, w_in, b_glu, w_dw, b_dw, conv_ln_g, conv_ln_b, w_pw, b_pw,
                 q_norm, w_uq, kv_norm, w_ukv, lambda_q1, lambda_k1, lambda_q2, lambda_k2,
                 diff_subln, w_out):
    B, S, _ = h.shape
    pos = jnp.arange(S)
    proj = h @ w_in
    cuts = [int(c) for c in np.cumsum([2 * CONV_CH, MLA_Q_RANK, MLA_KV_RANK, MLA_ROPE,
                                        DIFF_HEADS * DIFF_V, DIFF_HEADS * DIFF_V])]
    conv_in, c_q, c_kv, k_r, d_q, d_k, d_v = jnp.split(proj, cuts, axis=-1)

    y_conv = conv_module(conv_in, b_glu, w_dw, b_dw, conv_ln_g, conv_ln_b, w_pw, b_pw)

    q = (rms_norm(c_q, q_norm) @ w_uq).reshape(B, S, MLA_HEADS, MLA_NOPE + MLA_ROPE).transpose(0, 2, 1, 3)
    q = jnp.concatenate([q[..., :MLA_NOPE], apply_rope(q[..., MLA_NOPE:], pos)], axis=-1)
    kv = (rms_norm(c_kv, kv_norm) @ w_ukv).reshape(B, S, MLA_HEADS, MLA_NOPE + MLA_V).transpose(0, 2, 1, 3)
    k_rope = apply_rope(k_r[:, None], pos)
    k = jnp.concatenate([kv[..., :MLA_NOPE], jnp.broadcast_to(k_rope, (B, MLA_HEADS, S, MLA_ROPE))], axis=-1)
    v = kv[..., MLA_NOPE:]
    y_mla = mla_attention(q, k, v).transpose(0, 2, 1, 3).reshape(B, S, MLA_HEADS * MLA_V)

    def heads(t):
        return t.reshape(B, S, DIFF_HEADS, DIFF_V).transpose(0, 2, 1, 3)
    dq, dk, dv = heads(d_q), heads(d_k), heads(d_v)
    lam_init = 0.8 - 0.6 * math.exp(-0.3 * layer_idx)
    lam = (jnp.exp(jnp.sum(lambda_q1.astype(jnp.float32) * lambda_k1.astype(jnp.float32)))
           - jnp.exp(jnp.sum(lambda_q2.astype(jnp.float32) * lambda_k2.astype(jnp.float32)))
           + lam_init)
    o = diff_attention(dq[..., :DIFF_HD], dq[..., DIFF_HD:], dk[..., :DIFF_HD], dk[..., DIFF_HD:], dv, lam)
    o = rms_norm(o, diff_subln, LN_EPS) * (1.0 - lam_init)
    y_diff = o.transpose(0, 2, 1, 3).reshape(B, S, DIFF_HEADS * DIFF_V)

    return jnp.concatenate([y_conv, y_mla, y_diff], axis=-1) @ w_out


def setup_inputs(seed: int = 0) -> dict:
    key = jax.random.key(seed)
    ks = list(jax.random.split(key, 32))

    def nrm(shape, scale):
        return scale * jax.random.normal(ks.pop(), shape, jnp.float32)

    def gain(shape):
        return 1.0 + nrm(shape, 0.02)

    D, C, L = D_MODEL, CONV_CH, DEPTH
    return {
        'x': nrm((BATCH, SEQ, D), 1.0),
        'attn_norm': gain((L, D)),
        'w_in': nrm((L, D, IN_COLS), D ** -0.5),
        'b_glu': nrm((L, 2 * C), 0.02),
        'w_dw': nrm((L, CONV_WIDTH, C), CONV_WIDTH ** -0.5),
        'b_dw': nrm((L, C), 0.02),
        'conv_ln_g': gain((L, C)),
        'conv_ln_b': nrm((L, C), 0.02),
        'w_pw': nrm((L, C, C), C ** -0.5),
        'b_pw': nrm((L, C), 0.02),
        'q_norm': gain((L, MLA_Q_RANK)),
        'w_uq': nrm((L, MLA_Q_RANK, MLA_HEADS * (MLA_NOPE + MLA_ROPE)), MLA_Q_RANK ** -0.5),
        'kv_norm': gain((L, MLA_KV_RANK)),
        'w_ukv': nrm((L, MLA_KV_RANK, MLA_HEADS * (MLA_NOPE + MLA_V)), MLA_KV_RANK ** -0.5),
        'lambda_q1': nrm((L, DIFF_HD), 0.1),
        'lambda_k1': nrm((L, DIFF_HD), 0.1),
        'lambda_q2': nrm((L, DIFF_HD), 0.1),
        'lambda_k2': nrm((L, DIFF_HD), 0.1),
        'diff_subln': gain((L, DIFF_V)),
        'w_out': nrm((L, D_MIX, D), D_MIX ** -0.5),
        'ffn_norm': gain((L, D)),
        'w_gate_dense': nrm((N_DENSE, D, D_FF), D ** -0.5),
        'w_up_dense': nrm((N_DENSE, D, D_FF), D ** -0.5),
        'w_down_dense': nrm((N_DENSE, D_FF, D), D_FF ** -0.5),
        'w_router': nrm((N_MOE, D, N_EXPERTS), D ** -0.5),
        'w_gate_exp': nrm((N_MOE, N_EXPERTS, D, D_FF), D ** -0.5),
        'w_up_exp': nrm((N_MOE, N_EXPERTS, D, D_FF), D ** -0.5),
        'w_down_exp': nrm((N_MOE, N_EXPERTS, D_FF, D), D_FF ** -0.5),
        'final_norm': gain((D,)),
    }


def reference(x, attn_norm, w_in, b_glu, w_dw, b_dw, conv_ln_g, conv_ln_b, w_pw, b_pw,
              q_norm, w_uq, kv_norm, w_ukv, lambda_q1, lambda_k1, lambda_q2, lambda_k2,
              diff_subln, w_out, ffn_norm, w_gate_dense, w_up_dense, w_down_dense,
              w_router, w_gate_exp, w_up_exp, w_down_exp, final_norm):
    for l in range(DEPTH):
        h = rms_norm(x, attn_norm[l])
        x = x + hybrid_mixer(h, l, w_in[l], b_glu[l], w_dw[l], b_dw[l], conv_ln_g[l], conv_ln_b[l],
                             w_pw[l], b_pw[l], q_norm[l], w_uq[l], kv_norm[l], w_ukv[l],
                             lambda_q1[l], lambda_k1[l], lambda_q2[l], lambda_k2[l],
                             diff_subln[l], w_out[l])
        h = rms_norm(x, ffn_norm[l])
        j = l // 2
        if l % 2 == 0:
            x = x + swiglu(h, w_gate_dense[j], w_up_dense[j], w_down_dense[j])
        else:
            x = x + moe_ffn(h, w_router[j], w_gate_exp[j], w_up_exp[j], w_down_exp[j])
    return rms_norm(x, final_norm)
```

```cpp
#include <hip/hip_runtime.h>
#include <cstdio>
#include <cstdint>
namespace pg8 {
#define PG8_LAS __attribute__((address_space(3)))
typedef unsigned short bf16_t;
typedef short bf16x8 __attribute__((ext_vector_type(8)));
typedef float f32x4 __attribute__((ext_vector_type(4)));
typedef unsigned u32x4 __attribute__((ext_vector_type(4)));
constexpr int BM = 256, BK = 64, HALF = 128, HTB = HALF * BK * 2  , STAGE_BYTES = 8 * HTB, NXCD = 8, WGM = 8;

__host__ __device__ __forceinline__ int lds_byte(int r, int c) { const int st = (r >> 4) * 2 + (c >> 5), rr = r & 15, cc = c & 31, ob = rr * 64 + cc * 2; return st * 1024 + (ob ^ (((ob >> 9) & 1) << 5)); }
__host__ __device__ __forceinline__ void stage_rc(int b, int& R, int& C) { const int st = b / 1024, sb = b % 1024, swz = sb ^ (((sb >> 9) & 1) << 5); R = (st >> 1) * 16 + swz / 64; C = (st & 1) * 32 + (swz % 64) / 2; }
__host__ __device__ __forceinline__ int perm32(int rho) { const int n = rho >> 4, i = rho & 15; return 8 * (i >> 2) + 4 * n + (i & 3); }

struct Unit { int pm, pn, aux, aux2, aux3; };
struct Gemm { const bf16_t* A; const bf16_t* Bt; int lda, K; };

struct StaticOrder {
    int nM, nN, nwg, G, c;
    __host__ __device__ void init(int M, int N, int G_, int c_) { nM = M / BM; nN = N / BM; nwg = nM * nN; G = G_; c = c_; }
    __host__ __device__ bool next(int i, Unit& u) const {
        const long L = (long)i * G + c; if (L >= nwg) return false;
        int wgid = (int)L; { const int q = nwg / NXCD, r = nwg % NXCD, xcd = wgid % NXCD, off = wgid / NXCD; wgid = (xcd < r ? xcd * (q + 1) : r * (q + 1) + (xcd - r) * q) + off; }
        const int nig = WGM * nN, gid = wgid / nig, fm = gid * WGM, gsz = (nM - fm) < WGM ? (nM - fm) : WGM;
        u.pm = fm + ((wgid % nig) % gsz); u.pn = (wgid % nig) / gsz; return true;
    }
    __device__ __forceinline__ void a_ready(const Unit&) const {}
    __device__ __forceinline__ void done(const Unit&) const {}
};

__device__ __forceinline__ unsigned cvt_pk_bf16(float lo, float hi) { unsigned r; asm volatile("v_cvt_pk_bf16_f32 %0, %1, %2" : "=v"(r) : "v"(lo), "v"(hi)); return r; }
typedef float f32x2 __attribute__((ext_vector_type(2)));
typedef int i32x4 __attribute__((ext_vector_type(4)));
typedef int i32x8 __attribute__((ext_vector_type(8)));
#define PG8_RSBUF 147456
#define PG8_TOKBUF (131072 + 4096)
#ifndef FP8_SCALE1
#define FP8_SCALE1 0
#endif
__device__ __forceinline__ i32x8 cat8(bf16x8 a, bf16x8 b) { return __builtin_shufflevector(__builtin_bit_cast(i32x4, a), __builtin_bit_cast(i32x4, b), 0, 1, 2, 3, 4, 5, 6, 7); }
typedef float f32x8 __attribute__((ext_vector_type(8)));
typedef float f32x16 __attribute__((ext_vector_type(16)));
typedef float f32x32 __attribute__((ext_vector_type(32)));
__device__ __forceinline__ f32x32 cat32(f32x4 a, f32x4 b, f32x4 c, f32x4 d, f32x4 e, f32x4 f, f32x4 g, f32x4 h) {
    const f32x8 p = __builtin_shufflevector(a, b, 0, 1, 2, 3, 4, 5, 6, 7), q = __builtin_shufflevector(c, d, 0, 1, 2, 3, 4, 5, 6, 7), r = __builtin_shufflevector(e, f, 0, 1, 2, 3, 4, 5, 6, 7), s = __builtin_shufflevector(g, h, 0, 1, 2, 3, 4, 5, 6, 7);
    const f32x16 u = __builtin_shufflevector(p, q, 0, 1, 2, 3, 4, 5, 6, 7, 8, 9, 10, 11, 12, 13, 14, 15), v = __builtin_shufflevector(r, s, 0, 1, 2, 3, 4, 5, 6, 7, 8, 9, 10, 11, 12, 13, 14, 15);
    return __builtin_shufflevector(u, v, 0, 1, 2, 3, 4, 5, 6, 7, 8, 9, 10, 11, 12, 13, 14, 15, 16, 17, 18, 19, 20, 21, 22, 23, 24, 25, 26, 27, 28, 29, 30, 31); }
template <class Epi, class Sched, bool ALIGN_EPI = false, bool SP2 = false, bool GATHER = false, bool FP8 = false>
__device__ __forceinline__ void gemm_phase(PG8_LAS unsigned char* lds, const Gemm g, const Sched& S, const Epi& E, int wave_idx) {
    int tid_ = wave_idx * 64 + (int)__builtin_amdgcn_mbcnt_hi(~0u, __builtin_amdgcn_mbcnt_lo(~0u, 0u)); asm volatile("" : "+v"(tid_));
    const int tid = tid_, wid = __builtin_amdgcn_readfirstlane(tid >> 6), lane = tid & 63, wr = wid >> 2, wc = wid & 3, fr = lane & 15, fq = lane >> 4;
    const int K = g.K, lda = g.lda; int nt_ = K / BK; asm volatile("" : "+s"(nt_)); const int nt = nt_;
    unsigned voffA[2], voffB[2]; int rA_[2]; unsigned cA_[2]; unsigned gcur[2][2], gnxt[2][2];
#pragma unroll
    for (int i = 0; i < 2; ++i) { int R, C; stage_rc(tid * 16 + i * 8192, R, C); const int Rb = Epi::PERM ? ((R & ~31) + perm32(R & 31)) : R;
        voffA[i] = (unsigned)(R * lda + C) * 2u; rA_[i] = R; cA_[i] = (unsigned)C * 2u; voffB[i] = (unsigned)(Rb * K + C) * 2u; }
    const size_t kstep = (size_t)(BK * 2);
    const size_t hstepA = (size_t)HALF * lda * 2, hstepB = (size_t)HALF * K * 2;
    const size_t tstepA = GATHER ? 0 : 2 * hstepA, tstepB = 2 * hstepB;
    const unsigned ldsw = (unsigned)wid * 1024u;
    const int aoff = lds_byte(wr * 64 + fr, fq * 8), boff = lds_byte(wc * 32 + fr, fq * 8);
#define PG8_SA(b, h) (((b) * 2 + (h)) * HTB)
#define PG8_SB(b, h) ((4 + (b) * 2 + (h)) * HTB)
#define PG8_STAGE(bufoff, gbase, voff) do { _Pragma("unroll") for (int _i = 0; _i < 2; ++_i) \
        __builtin_amdgcn_global_load_lds((const unsigned*)((const char*)(gbase) + (voff)[_i]), (PG8_LAS unsigned*)(lds + (bufoff) + ldsw + _i * 8192), 16, 0, 0); } while (0)
#define PG8_STAGE_A(bufoff, gbase, h, NX) do { if constexpr (GATHER) { _Pragma("unroll") for (int _i = 0; _i < 2; ++_i) { const unsigned o_ = (NX) ? gnxt[h][_i] : gcur[h][_i]; \
        __builtin_amdgcn_global_load_lds((const unsigned*)((const char*)(gbase) + o_), (PG8_LAS unsigned*)(lds + (bufoff) + ldsw + _i * 8192), 16, 0, 0); } } \
    else { PG8_STAGE(bufoff, (const char*)(gbase) + (h) * hstepA, voffA); } } while (0)
#define PG8_LDA(dst, b, h) do { _Pragma("unroll") for (int m = 0; m < 4; ++m) _Pragma("unroll") for (int k = 0; k < 2; ++k) dst[m][k] = *(const PG8_LAS bf16x8*)(lds + PG8_SA(b, h) + aoff + m * 2048 + k * 1024); } while (0)
#define PG8_LDB(dst, b, h) do { _Pragma("unroll") for (int n = 0; n < 2; ++n) _Pragma("unroll") for (int k = 0; k < 2; ++k) dst[n][k] = *(const PG8_LAS bf16x8*)(lds + PG8_SB(b, h) + boff + n * 2048 + k * 1024); } while (0)
#define PG8_MMA(ai, bj, At, Bt) do { if constexpr (FP8 && bj == 0) { PG8_FRAG_ANCHOR("v[160:191]", At[0][0], At[0][1], At[1][0], At[1][1], At[2][0], At[2][1], At[3][0], At[3][1]); PG8_FRAG_ANCHOR("v[128:159]", B0[0][0], B0[0][1], B0[1][0], B0[1][1], B1[0][0], B1[0][1], B1[1][0], B1[1][1]); } \
        __builtin_amdgcn_s_setprio(1); _Pragma("unroll") for (int m = 0; m < 4; ++m) _Pragma("unroll") for (int n = 0; n < 2; ++n) { \
        if constexpr (FP8) acc[ai][bj][m][n] = __builtin_amdgcn_mfma_scale_f32_16x16x128_f8f6f4(cat8(Bt[n][0], Bt[n][1]), cat8(At[m][0], At[m][1]), acc[ai][bj][m][n], 0, 0, 0, FP8_SCALE1, 0, FP8_SCALE1); \
        else { _Pragma("unroll") for (int k = 0; k < 2; ++k) acc[ai][bj][m][n] = __builtin_amdgcn_mfma_f32_16x16x32_bf16(Bt[n][k], At[m][k], acc[ai][bj][m][n], 0, 0, 0); } } __builtin_amdgcn_s_setprio(0); } while (0)
#define PG8_FRAG_ANCHOR(REG, f0, f1, f2, f3, f4, f5, f6, f7) do { f32x32 big_ = cat32(__builtin_bit_cast(f32x4, f0), __builtin_bit_cast(f32x4, f1), __builtin_bit_cast(f32x4, f2), __builtin_bit_cast(f32x4, f3), __builtin_bit_cast(f32x4, f4), __builtin_bit_cast(f32x4, f5), __builtin_bit_cast(f32x4, f6), __builtin_bit_cast(f32x4, f7)); asm volatile("" : "+{" REG "}"(big_)); \
        f0 = __builtin_bit_cast(bf16x8, (f32x4)__builtin_shufflevector(big_, big_, 0, 1, 2, 3)); f1 = __builtin_bit_cast(bf16x8, (f32x4)__builtin_shufflevector(big_, big_, 4, 5, 6, 7)); f2 = __builtin_bit_cast(bf16x8, (f32x4)__builtin_shufflevector(big_, big_, 8, 9, 10, 11)); f3 = __builtin_bit_cast(bf16x8, (f32x4)__builtin_shufflevector(big_, big_, 12, 13, 14, 15)); \
        f4 = __builtin_bit_cast(bf16x8, (f32x4)__builtin_shufflevector(big_, big_, 16, 17, 18, 19)); f5 = __builtin_bit_cast(bf16x8, (f32x4)__builtin_shufflevector(big_, big_, 20, 21, 22, 23)); f6 = __builtin_bit_cast(bf16x8, (f32x4)__builtin_shufflevector(big_, big_, 24, 25, 26, 27)); f7 = __builtin_bit_cast(bf16x8, (f32x4)__builtin_shufflevector(big_, big_, 28, 29, 30, 31)); } while (0)
#define PG8_WAIT_V(n) asm volatile("s_waitcnt vmcnt(" #n ")" ::: "memory")
#define PG8_WAIT_L(n) asm volatile("s_waitcnt lgkmcnt(" #n ")" ::: "memory")
#define PG8_BAR __builtin_amdgcn_s_barrier()
#define PG8_SCHED __builtin_amdgcn_sched_barrier(0)
    Unit cur, nxt; int ui = 0;
    if (!S.next(0, cur)) return;
    if constexpr (GATHER) {
#pragma unroll
        for (int h_ = 0; h_ < 2; ++h_)
#pragma unroll
            for (int i_ = 0; i_ < 2; ++i_) { gcur[h_][i_] = (unsigned)S.row_tok(cur, h_ * HALF + rA_[i_]) * (unsigned)(lda * 2) + cA_[i_]; gnxt[h_][i_] = gcur[h_][i_]; } }
#define PG8_ANCHOR() do { if constexpr (FP8) { _Pragma("unroll") for (int a_ = 0; a_ < 2; ++a_) _Pragma("unroll") for (int b_ = 0; b_ < 2; ++b_) { \
        f32x32 big_ = cat32(acc[a_][b_][0][0], acc[a_][b_][0][1], acc[a_][b_][1][0], acc[a_][b_][1][1], acc[a_][b_][2][0], acc[a_][b_][2][1], acc[a_][b_][3][0], acc[a_][b_][3][1]); if (a_ == 0 && b_ == 0) asm volatile("" : "+{v[0:31]}"(big_)); else if (a_ == 0) asm volatile("" : "+{v[32:63]}"(big_)); else if (b_ == 0) asm volatile("" : "+{v[64:95]}"(big_)); else asm volatile("" : "+{v[96:127]}"(big_)); \
        acc[a_][b_][0][0] = __builtin_shufflevector(big_, big_, 0, 1, 2, 3); acc[a_][b_][0][1] = __builtin_shufflevector(big_, big_, 4, 5, 6, 7); acc[a_][b_][1][0] = __builtin_shufflevector(big_, big_, 8, 9, 10, 11); acc[a_][b_][1][1] = __builtin_shufflevector(big_, big_, 12, 13, 14, 15); \
        acc[a_][b_][2][0] = __builtin_shufflevector(big_, big_, 16, 17, 18, 19); acc[a_][b_][2][1] = __builtin_shufflevector(big_, big_, 20, 21, 22, 23); acc[a_][b_][3][0] = __builtin_shufflevector(big_, big_, 24, 25, 26, 27); acc[a_][b_][3][1] = __builtin_shufflevector(big_, big_, 28, 29, 30, 31); } } } while (0)
    f32x4 acc[2][2][4][2];
#pragma unroll
    for (int a = 0; a < 2; ++a)
#pragma unroll
        for (int b = 0; b < 2; ++b)
#pragma unroll
            for (int m = 0; m < 4; ++m)
#pragma unroll
                for (int n = 0; n < 2; ++n) acc[a][b][m][n] = (f32x4){0.f, 0.f, 0.f, 0.f};
    PG8_ANCHOR();
    bf16x8 At[4][2], B0[2][2], B1[2][2];
    const char* cA = (const char*)g.A + (size_t)cur.pm * tstepA; const char* cB = (const char*)g.Bt + (size_t)cur.pn * tstepB;
    S.a_ready(cur);
    if constexpr (SP2) {
        PG8_STAGE(PG8_SB(0, 0), cB, voffB); PG8_STAGE(PG8_SB(0, 1), cB + hstepB, voffB); PG8_STAGE_A(PG8_SA(0, 0), cA, 0, false); PG8_STAGE_A(PG8_SA(0, 1), cA, 1, false);
        if (wr == 1) PG8_BAR;
        PG8_WAIT_V(2); PG8_BAR;
        PG8_STAGE(PG8_SB(1, 0), cB + kstep, voffB); PG8_STAGE_A(PG8_SA(1, 0), cA + kstep, 0, false); PG8_STAGE(PG8_SB(1, 1), cB + hstepB + kstep, voffB);
        PG8_WAIT_V(6); PG8_BAR;
    } else {
        PG8_STAGE(PG8_SB(0, 0), cB, voffB); PG8_STAGE_A(PG8_SA(0, 0), cA, 0, false); PG8_STAGE(PG8_SB(0, 1), cB + hstepB, voffB); PG8_STAGE_A(PG8_SA(0, 1), cA, 1, false);
        if (wr == 1) PG8_BAR;
        PG8_WAIT_V(4); PG8_BAR;
        PG8_STAGE(PG8_SB(1, 0), cB + kstep, voffB); PG8_STAGE_A(PG8_SA(1, 0), cA + kstep, 0, false); PG8_STAGE(PG8_SB(1, 1), cB + hstepB + kstep, voffB);
        PG8_WAIT_V(6); PG8_BAR;
    }
    for (;;) {
        bool has_next = false; const char* nA = cA; const char* nB = cB;
        _Pragma("nounroll") for (int t = 0; t < nt; t += 2) {
            const bool last = (t == nt - 2);
            const char* a1 = cA + (size_t)(t + 1) * kstep;
            if constexpr (SP2) {
            PG8_LDB(B0, 0, 0); PG8_LDB(B1, 0, 1); PG8_SCHED; PG8_LDA(At, 0, 0); PG8_STAGE_A(PG8_SA(1, 1), a1, 1, false);
            PG8_WAIT_V(8); PG8_WAIT_L(0); PG8_BAR; PG8_MMA(0, 0, At, B0); PG8_MMA(0, 1, At, B1); PG8_BAR; PG8_SCHED;
            if (t == 0) {
        if constexpr (Epi::RSNP == 16) { const char* rp_ = (const char*)E.rs_src(cur);
            if (rp_) { _Pragma("unroll") for (int i_ = 0; i_ < 2; ++i_) __builtin_amdgcn_global_load_lds((const unsigned*)(rp_ + tid * 16 + i_ * 8192), (PG8_LAS unsigned*)(lds + PG8_RSBUF + wid * 1024 + i_ * 8192), 16, 0, 0); } }
        if constexpr (Epi::RSNP == 4) { const char* rp_ = (const char*)E.rs_src(cur);
            if (rp_ && wid < 4) __builtin_amdgcn_global_load_lds((const unsigned*)(rp_ + tid * 16), (PG8_LAS unsigned*)(lds + PG8_RSBUF + wid * 1024), 16, 0, 0); }
has_next = S.next(ui + 1, nxt);
        if constexpr (GATHER) { if (has_next && wid < 4) {
            __builtin_amdgcn_global_load_lds((const unsigned*)(S.row_ptr(nxt) + tid), (PG8_LAS unsigned*)(lds + PG8_TOKBUF + wid * 256), 4, 0, 0); } }
        nA = has_next ? (const char*)g.A + (size_t)nxt.pm * tstepA : cA; nB = has_next ? (const char*)g.Bt + (size_t)nxt.pn * tstepB : cB;
            }
            const char* a2 = last ? nA : cA + (size_t)(t + 2) * kstep; const char* b2 = last ? nB : cB + (size_t)(t + 2) * kstep;
            const char* a3 = a2 + kstep; const char* b3 = b2 + kstep;
            if (last && has_next) S.a_ready(nxt);
            if constexpr (GATHER) { if (last && has_next) { asm volatile("" ::: "memory");
#pragma unroll
                for (int h_ = 0; h_ < 2; ++h_)
#pragma unroll
                    for (int i_ = 0; i_ < 2; ++i_) { const int tk_ = *(const PG8_LAS int*)(lds + PG8_TOKBUF + (h_ * HALF + rA_[i_]) * 4); gnxt[h_][i_] = (unsigned)(tk_ & 0xffff) * (unsigned)(lda * 2) + cA_[i_]; } } }
            PG8_LDA(At, 0, 1); PG8_STAGE(PG8_SB(0, 0), b2, voffB); PG8_STAGE(PG8_SB(0, 1), b2 + hstepB, voffB); PG8_STAGE_A(PG8_SA(0, 0), a2, 0, last);
            PG8_WAIT_V(8); PG8_WAIT_L(0); PG8_BAR; PG8_MMA(1, 0, At, B0); PG8_MMA(1, 1, At, B1); PG8_BAR; PG8_SCHED;
            PG8_LDB(B0, 1, 0); PG8_LDB(B1, 1, 1); PG8_SCHED; PG8_LDA(At, 1, 0); PG8_STAGE_A(PG8_SA(0, 1), a2, 1, last);
            PG8_WAIT_V(8); PG8_WAIT_L(0); PG8_BAR; PG8_MMA(0, 0, At, B0); PG8_MMA(0, 1, At, B1); PG8_BAR; PG8_SCHED;
            PG8_LDA(At, 1, 1); PG8_STAGE(PG8_SB(1, 0), b3, voffB); PG8_STAGE(PG8_SB(1, 1), b3 + hstepB, voffB); PG8_STAGE_A(PG8_SA(1, 0), a3, 0, last);
            PG8_WAIT_V(8); PG8_WAIT_L(0); PG8_BAR; PG8_MMA(1, 0, At, B0); PG8_MMA(1, 1, At, B1); PG8_BAR; PG8_SCHED;
            } else {
            if (t == 0) {
        if constexpr (Epi::RSNP == 16) { const char* rp_ = (const char*)E.rs_src(cur);
            if (rp_) { _Pragma("unroll") for (int i_ = 0; i_ < 2; ++i_) __builtin_amdgcn_global_load_lds((const unsigned*)(rp_ + tid * 16 + i_ * 8192), (PG8_LAS unsigned*)(lds + PG8_RSBUF + wid * 1024 + i_ * 8192), 16, 0, 0); } }
        if constexpr (Epi::RSNP == 4) { const char* rp_ = (const char*)E.rs_src(cur);
            if (rp_ && wid < 4) __builtin_amdgcn_global_load_lds((const unsigned*)(rp_ + tid * 16), (PG8_LAS unsigned*)(lds + PG8_RSBUF + wid * 1024), 16, 0, 0); }
has_next = S.next(ui + 1, nxt);
        if constexpr (GATHER) { if (has_next && wid < 4) {
            __builtin_amdgcn_global_load_lds((const unsigned*)(S.row_ptr(nxt) + tid), (PG8_LAS unsigned*)(lds + PG8_TOKBUF + wid * 256), 4, 0, 0); } }
        nA = has_next ? (const char*)g.A + (size_t)nxt.pm * tstepA : cA; nB = has_next ? (const char*)g.Bt + (size_t)nxt.pn * tstepB : cB;
            }
            const char* a2 = last ? nA : cA + (size_t)(t + 2) * kstep; const char* b2 = last ? nB : cB + (size_t)(t + 2) * kstep;
            const char* a3 = a2 + kstep; const char* b3 = b2 + kstep;
            if (last && has_next) S.a_ready(nxt);
            if constexpr (GATHER) { if (last && has_next) { asm volatile("" ::: "memory");
#pragma unroll
                for (int h_ = 0; h_ < 2; ++h_)
#pragma unroll
                    for (int i_ = 0; i_ < 2; ++i_) { const int tk_ = *(const PG8_LAS int*)(lds + PG8_TOKBUF + (h_ * HALF + rA_[i_]) * 4); gnxt[h_][i_] = (unsigned)(tk_ & 0xffff) * (unsigned)(lda * 2) + cA_[i_]; } } }
            PG8_LDB(B0, 0, 0); PG8_SCHED; PG8_LDA(At, 0, 0); PG8_STAGE_A(PG8_SA(1, 1), a1, 1, false);
            PG8_WAIT_L(8); PG8_BAR; PG8_WAIT_L(0); PG8_MMA(0, 0, At, B0); PG8_BAR; PG8_SCHED;
            PG8_LDB(B1, 0, 1); PG8_STAGE(PG8_SB(0, 0), b2, voffB);
            PG8_BAR; PG8_WAIT_L(0); PG8_MMA(0, 1, At, B1); PG8_BAR;
            PG8_LDA(At, 0, 1); PG8_STAGE_A(PG8_SA(0, 0), a2, 0, last);
            PG8_BAR; PG8_WAIT_L(0); PG8_MMA(1, 0, At, B0); PG8_BAR; PG8_SCHED;
            PG8_STAGE(PG8_SB(0, 1), b2 + hstepB, voffB);
            PG8_WAIT_V(6); PG8_BAR; PG8_MMA(1, 1, At, B1); PG8_BAR;
            PG8_LDB(B0, 1, 0); PG8_SCHED; PG8_LDA(At, 1, 0); PG8_STAGE_A(PG8_SA(0, 1), a2, 1, last);
            PG8_WAIT_L(8); PG8_BAR; PG8_WAIT_L(0); PG8_MMA(0, 0, At, B0); PG8_BAR; PG8_SCHED;
            PG8_LDB(B1, 1, 1); PG8_STAGE(PG8_SB(1, 0), b3, voffB);
            PG8_BAR; PG8_WAIT_L(0); PG8_MMA(0, 1, At, B1); PG8_BAR;
            PG8_LDA(At, 1, 1); PG8_STAGE_A(PG8_SA(1, 0), a3, 0, last);
            PG8_BAR; PG8_WAIT_L(0); PG8_MMA(1, 0, At, B0); PG8_BAR; PG8_SCHED;
            PG8_STAGE(PG8_SB(1, 1), b3 + hstepB, voffB);
            PG8_WAIT_V(6); PG8_BAR; PG8_MMA(1, 1, At, B1); PG8_BAR;
            }
        }
        if constexpr (ALIGN_EPI) { if (wr == 0) PG8_BAR; }
        if constexpr (!Epi::AFTER_DRAIN) { E(acc, cur, wr, wc, fr, fq); S.done(cur); }
        if (!has_next) break;
#pragma unroll
        for (int a = 0; a < 2; ++a)
#pragma unroll
            for (int b = 0; b < 2; ++b)
#pragma unroll
                for (int m = 0; m < 4; ++m)
#pragma unroll
                    for (int n = 0; n < 2; ++n) acc[a][b][m][n] = (f32x4){0.f, 0.f, 0.f, 0.f};
    PG8_ANCHOR();
        cur = nxt; cA = nA; cB = nB; ++ui;
        if constexpr (GATHER) {
#pragma unroll
            for (int h_ = 0; h_ < 2; ++h_)
#pragma unroll
                for (int i_ = 0; i_ < 2; ++i_) gcur[h_][i_] = gnxt[h_][i_]; }
        if constexpr (ALIGN_EPI) { if (wr == 1) PG8_BAR; }
    }
    PG8_WAIT_V(0);
    if constexpr (!ALIGN_EPI) { if (wr == 0) PG8_BAR; }
    PG8_BAR;
    if constexpr (Epi::AFTER_DRAIN) { E.fused(acc, cur, wr, wc, fr, fq, lds, wid, lane); S.done(cur); }
#undef PG8_SA
#undef PG8_SB
#undef PG8_STAGE
#undef PG8_STAGE_A
#undef PG8_LDA
#undef PG8_LDB
#undef PG8_MMA
#undef PG8_WAIT_V
#undef PG8_WAIT_L
#undef PG8_BAR
#undef PG8_SCHED
}
}

constexpr int NWAVES = 8;
constexpr int M = 65536, SEQ = 2048, NBATCH = 32, D = 1024;
constexpr int NPROJ = 2304, FF = 2816, NGU = 2 * FF, NEXP = 8;
constexpr int C_CQ = 512, C_CKV = 768, C_KR = 896, C_DQ = 1024, C_DK = 1408, C_DV = 1792;
constexpr int QW = 576, KVW = 768;
constexpr float LOG2E = 1.4426950408889634f;
constexpr float RMS_EPS = 1e-6f, LN_EPS = 1e-5f;
constexpr float LAM_INIT0 = 0.2f, LAM_INIT1 = 0.35550906759096926f;
constexpr int NPHASE = 19;
constexpr int MOE_CHUNK_TILES = 128, MOE_MAX_TILES = 528;

constexpr size_t MiB = 1u << 20;
constexpr size_t WS_CTL = 0, CTL_ZERO_BYTES = 40960;
constexpr size_t WS_SSX = 4 * MiB;
constexpr size_t WS_SSF = 12 * MiB;
constexpr size_t WS_SSCQ = 16 * MiB;
constexpr size_t WS_SSCKV = 18 * MiB;
constexpr size_t WS_SSF1 = 20 * MiB;
constexpr size_t WS_ROPE = 21 * MiB;
constexpr size_t BGLU_OFF = 320 * 1024;
constexpr size_t WS_WR = 21 * MiB + 512 * 1024;
constexpr size_t WS_LAM = 21 * MiB + 768 * 1024;
constexpr size_t WS_WIN = 22 * MiB;
constexpr size_t WS_WUQ = 31 * MiB;
constexpr size_t WS_WUKV = WS_WUQ + 768 * 1024;
constexpr size_t WS_WPW = WS_WUKV + 768 * 1024;
constexpr size_t WS_WOUT = 33 * MiB;
constexpr size_t WS_WGUD = 37 * MiB;
constexpr size_t WS_WDD = 48 * MiB;
constexpr size_t WS_WGUE = 54 * MiB;
constexpr size_t WS_WDE = 142 * MiB;
constexpr size_t WS_XB = 186 * MiB;
constexpr size_t WS_PROJ = 314 * MiB;
constexpr size_t WS_Q = 602 * MiB;
constexpr size_t WS_KV = 674 * MiB;
constexpr size_t WS_KR = 770 * MiB;
constexpr size_t WS_CB = 774 * MiB;
constexpr size_t WS_CAT = 806 * MiB;
constexpr size_t WS_ACT = 314 * MiB;
constexpr size_t WS_HB3 = 314 * MiB;
constexpr size_t WS_Y1 = 442 * MiB;
constexpr size_t WS_ACT0 = 570 * MiB;
constexpr size_t WS_ACT1 = 746 * MiB;
constexpr size_t WS_LIST = 922 * MiB;
constexpr size_t WS_WGT = 926 * MiB;
constexpr size_t WS_END = 934 * MiB;
static_assert(WS_WPW + 2 * 256 * 256 * 2 <= WS_WOUT && WS_WDD + (size_t)1024 * 2816 * 2 <= WS_WGUE && WS_WGUE + (size_t)8 * 5632 * 1024 * 2 <= WS_WDE && WS_WDE + (size_t)8 * 1024 * 2816 * 2 <= WS_XB, "weights map");
static_assert(WS_ACT + (size_t)M * FF * 2 <= WS_KV && WS_ACT0 + (size_t)MOE_CHUNK_TILES * 256 * FF * 2 <= WS_ACT1 && WS_ACT1 + (size_t)MOE_CHUNK_TILES * 256 * FF * 2 <= WS_LIST && WS_WGT + 4 * MiB <= WS_END, "overlay map");
constexpr int CW_TMO = 0, CW_CODE = 1;
constexpr int CW_BAR = 4096;
constexpr int CW_CNT = 8192;
static_assert((CW_CNT + 8 * 64) * 4 <= (int)CTL_ZERO_BYTES && (CW_BAR + 3456) * 4 <= CW_CNT * 4, "control words inside the memset region");

constexpr int RING_OFF = 0, RING_BYTES = 131072;
constexpr int LDSCTL_OFF = RING_BYTES, MISC_OFF = LDSCTL_OFF + 320;
constexpr int RSBUF_OFF = 147456;
constexpr int LDS_BYTES = 163840;
static_assert(MISC_OFF + 64 * 4 <= LDS_BYTES, "LDS map");

#define GAS __attribute__((address_space(1)))
#define LAS __attribute__((address_space(3)))
typedef unsigned short bf16;
typedef unsigned v4u __attribute__((ext_vector_type(4)));
typedef unsigned v2u __attribute__((ext_vector_type(2)));
typedef float f32x4 __attribute__((ext_vector_type(4)));
typedef short bf16x8 __attribute__((ext_vector_type(8)));
typedef GAS unsigned gu32;
#define RLX_AGENT __ATOMIC_RELAXED, __HIP_MEMORY_SCOPE_AGENT
#define LDS_WAIT() asm volatile("s_waitcnt lgkmcnt(0)" ::: "memory")
#define VM_WAIT() asm volatile("s_waitcnt vmcnt(0)" ::: "memory")
__device__ __forceinline__ unsigned pkbf(float lo, float hi) { return pg8::cvt_pk_bf16(lo, hi); }
__device__ __forceinline__ float bf_lo(unsigned w) { return __uint_as_float(w << 16); }
__device__ __forceinline__ float bf_hi(unsigned w) { return __uint_as_float(w & 0xffff0000u); }
__device__ __forceinline__ float sigmoidf_(float x) { return __builtin_amdgcn_rcpf(1.0f + __builtin_amdgcn_exp2f(-x * LOG2E)); }
__device__ __forceinline__ float wave_sum(float v) {
#pragma unroll
    for (int o = 1; o < 64; o <<= 1) v += __shfl_xor(v, o);
    return v;
}
constexpr float QS_GU = 32.f, QS_D = 64.f, QS_ACT = 4.f;
__device__ __forceinline__ float clamp8(float x) { return __builtin_fminf(__builtin_fmaxf(x, -448.f), 448.f); }
__device__ __forceinline__ unsigned pk4f8(float a, float b, float c, float d) {
    int p = 0; p = __builtin_amdgcn_cvt_pk_fp8_f32(clamp8(a), clamp8(b), p, false); p = __builtin_amdgcn_cvt_pk_fp8_f32(clamp8(c), clamp8(d), p, true); return (unsigned)p; }
__device__ __forceinline__ float dot4_(f32x4 v) { return (v[0] * v[0] + v[1] * v[1]) + (v[2] * v[2] + v[3] * v[3]); }

namespace pg8 {
typedef unsigned u32x2 __attribute__((ext_vector_type(2)));
__device__ __forceinline__ float red_fq(float s) {
    const auto a = __builtin_amdgcn_permlane16_swap(__float_as_uint(s), __float_as_uint(s), false, false); s = __uint_as_float(a[0]) + __uint_as_float(a[1]);
    const auto b = __builtin_amdgcn_permlane32_swap(__float_as_uint(s), __float_as_uint(s), false, false); return __uint_as_float(b[0]) + __uint_as_float(b[1]);
}
__device__ __forceinline__ void load_rs8(const float* ssp_, int np, int row0, int fq, float inv_n, float eps, float (&rs)[2][4]) {
    const GAS float* ssp = (const GAS float*)ssp_;
    if (np == 16) { f32x4 t[2][4];
#pragma unroll
        for (int ai = 0; ai < 2; ++ai)
#pragma unroll
            for (int m = 0; m < 4; ++m) t[ai][m] = *(const GAS f32x4*)((const GAS char*)ssp + ((unsigned)(row0 + ai * HALF + m * 16) * 64u + 16u * fq));
#pragma unroll
        for (int ai = 0; ai < 2; ++ai)
#pragma unroll
            for (int m = 0; m < 4; ++m) rs[ai][m] = (t[ai][m][0] + t[ai][m][1]) + (t[ai][m][2] + t[ai][m][3]);
    } else if (np == 4) {
#pragma unroll
        for (int ai = 0; ai < 2; ++ai)
#pragma unroll
            for (int m = 0; m < 4; ++m) rs[ai][m] = *(const GAS float*)((const GAS char*)ssp + ((unsigned)(row0 + ai * HALF + m * 16) * 16u + 4u * fq));
    } else {
#pragma unroll
        for (int ai = 0; ai < 2; ++ai)
#pragma unroll
            for (int m = 0; m < 4; ++m) rs[ai][m] = (fq == 0) ? ssp[row0 + ai * HALF + m * 16] : 0.f;
    }
#pragma unroll
    for (int ai = 0; ai < 2; ++ai)
#pragma unroll
        for (int m = 0; m < 4; ++m) rs[ai][m] = __builtin_amdgcn_rsqf(red_fq(rs[ai][m]) * inv_n + eps);
}
__device__ __forceinline__ void load_rs8_lds(const PG8_LAS float* rsl, int trow0, int fq, float inv_n, float eps, float (&rs)[2][4]) {
    f32x4 t[2][4];
#pragma unroll
    for (int ai = 0; ai < 2; ++ai)
#pragma unroll
        for (int m = 0; m < 4; ++m) t[ai][m] = *(const PG8_LAS f32x4*)(rsl + (trow0 + ai * HALF + m * 16) * 16 + 4 * fq);
#pragma unroll
    for (int ai = 0; ai < 2; ++ai)
#pragma unroll
        for (int m = 0; m < 4; ++m) rs[ai][m] = __builtin_amdgcn_rsqf(red_fq((t[ai][m][0] + t[ai][m][1]) + (t[ai][m][2] + t[ai][m][3])) * inv_n + eps);
}
__device__ __forceinline__ void load_rs8_lds4(const PG8_LAS float* rsl, int trow0, int fq, float inv_n, float eps, float (&rs)[2][4]) {
#pragma unroll
    for (int ai = 0; ai < 2; ++ai)
#pragma unroll
        for (int m = 0; m < 4; ++m) rs[ai][m] = rsl[(trow0 + ai * HALF + m * 16) * 4 + fq];
#pragma unroll
    for (int ai = 0; ai < 2; ++ai)
#pragma unroll
        for (int m = 0; m < 4; ++m) rs[ai][m] = __builtin_amdgcn_rsqf(red_fq(rs[ai][m]) * inv_n + eps);
}
__device__ __forceinline__ float dot4(f32x4 v) { return (v[0] * v[0] + v[1] * v[1]) + (v[2] * v[2] + v[3] * v[3]); }

__device__ __forceinline__ void rope4(f32x4& x1, f32x4& x2, const float* rope, int pos, int g) {
    const GAS f32x4* t = (const GAS f32x4*)(rope + ((size_t)pos * 16 + 4 * g) * 2); const f32x4 t0 = t[0], t1 = t[1];
    const f32x4 c = (f32x4){t0[0], t0[2], t1[0], t1[2]}, s = (f32x4){t0[1], t0[3], t1[1], t1[3]};
    const f32x4 a = x1 * c - x2 * s, b = x1 * s + x2 * c; x1 = a; x2 = b;
}
__device__ __forceinline__ void rope4v(f32x4& x1, f32x4& x2, f32x4 t0, f32x4 t1) {
    const f32x4 c = (f32x4){t0[0], t0[2], t1[0], t1[2]}, s = (f32x4){t0[1], t0[3], t1[1], t1[3]};
    const f32x4 a = x1 * c - x2 * s, b = x1 * s + x2 * c; x1 = a; x2 = b;
}
__device__ __forceinline__ u32x4 pack8(f32x4 v0, f32x4 v1) { u32x4 w; w.x = cvt_pk_bf16(v0[0], v0[1]); w.y = cvt_pk_bf16(v0[2], v0[3]); w.z = cvt_pk_bf16(v1[0], v1[1]); w.w = cvt_pk_bf16(v1[2], v1[3]); return w; }

struct EpiStore {
    static constexpr bool PERM = true, AFTER_DRAIN = false;
    static constexpr int RSNP = 4;
    bf16_t* O; int ldc; const float* bias; const float* ss; int np; float inv_n, eps; const PG8_LAS float* rsl = nullptr;
    __device__ __forceinline__ const float* rs_src(const Unit& u) const { return (ss && rsl && np == 4) ? ss + (size_t)u.pm * BM * 4 : nullptr; }
    __device__ __forceinline__ void operator()(const f32x4 (&acc)[2][2][4][2], const Unit& u, int wr, int wc, int fr, int fq) const {
        const int row0 = u.pm * BM + wr * 64 + fr, col0 = u.pn * BM + wc * 32 + 8 * fq;
        f32x4 bv[2][2];
#pragma unroll
        for (int bj = 0; bj < 2; ++bj)
#pragma unroll
            for (int n = 0; n < 2; ++n) bv[bj][n] = bias ? *(const GAS f32x4*)(bias + col0 + bj * HALF + 4 * n) : (f32x4){0.f, 0.f, 0.f, 0.f};
        float rsv[2][4];
        if (ss) { if (rsl && np == 4) load_rs8_lds4(rsl, wr * 64 + fr, fq, inv_n, eps, rsv); else load_rs8(ss, np, row0, fq, inv_n, eps, rsv); }
        else {
#pragma unroll
            for (int ai = 0; ai < 2; ++ai)
#pragma unroll
                for (int m = 0; m < 4; ++m) rsv[ai][m] = 1.0f; }
#pragma unroll
        for (int ai = 0; ai < 2; ++ai)
#pragma unroll
            for (int m = 0; m < 4; ++m) { const int row = row0 + ai * HALF + m * 16; const float rs = rsv[ai][m];
                const unsigned ob = ((unsigned)row * (unsigned)ldc + (unsigned)col0) * 2u;
#pragma unroll
                for (int bj = 0; bj < 2; ++bj) *(GAS u32x4*)((GAS char*)O + (ob + bj * HALF * 2)) = pack8(acc[ai][bj][m][0] * rs + bv[bj][0], acc[ai][bj][m][1] * rs + bv[bj][1]); }
    }
};
struct EpiProj {
    static constexpr bool PERM = true, AFTER_DRAIN = false;
    static constexpr int RSNP = 16;
    bf16_t* proj; const float* ss_x; float* ss_cq; float* ss_ckv; bf16_t* krope; const float* rope; const PG8_LAS float* rsl = nullptr;
    __device__ __forceinline__ const float* rs_src(const Unit& u) const { return (ss_x && rsl) ? ss_x + (size_t)u.pm * BM * 16 : nullptr; }
    __device__ __forceinline__ void operator()(const f32x4 (&acc)[2][2][4][2], const Unit& u, int wr, int wc, int fr, int fq) const {
        const int row0 = u.pm * BM + wr * 64 + fr, col0 = u.pn * BM + wc * 32 + 8 * fq;
        float rsv[2][4];
        if (ss_x) { if (rsl) load_rs8_lds(rsl, wr * 64 + fr, fq, 1.0f / 1024.0f, 1e-6f, rsv); else load_rs8(ss_x, 16, row0, fq, 1.0f / 1024.0f, 1e-6f, rsv); }
        else {
#pragma unroll
            for (int ai = 0; ai < 2; ++ai)
#pragma unroll
                for (int m = 0; m < 4; ++m) rsv[ai][m] = 1.0f; }
        const bool glu_ = u.pn < 2;
        f32x4 gb[2][2];
        { const int c0 = (glu_ ? u.pn : 0) * 128 + wc * 32 + 8 * fq; const float* bglu = (const float*)((const char*)rope + BGLU_OFF) + (ss_x ? 512 : 0);
#pragma unroll
          for (int n = 0; n < 2; ++n) { gb[0][n] = *(const GAS f32x4*)(bglu + c0 + 4 * n); gb[1][n] = *(const GAS f32x4*)(bglu + 256 + c0 + 4 * n); } }
#pragma unroll
        for (int ai = 0; ai < 2; ++ai)
#pragma unroll
            for (int m = 0; m < 4; ++m) { const int row = row0 + ai * HALF + m * 16; const float rs = rsv[ai][m];
                const unsigned ob = ((unsigned)row * 2304u + (unsigned)col0) * 2u; float sq0 = 0.f, sq1 = 0.f;
                if (glu_) { f32x4 o_[2];
#pragma unroll
                    for (int n = 0; n < 2; ++n) { f32x4 t_ = (acc[ai][1][m][n] * rs + gb[1][n]) * -1.4426950408889634f;
#pragma unroll
                        for (int j = 0; j < 4; ++j) t_[j] = __builtin_amdgcn_rcpf(1.0f + __builtin_amdgcn_exp2f(t_[j]));
                        o_[n] = (acc[ai][0][m][n] * rs + gb[0][n]) * t_; }
                    *(GAS u32x4*)((GAS char*)proj + ((unsigned)row * 2304u + (unsigned)(u.pn * 128 + wc * 32 + 8 * fq)) * 2u) = pack8(o_[0], o_[1]); continue; }
#pragma unroll
                for (int bj = 0; bj < 2; ++bj) { f32x4 v0 = acc[ai][bj][m][0] * rs, v1 = acc[ai][bj][m][1] * rs;
                    if (u.pn == 2 || u.pn == 3) { if (bj == 0) sq0 = dot4(v0) + dot4(v1); else sq1 = dot4(v0) + dot4(v1); }
                    if (!(bj == 1 && ((u.pn == 3 && wc >= 1) || u.pn == 8))) *(GAS u32x4*)((GAS char*)proj + (ob + bj * HALF * 2)) = pack8(v0, v1);
 }
                if (u.pn == 2) { const float s = red_fq(sq0 + sq1); if (fq == 0) *(GAS float*)((GAS char*)ss_cq + ((unsigned)row * 16u + 4u * wc)) = s; }
                else if (u.pn == 3) { const float s = red_fq(sq0); if (fq == 0) *(GAS float*)((GAS char*)ss_ckv + ((unsigned)row * 16u + 4u * wc)) = s; } }
        if (u.pn == 3 && wc == 0) {
            f32x4 tr[2][4][2];
#pragma unroll
            for (int ai = 0; ai < 2; ++ai)
#pragma unroll
                for (int m = 0; m < 4; ++m) { const GAS f32x4* t = (const GAS f32x4*)(rope + ((size_t)((row0 + ai * HALF + m * 16) & 2047) * 16 + 4 * fq) * 2); tr[ai][m][0] = t[0]; tr[ai][m][1] = t[1]; }
#pragma unroll
            for (int ai = 0; ai < 2; ++ai)
#pragma unroll
                for (int m = 0; m < 4; ++m) { const int row = row0 + ai * HALF + m * 16; const float rs = rsv[ai][m];
                    f32x4 v0 = acc[ai][1][m][0] * rs, v1 = acc[ai][1][m][1] * rs; rope4v(v0, v1, tr[ai][m][0], tr[ai][m][1]); *(GAS u32x4*)((GAS char*)krope + ((unsigned)row * 64u + 16u * fq)) = pack8(v0, v1); } }
    }
};
struct EpiQ {
    static constexpr bool PERM = true, AFTER_DRAIN = false;
    static constexpr int RSNP = 4;
    bf16_t* q; const float* ss_cq; const float* rope; const PG8_LAS float* rsl = nullptr;
    __device__ __forceinline__ const float* rs_src(const Unit& u) const { return rsl ? ss_cq + (size_t)u.pm * BM * 4 : nullptr; }
    __device__ __forceinline__ void operator()(const f32x4 (&acc)[2][2][4][2], const Unit& u, int wr, int wc, int fr, int fq) const {
        if (wc == 3) return;
        const int row0 = u.pm * BM + wr * 64 + fr;
        f32x4 tr[2][4][2];
        if (wc == 2) {
#pragma unroll
            for (int ai = 0; ai < 2; ++ai)
#pragma unroll
                for (int m = 0; m < 4; ++m) { const GAS f32x4* t = (const GAS f32x4*)(rope + ((size_t)((row0 + ai * HALF + m * 16) & 2047) * 16 + 4 * fq) * 2); tr[ai][m][0] = t[0]; tr[ai][m][1] = t[1]; } }
        float rsv[2][4]; if (rsl) load_rs8_lds4(rsl, wr * 64 + fr, fq, 1.0f / 256.0f, 1e-6f, rsv); else load_rs8(ss_cq, 4, row0, fq, 1.0f / 256.0f, 1e-6f, rsv);
#pragma unroll
        for (int ai = 0; ai < 2; ++ai)
#pragma unroll
            for (int m = 0; m < 4; ++m) { const int row = row0 + ai * HALF + m * 16; const float rs = rsv[ai][m];
#pragma unroll
                for (int bj = 0; bj < 2; ++bj) { f32x4 v0 = acc[ai][bj][m][0] * rs, v1 = acc[ai][bj][m][1] * rs;
                    if (wc == 2) rope4v(v0, v1, tr[ai][m][0], tr[ai][m][1]);
                    *(GAS u32x4*)((GAS char*)q + ((unsigned)row * 1152u + (unsigned)((2 * u.pn + bj) * 96 + wc * 32 + 8 * fq) * 2u)) = pack8(v0, v1); } }
    }
};
__device__ __forceinline__ f32x4 unpk_lo(u32x4 p) { return (f32x4){__uint_as_float(p.x << 16), __uint_as_float(p.x & 0xffff0000u), __uint_as_float(p.y << 16), __uint_as_float(p.y & 0xffff0000u)}; }
__device__ __forceinline__ f32x4 unpk_hi(u32x4 p) { return (f32x4){__uint_as_float(p.z << 16), __uint_as_float(p.z & 0xffff0000u), __uint_as_float(p.w << 16), __uint_as_float(p.w & 0xffff0000u)}; }
struct EpiResid {
    static constexpr bool PERM = true, AFTER_DRAIN = false;
    static constexpr int RSNP = 0;
    const float* xin; bf16_t* xb; float* ss; float asc = 1.0f;
    __device__ __forceinline__ void operator()(const f32x4 (&acc)[2][2][4][2], const Unit& u, int wr, int wc, int fr, int fq) const {
        const int row0 = u.pm * BM + wr * 64 + fr, col0 = u.pn * BM + wc * 32 + 8 * fq;
        if (xin) {
            f32x4 pre[4][2][2];
#pragma unroll
            for (int m = 0; m < 4; ++m) { const unsigned oe = (unsigned)(row0 + m * 16) * 1024u + (unsigned)col0;
#pragma unroll
                for (int bj = 0; bj < 2; ++bj)
#pragma unroll
                    for (int n = 0; n < 2; ++n) pre[m][bj][n] = *(const GAS f32x4*)((const GAS char*)xin + (oe + bj * HALF + n * 4) * 4u); }
#pragma unroll
            for (int ai = 0; ai < 2; ++ai)
#pragma unroll
                for (int m = 0; m < 4; ++m) { const int row = row0 + ai * HALF + m * 16; const unsigned oe = (unsigned)row * 1024u + (unsigned)col0; float sq = 0.f;
                    f32x4 v[2][2];
#pragma unroll
                    for (int bj = 0; bj < 2; ++bj)
#pragma unroll
                        for (int n = 0; n < 2; ++n) v[bj][n] = pre[m][bj][n] + acc[ai][bj][m][n];
                    if (ai == 0) { const unsigned oe2 = oe + (unsigned)HALF * 1024u;
#pragma unroll
                        for (int bj = 0; bj < 2; ++bj)
#pragma unroll
                            for (int n = 0; n < 2; ++n) pre[m][bj][n] = *(const GAS f32x4*)((const GAS char*)xin + (oe2 + bj * HALF + n * 4) * 4u); }
#pragma unroll
                    for (int bj = 0; bj < 2; ++bj) { sq += dot4(v[bj][0]) + dot4(v[bj][1]); *(GAS u32x4*)((GAS char*)xb + (oe + bj * HALF) * 2u) = pack8(v[bj][0], v[bj][1]); }
                    if (ss) { const float s = red_fq(sq); if (fq == 0) *(GAS float*)((GAS char*)ss + ((unsigned)row * 64u + (unsigned)(4 * u.pn + wc) * 4u)) = s; } }
        } else {
            u32x4 pre[2][4][2];
#pragma unroll
            for (int ai = 0; ai < 2; ++ai)
#pragma unroll
                for (int m = 0; m < 4; ++m) { const unsigned ob = ((unsigned)(row0 + ai * HALF + m * 16) * 1024u + (unsigned)col0) * 2u;
#pragma unroll
                    for (int bj = 0; bj < 2; ++bj) pre[ai][m][bj] = *(const GAS u32x4*)((const GAS char*)xb + (ob + bj * HALF * 2)); }
#pragma unroll
            for (int ai = 0; ai < 2; ++ai)
#pragma unroll
                for (int m = 0; m < 4; ++m) { const int row = row0 + ai * HALF + m * 16; const unsigned ob = ((unsigned)row * 1024u + (unsigned)col0) * 2u; float sq = 0.f;
#pragma unroll
                    for (int bj = 0; bj < 2; ++bj) { const u32x4 p = pre[ai][m][bj]; const f32x4 v0 = unpk_lo(p) + acc[ai][bj][m][0] * asc, v1 = unpk_hi(p) + acc[ai][bj][m][1] * asc;
                        sq += dot4(v0) + dot4(v1); *(GAS u32x4*)((GAS char*)xb + (ob + bj * HALF * 2)) = pack8(v0, v1); }
                    if (ss) { const float s = red_fq(sq); if (fq == 0) *(GAS float*)((GAS char*)ss + ((unsigned)row * 64u + (unsigned)(4 * u.pn + wc) * 4u)) = s; } }
        }
    }
};
template <int PROBE = 0  , bool NORS = false  , int F8 = 0  > struct EpiSwiGLU_ {
    static constexpr bool PERM = true, AFTER_DRAIN = false;
    static constexpr int RSNP = NORS ? 0 : 16;
    bf16_t* act; const float* ss; int np; int nct; const PG8_LAS float* rsl = nullptr;
    __device__ __forceinline__ const float* rs_src(const Unit& u) const { return (ss && rsl) ? ss + (size_t)u.pm * BM * 16 : nullptr; }
    __device__ __forceinline__ void operator()(const f32x4 (&acc)[2][2][4][2], const Unit& u, int wr, int wc, int fr, int fq) const {
        const int row0 = u.pm * BM + wr * 64 + fr, col0 = (u.pn % nct) * 128 + wc * 32 + 8 * fq;
        float rsv[2][4];
        if (PROBE == 2 || !ss) {
#pragma unroll
            for (int ai = 0; ai < 2; ++ai)
#pragma unroll
                for (int m = 0; m < 4; ++m) rsv[ai][m] = PROBE == 2 ? 0.03f : 1.0f; }
        else if (rsl) load_rs8_lds(rsl, wr * 64 + fr, fq, 1.0f / 1024.0f, 1e-6f, rsv);
        else load_rs8(ss, np, row0, fq, 1.0f / 1024.0f, 1e-6f, rsv);
#pragma unroll
        for (int ai = 0; ai < 2; ++ai)
#pragma unroll
            for (int m = 0; m < 4; ++m) { const int row = row0 + ai * HALF + m * 16; const float rs = rsv[ai][m];
                f32x4 a[2];
#pragma unroll
                for (int n = 0; n < 2; ++n) {
                    if constexpr (F8 != 0) {
                        const float sg = F8 == 1 ? 1.0f / QS_GU : rs, ce = -1.4426950408889634f * sg, ci = F8 == 1 ? QS_GU * QS_GU / QS_ACT : __builtin_amdgcn_rcpf(sg * sg * QS_ACT), lci = F8 == 1 ? 8.0f : __builtin_amdgcn_logf(ci);
                        static_assert(F8 != 1 || QS_GU * QS_GU / QS_ACT == 256.0f, "log2 of the MoE scale constant");
                        const f32x4 G = acc[ai][0][m][n], U = acc[ai][1][m][n]; f32x4 t;
#pragma unroll
                        for (int j = 0; j < 4; ++j) t[j] = __builtin_amdgcn_exp2f(__builtin_fmaf(G[j], ce, lci));
                        t = t + ci;
#pragma unroll
                        for (int j = 0; j < 4; ++j) t[j] = __builtin_amdgcn_rcpf(t[j]);
                        a[n] = (G * U) * t; }
                    else { const f32x4 g = NORS ? acc[ai][0][m][n] : acc[ai][0][m][n] * rs, up = NORS ? acc[ai][1][m][n] : acc[ai][1][m][n] * rs;
#pragma unroll
                        for (int j = 0; j < 4; ++j) a[n][j] = g[j] * __builtin_amdgcn_rcpf(1.0f + __builtin_amdgcn_exp2f(-g[j] * 1.4426950408889634f)) * up[j]; } }
                if constexpr (F8 != 0) { v2u w8; w8.x = pk4f8(a[0][0], a[0][1], a[0][2], a[0][3]); w8.y = pk4f8(a[1][0], a[1][1], a[1][2], a[1][3]);
                    *(GAS v2u*)((GAS char*)act + ((unsigned)row * 2816u + (unsigned)col0)) = w8; }
                else { const u32x4 w = pack8(a[0], a[1]);
                    if (PROBE == 1) asm volatile("" :: "v"(w)); else *(GAS u32x4*)(act + (size_t)row * 2816 + col0) = w; } }
    }
};
typedef EpiSwiGLU_<0> EpiSwiGLU;
typedef EpiSwiGLU_<0, true> EpiSwiGLUn;
typedef EpiSwiGLU_<0, true, 1> EpiSwiGLU8;
typedef EpiSwiGLU_<0, false, 2> EpiSwiGLUd8;
struct EpiScatter {
    static constexpr bool PERM = true, AFTER_DRAIN = false;
    static constexpr int RSNP = 0;
    bf16_t* xb; bf16_t* y1; const int* list; const float* wgt; float wsc;
    __device__ __forceinline__ void operator()(const f32x4 (&acc)[2][2][4][2], const Unit& u, int wr, int wc, int fr, int fq) const {
        const int tr0 = wr * 64 + fr, col0 = (u.pn & 3) * BM + wc * 32 + 8 * fq; const unsigned y1off = (unsigned)((const char*)y1 - (const char*)xb);
        int tok[2][4]; float wg[2][4];
#pragma unroll
        for (int ai = 0; ai < 2; ++ai)
#pragma unroll
            for (int m = 0; m < 4; ++m) { const int tr = tr0 + ai * HALF + m * 16; const bool ok = tr < u.aux3; tok[ai][m] = ok ? ((const GAS int*)list)[u.aux2 + tr] : -1; wg[ai][m] = ok ? ((const GAS float*)wgt)[u.aux2 + tr] * wsc : 0.f; }
        u32x4 pre[2][4][2];
#pragma unroll
        for (int ai = 0; ai < 2; ++ai)
#pragma unroll
            for (int m = 0; m < 4; ++m) { const int tv = tok[ai][m]; const unsigned ob = ((unsigned)(tv < 0 ? 0 : (tv & 0xffff)) * 1024u + (unsigned)col0) * 2u;
#pragma unroll
                for (int bj = 0; bj < 2; ++bj) pre[ai][m][bj] = (tv >= 0 && (tv >> 16) == 0) ? *(const GAS u32x4*)((const GAS char*)xb + (ob + bj * HALF * 2)) : (u32x4){0u, 0u, 0u, 0u}; }
#pragma unroll
        for (int ai = 0; ai < 2; ++ai)
#pragma unroll
            for (int m = 0; m < 4; ++m) { const int tv = tok[ai][m]; const float w = wg[ai][m];
                if (tv >= 0) { const unsigned ob = ((unsigned)(tv & 0xffff) * 1024u + (unsigned)col0) * 2u + ((tv >> 16) == 0 ? 0u : y1off);
#pragma unroll
                    for (int bj = 0; bj < 2; ++bj) { const u32x4 p = pre[ai][m][bj];
                        *(GAS u32x4*)((GAS char*)xb + (ob + bj * HALF * 2)) = pack8(unpk_lo(p) + acc[ai][bj][m][0] * w, unpk_hi(p) + acc[ai][bj][m][1] * w); } } }
    }
};
struct RangeOrder : StaticOrder {
    int i0, i1;
    __device__ __forceinline__ bool next(int i, Unit& u) const { return (i0 + i < i1) && StaticOrder::next(i0 + i, u); }
};
struct FixedOrder : StaticOrder {
    __device__ __forceinline__ bool next(int i, Unit& u) const { const bool ok = StaticOrder::next(i, u); u.pm = 0; u.pn = 0; return ok; }
};
struct EpiNull {
    static constexpr bool PERM = true, AFTER_DRAIN = false;
    static constexpr int RSNP = 0;
    __device__ __forceinline__ void operator()(const f32x4 (&acc)[2][2][4][2], const Unit& u, int wr, int wc, int fr, int fq) const {
#pragma unroll
        for (int ai = 0; ai < 2; ++ai)
#pragma unroll
            for (int bj = 0; bj < 2; ++bj)
#pragma unroll
                for (int m = 0; m < 4; ++m)
#pragma unroll
                    for (int n = 0; n < 2; ++n) { f32x4 v = acc[ai][bj][m][n]; asm volatile("" :: "v"(v)); }
    }
};
struct MoeOrder {
    int nrt, nct, ta, G, c; const PG8_LAS int* P; const int* list;
    __device__ __forceinline__ bool next(int i, Unit& u) const {
        const long L = (long)i * G + c; const int nwg = nrt * nct; if (L >= nwg) return false;
        int wgid = (int)L; { const int q = nwg / NXCD, r = nwg % NXCD, xcd = wgid % NXCD, off = wgid / NXCD; wgid = (xcd < r ? xcd * (q + 1) : r * (q + 1) + (xcd - r) * q) + off; }
        const int nig = WGM * nct, gid = wgid / nig, fm = gid * WGM, gsz = (nrt - fm) < WGM ? (nrt - fm) : WGM;
        const int pm = fm + ((wgid % nig) % gsz), pn = (wgid % nig) / gsz;
        const int rt = ta + pm; int g = 0;
#pragma unroll
        for (int k = 1; k < 8; ++k) g += (P[k] <= rt) ? 1 : 0;
        const int j = rt - P[g], left = P[20 + g] - j * BM;
        u.pm = pm; u.pn = g * nct + pn; u.aux = 0; u.aux2 = g * 65536 + j * BM; u.aux3 = left < BM ? left : BM; return true;
    }
    __device__ __forceinline__ const int* row_ptr(const Unit& u) const { return list + u.aux2; }
    __device__ __forceinline__ int row_tok(const Unit& u, int r) const { return r < u.aux3 ? (((const GAS int*)list)[u.aux2 + r] & 0xffff) : 0; }
    __device__ __forceinline__ void a_ready(const Unit&) const {}
    __device__ __forceinline__ void done(const Unit&) const {}
};
}

namespace att {
using bf16x8 = __attribute__((ext_vector_type(8))) short;
using s16x4 = __attribute__((ext_vector_type(4))) short;
using f32x16 = __attribute__((ext_vector_type(16))) float;
using u32x4 = __attribute__((ext_vector_type(4))) unsigned;
typedef __attribute__((address_space(3))) const char* lds_cptr;
typedef __attribute__((address_space(3))) char* lds_ptr;
typedef short v4i16_t __attribute__((ext_vector_type(4)));
typedef unsigned short bf16;
#define LAS3 __attribute__((address_space(3)))
__device__ __forceinline__ int crow(int r, int hi) { return (r & 3) + 8 * (r >> 2) + 4 * hi; }
__device__ __forceinline__ void glds16(const void* sbase, unsigned voff, unsigned lds_dst) { unsigned keep;
    asm volatile("s_mov_b32 %0, m0\n\ts_mov_b32 m0, %3\n\ts_nop 0\n\tglobal_load_lds_dwordx4 %1, %2\n\ts_mov_b32 m0, %0" : "=&s"(keep) : "v"(voff), "s"(sbase), "s"(lds_dst) : "memory"); }
__device__ __forceinline__ s16x4 vtr(lds_cptr p) { return __builtin_bit_cast(s16x4, __builtin_amdgcn_ds_read_tr16_b64_v4i16((LAS3 v4i16_t*)p)); }
typedef float f32x2_t __attribute__((ext_vector_type(2))); typedef __bf16 bf16x2_t __attribute__((ext_vector_type(2)));
__device__ __forceinline__ unsigned cvtpk(float lo, float hi) { f32x2_t v = {lo, hi}; bf16x2_t b = __builtin_convertvector(v, bf16x2_t); return __builtin_bit_cast(unsigned, b); }
#define MFMA(a, b, c) __builtin_amdgcn_mfma_f32_32x32x16_bf16(a, b, c, 0, 0, 0)
#define SBAR() __builtin_amdgcn_sched_barrier(0)
#define PIN(x) asm volatile("" : "+v"(x))
#define EX(v) __builtin_amdgcn_exp2f(v)
#define WAIT_BAR0() asm volatile("s_waitcnt vmcnt(0) lgkmcnt(0)\n\ts_barrier" ::: "memory")
#define WAIT_BARN(N) asm volatile("s_waitcnt vmcnt(" #N ") lgkmcnt(0)\n\ts_barrier" ::: "memory")
#define MX3(a, b, c) __builtin_fmaxf(__builtin_fmaxf((a), (b)), (c))
#define PAF(k) __builtin_bit_cast(bf16x8, pw##k)
#define VFR(i) (bf16x8){vlo[i][0], vlo[i][1], vlo[i][2], vlo[i][3], vhi[i][0], vhi[i][1], vhi[i][2], vhi[i][3]}
__device__ __forceinline__ float rowmax(const f32x16& p0, const f32x16& p1) {
    float a = MX3(p0[0], p0[1], p1[0]), b = MX3(p0[2], p0[3], p1[1]); a = MX3(a, p1[2], p1[3]);
#pragma unroll
    for (int r = 4; r < 16; r += 4) { a = MX3(a, p0[r], p0[r + 1]); b = MX3(b, p0[r + 2], p0[r + 3]); a = MX3(a, p1[r], p1[r + 1]); b = MX3(b, p1[r + 2], p1[r + 3]); }
    float m = __builtin_fmaxf(a, b); auto rr = __builtin_amdgcn_permlane32_swap(__float_as_uint(m), __float_as_uint(m), false, false);
    return __builtin_fmaxf(__uint_as_float(rr[0]), __uint_as_float(rr[1])); }
__device__ __forceinline__ float big_shift(float sacc) {
    auto rr = __builtin_amdgcn_permlane32_swap(__float_as_uint(sacc), __float_as_uint(sacc), false, false);
    const float m = __builtin_fmaxf(__uint_as_float(rr[0]), __uint_as_float(rr[1]));
    return m > 1073741824.0f ? (float)((int)(__float_as_uint(m) >> 23) - 127) : 0.f;
}
__device__ __forceinline__ float halfsum(float v) { auto rr = __builtin_amdgcn_permlane32_swap(__float_as_uint(v), __float_as_uint(v), false, false); return __uint_as_float(rr[0]) + __uint_as_float(rr[1]); }
__device__ __forceinline__ void cmask(f32x16& p0, f32x16& p1, int jb, int qrel, int hi) {
    const int kb = 64 * jb + 4 * hi;
#pragma unroll
    for (int r = 0; r < 16; ++r) { const int kv = kb + (r & 3) + 8 * (r >> 2); if (kv > qrel) p0[r] = -INFINITY; if (kv + 32 > qrel) p1[r] = -INFINITY; } }
__device__ __forceinline__ void store_o(const f32x16& v0, const f32x16& v1, LAS3 bf16* stg, bf16* Ow, int op, int lane, int r32, int hi) {
#pragma unroll
    for (int r = 0; r < 16; ++r) { const int orow = crow(r, hi);
        stg[orow * 64 + r32] = (bf16)(cvtpk(v0[r], 0.f) & 0xffffu); stg[orow * 64 + 32 + r32] = (bf16)(cvtpk(v1[r], 0.f) & 0xffffu); }
    asm volatile("s_waitcnt lgkmcnt(0)" ::: "memory");
#pragma unroll
    for (int i = 0; i < 4; ++i) { const int row = i * 8 + (lane >> 3), ch = lane & 7; const u32x4 v = *(const LAS3 u32x4*)(stg + row * 64 + ch * 8); *(GAS u32x4*)(Ow + (size_t)row * op + ch * 8) = v; }
    asm volatile("s_waitcnt lgkmcnt(0)" ::: "memory");
}
#define MLA_STEP(C0, C1, P0, P1, t) do { SBAR(); \
    const int sl_knext = (((t) + 1) & 3) * KS; const lds_cptr vp_ = vp0 + (((t) - 1) & 3) * VS; const lds_cptr kr_ = kp0 + ((t) & 3) * KS + 8192; \
    float sacc = (P0[0] + P0[1]); \
    C0 = MFMA(kf[0], qr[0], negm); sacc += P0[2]; sacc += P0[3]; sacc += P0[4]; PIN(sacc); pw0[0] = cvtpk(P0[0], P0[1]); pw0[1] = cvtpk(P0[2], P0[3]); PIN(pw0); SBAR(); \
    C1 = MFMA(kf[1], qr[0], negm); sacc += P0[5]; sacc += P0[6]; sacc += P0[7]; PIN(sacc); pw0[2] = cvtpk(P0[4], P0[5]); pw0[3] = cvtpk(P0[6], P0[7]); PIN(pw0); SBAR(); \
    C0 = MFMA(kf[2], qr[1], C0); sacc += P0[8]; sacc += P0[9]; sacc += P0[10]; PIN(sacc); pw1[0] = cvtpk(P0[8], P0[9]); PIN(pw1); SBAR(); \
    C1 = MFMA(kf[3], qr[1], C1); sacc += P0[11]; sacc += P0[12]; sacc += P0[13]; PIN(sacc); pw1[1] = cvtpk(P0[10], P0[11]); PIN(pw1); SBAR(); \
    kf[0] = *(const LAS3 bf16x8*)(kr_ + 0); SBAR(); C0 = MFMA(kf[4], qr[2], C0); sacc += P0[14]; sacc += P0[15]; sacc += P1[0]; PIN(sacc); pw1[2] = cvtpk(P0[12], P0[13]); PIN(pw1); SBAR(); \
    kf[1] = *(const LAS3 bf16x8*)(kr_ + 512); SBAR(); C1 = MFMA(kf[5], qr[2], C1); sacc += P1[1]; sacc += P1[2]; sacc += P1[3]; PIN(sacc); pw1[3] = cvtpk(P0[14], P0[15]); PIN(pw1); SBAR(); \
    kf[2] = *(const LAS3 bf16x8*)(kr_ + 2048); SBAR(); C0 = MFMA(kf[6], qr[3], C0); sacc += P1[4]; sacc += P1[5]; PIN(sacc); pw2[0] = cvtpk(P1[0], P1[1]); pw2[1] = cvtpk(P1[2], P1[3]); PIN(pw2); SBAR(); \
    kf[3] = *(const LAS3 bf16x8*)(kr_ + 2560); SBAR(); C1 = MFMA(kf[7], qr[3], C1); sacc += P1[6]; sacc += P1[7]; PIN(sacc); pw2[2] = cvtpk(P1[4], P1[5]); pw2[3] = cvtpk(P1[6], P1[7]); PIN(pw2); SBAR(); \
    C0 = MFMA(kf[0], qr[4], C0); sacc += P1[8]; sacc += P1[9]; PIN(sacc); pw3[0] = cvtpk(P1[8], P1[9]); PIN(pw3); SBAR(); \
    C1 = MFMA(kf[1], qr[4], C1); sacc += P1[10]; sacc += P1[11]; PIN(sacc); pw3[1] = cvtpk(P1[10], P1[11]); PIN(pw3); SBAR(); \
    if (PROBE != 4) { vlo[0] = vtr(vp_ + 0); vhi[0] = vtr(vp_ + 512); } SBAR(); C0 = MFMA(kf[2], qr[5], C0); sacc += P1[12]; sacc += P1[13]; PIN(sacc); pw3[2] = cvtpk(P1[12], P1[13]); PIN(pw3); SBAR(); \
    if (PROBE != 4) { vlo[4] = vtr(vp_ + 4096); vhi[4] = vtr(vp_ + 4608); } SBAR(); C1 = MFMA(kf[3], qr[5], C1); sacc += P1[14]; sacc += P1[15]; PIN(sacc); pw3[3] = cvtpk(P1[14], P1[15]); PIN(pw3); SBAR(); \
    l_reg += sacc; \
    if ((t) - (NT - 4) >= (wid >> 1)) cmask(C0, C1, (t) - (NT - 4), qrel, hi); \
    MLA_DECIDE(C0, C1); SBAR(); MLA_MIDBAR(); SBAR(); \
    if (PROBE != 4) { vlo[1] = vtr(vp_ + 1024); vhi[1] = vtr(vp_ + 1536); } SBAR(); if (PROBE != 6) o[0] = MFMA(PAF(0), VFR(0), o[0]); C0[0] = MEX(C0[0]); C0[1] = MEX(C0[1]); C0[2] = MEX(C0[2]); C0[3] = MEX(C0[3]); PIN(C0); SBAR(); \
    if (PROBE != 4) { vlo[5] = vtr(vp_ + 5120); vhi[5] = vtr(vp_ + 5632); } SBAR(); if (PROBE != 5) { kf[0] = *(const LAS3 bf16x8*)(kp0 + sl_knext + 0); kf[1] = *(const LAS3 bf16x8*)(kp0 + sl_knext + 512); } SBAR(); if (PROBE != 6) o[1] = MFMA(PAF(0), VFR(4), o[1]); C0[4] = MEX(C0[4]); C0[5] = MEX(C0[5]); C0[6] = MEX(C0[6]); C0[7] = MEX(C0[7]); PIN(C0); SBAR(); \
    if (PROBE != 4) { vlo[2] = vtr(vp_ + 2048); vhi[2] = vtr(vp_ + 2560); } SBAR(); if (PROBE != 5) { kf[2] = *(const LAS3 bf16x8*)(kp0 + sl_knext + 2048); kf[3] = *(const LAS3 bf16x8*)(kp0 + sl_knext + 2560); } SBAR(); if (PROBE != 6) o[0] = MFMA(PAF(1), VFR(1), o[0]); C0[8] = MEX(C0[8]); C0[9] = MEX(C0[9]); C0[10] = MEX(C0[10]); C0[11] = MEX(C0[11]); PIN(C0); SBAR(); \
    if (PROBE != 4) { vlo[6] = vtr(vp_ + 6144); vhi[6] = vtr(vp_ + 6656); } SBAR(); if (PROBE != 5) { kf[4] = *(const LAS3 bf16x8*)(kp0 + sl_knext + 4096); kf[5] = *(const LAS3 bf16x8*)(kp0 + sl_knext + 4608); } SBAR(); if (PROBE != 6) o[1] = MFMA(PAF(1), VFR(5), o[1]); C0[12] = MEX(C0[12]); C0[13] = MEX(C0[13]); C0[14] = MEX(C0[14]); C0[15] = MEX(C0[15]); PIN(C0); SBAR(); \
    if (PROBE != 4) { vlo[3] = vtr(vp_ + 3072); vhi[3] = vtr(vp_ + 3584); } SBAR(); if (PROBE != 5) { kf[6] = *(const LAS3 bf16x8*)(kp0 + sl_knext + 6144); kf[7] = *(const LAS3 bf16x8*)(kp0 + sl_knext + 6656); } SBAR(); if (PROBE != 6) o[0] = MFMA(PAF(2), VFR(2), o[0]); C1[0] = MEX(C1[0]); C1[1] = MEX(C1[1]); C1[2] = MEX(C1[2]); C1[3] = MEX(C1[3]); PIN(C1); SBAR(); \
    if (PROBE != 4) { vlo[7] = vtr(vp_ + 7168); vhi[7] = vtr(vp_ + 7680); } SBAR(); if (PROBE != 6) o[1] = MFMA(PAF(2), VFR(6), o[1]); C1[4] = MEX(C1[4]); C1[5] = MEX(C1[5]); C1[6] = MEX(C1[6]); C1[7] = MEX(C1[7]); PIN(C1); SBAR(); \
    if (PROBE != 6) o[0] = MFMA(PAF(3), VFR(3), o[0]); C1[8] = MEX(C1[8]); C1[9] = MEX(C1[9]); C1[10] = MEX(C1[10]); C1[11] = MEX(C1[11]); PIN(C1); SBAR(); \
    if (PROBE != 6) o[1] = MFMA(PAF(3), VFR(7), o[1]); C1[12] = MEX(C1[12]); C1[13] = MEX(C1[13]); C1[14] = MEX(C1[14]); C1[15] = MEX(C1[15]); PIN(C1); SBAR(); \
    } while (0)

#define DIFF_STEP(C0, C1, P0, P1, OP, MP, t, VSL, KNEXT, KND0, NMH, TBN, HASPREV, FIRST) do { SBAR(); \
    const lds_cptr vp_ = vp0 + (VSL); float sacc = 0.f; \
    C0 = MFMA(kx0, QXF(), (f32x16){}); if (HASPREV) { sacc += P0[0]; sacc += P0[1]; sacc += P0[2]; sacc += P0[3]; sacc += P0[4]; sacc += P0[5]; PIN(sacc); pw0[0] = cvtpk(P0[0], P0[1]); pw0[1] = cvtpk(P0[2], P0[3]); pw0[2] = cvtpk(P0[4], P0[5]); PIN(pw0); } SBAR(); \
    C1 = MFMA(kx1, QXF(), (f32x16){}); if (HASPREV) { sacc += P0[6]; sacc += P0[7]; sacc += P0[8]; sacc += P0[9]; sacc += P0[10]; sacc += P0[11]; PIN(sacc); pw0[3] = cvtpk(P0[6], P0[7]); pw1[0] = cvtpk(P0[8], P0[9]); pw1[1] = cvtpk(P0[10], P0[11]); PIN(pw0); PIN(pw1); } SBAR(); \
    C0 = MFMA(kf[0], qr[2 * (MP)], C0); if (HASPREV) { sacc += P0[12]; sacc += P0[13]; sacc += P0[14]; sacc += P0[15]; sacc += P1[0]; PIN(sacc); pw1[2] = cvtpk(P0[12], P0[13]); pw1[3] = cvtpk(P0[14], P0[15]); pw2[0] = cvtpk(P1[0], P1[1]); PIN(pw1); PIN(pw2); } SBAR(); \
    C1 = MFMA(kf[1], qr[2 * (MP)], C1); if (HASPREV) { sacc += P1[1]; sacc += P1[2]; sacc += P1[3]; sacc += P1[4]; sacc += P1[5]; PIN(sacc); pw2[1] = cvtpk(P1[2], P1[3]); pw2[2] = cvtpk(P1[4], P1[5]); pw2[3] = cvtpk(P1[6], P1[7]); PIN(pw2); } SBAR(); \
    if (HASPREV) { vlo[0] = vtr(vp_ + 0); vhi[0] = vtr(vp_ + 512); } SBAR(); C0 = MFMA(kf[2], qr[2 * (MP) + 1], C0); if (HASPREV) { sacc += P1[6]; sacc += P1[7]; sacc += P1[8]; sacc += P1[9]; sacc += P1[10]; PIN(sacc); pw3[0] = cvtpk(P1[8], P1[9]); pw3[1] = cvtpk(P1[10], P1[11]); PIN(pw3); } SBAR(); \
    if (HASPREV) { vlo[4] = vtr(vp_ + 4096); vhi[4] = vtr(vp_ + 4608); } SBAR(); C1 = MFMA(kf[3], qr[2 * (MP) + 1], C1); if (HASPREV) { sacc += P1[11]; sacc += P1[12]; sacc += P1[13]; sacc += P1[14]; sacc += P1[15]; PIN(sacc); pw3[2] = cvtpk(P1[12], P1[13]); pw3[3] = cvtpk(P1[14], P1[15]); PIN(pw3); } SBAR(); \
    if (HASPREV) { if ((MP) == 0) l2 += sacc; else l1 += sacc; } \
    if ((t) - (NT - 4) >= (wid >> 1)) cmask(C0, C1, (t) - (NT - 4), qrel, hi); \
    DIFF_DECIDE(C0, C1, MP, FIRST, HASPREV); SBAR(); \
    if (HASPREV) { vlo[1] = vtr(vp_ + 1024); vhi[1] = vtr(vp_ + 1536); } SBAR(); if (HASPREV) OP[0] = MFMA(PAF(0), VFR(0), OP[0]); C0[0] = EX(C0[0]); C0[1] = EX(C0[1]); C0[2] = EX(C0[2]); C0[3] = EX(C0[3]); PIN(C0); QX_SET((TBN) - (NMH)); SBAR(); \
    if (HASPREV) { vlo[5] = vtr(vp_ + 5120); vhi[5] = vtr(vp_ + 5632); } SBAR(); kf[0] = *(const LAS3 bf16x8*)(kp0 + (KNEXT) + ((KND0) + 0) * 2048 + 0); SBAR(); if (HASPREV) OP[1] = MFMA(PAF(0), VFR(4), OP[1]); C0[4] = EX(C0[4]); C0[5] = EX(C0[5]); C0[6] = EX(C0[6]); C0[7] = EX(C0[7]); PIN(C0); SBAR(); \
    if (HASPREV) { vlo[2] = vtr(vp_ + 2048); vhi[2] = vtr(vp_ + 2560); } SBAR(); kf[1] = *(const LAS3 bf16x8*)(kp0 + (KNEXT) + ((KND0) + 0) * 2048 + 512); SBAR(); if (HASPREV) OP[0] = MFMA(PAF(1), VFR(1), OP[0]); C0[8] = EX(C0[8]); C0[9] = EX(C0[9]); C0[10] = EX(C0[10]); C0[11] = EX(C0[11]); PIN(C0); SBAR(); \
    if (HASPREV) { vlo[6] = vtr(vp_ + 6144); vhi[6] = vtr(vp_ + 6656); } SBAR(); kf[2] = *(const LAS3 bf16x8*)(kp0 + (KNEXT) + ((KND0) + 1) * 2048 + 0); SBAR(); if (HASPREV) OP[1] = MFMA(PAF(1), VFR(5), OP[1]); C0[12] = EX(C0[12]); C0[13] = EX(C0[13]); C0[14] = EX(C0[14]); C0[15] = EX(C0[15]); PIN(C0); SBAR(); \
    if (HASPREV) { vlo[3] = vtr(vp_ + 3072); vhi[3] = vtr(vp_ + 3584); } SBAR(); kf[3] = *(const LAS3 bf16x8*)(kp0 + (KNEXT) + ((KND0) + 1) * 2048 + 512); SBAR(); if (HASPREV) OP[0] = MFMA(PAF(2), VFR(2), OP[0]); C1[0] = EX(C1[0]); C1[1] = EX(C1[1]); C1[2] = EX(C1[2]); C1[3] = EX(C1[3]); PIN(C1); SBAR(); \
    if (HASPREV) { vlo[7] = vtr(vp_ + 7168); vhi[7] = vtr(vp_ + 7680); } SBAR(); if (HASPREV) OP[1] = MFMA(PAF(2), VFR(6), OP[1]); C1[4] = EX(C1[4]); C1[5] = EX(C1[5]); C1[6] = EX(C1[6]); C1[7] = EX(C1[7]); PIN(C1); SBAR(); \
    if (HASPREV) OP[0] = MFMA(PAF(3), VFR(3), OP[0]); C1[8] = EX(C1[8]); C1[9] = EX(C1[9]); C1[10] = EX(C1[10]); C1[11] = EX(C1[11]); PIN(C1); SBAR(); \
    if (HASPREV) OP[1] = MFMA(PAF(3), VFR(7), OP[1]); C1[12] = EX(C1[12]); C1[13] = EX(C1[13]); C1[14] = EX(C1[14]); C1[15] = EX(C1[15]); PIN(C1); SBAR(); \
    if (rescd) { asm volatile("s_waitcnt lgkmcnt(0)" ::: "memory"); _Pragma("unroll") for (int r = 0; r < 16; ++r) { const float g_ = wsf[crow(r, hi)]; OP[0][r] *= g_; OP[1][r] *= g_; } asm volatile("s_waitcnt lgkmcnt(0)" ::: "memory"); } \
    } while (0)


constexpr int MLA_KS = 12288, MLA_VS = 8192, MLA_LV = 4 * MLA_KS, MLA_WS = MLA_LV + 4 * MLA_VS, MLA_OST = MLA_WS + 8 * 256, MLA_LDS = MLA_OST + 8 * 4096;
constexpr int DIF_KS = 8192, DIF_VS = 8192, DIF_LV = 4 * DIF_KS, DIF_WS = DIF_LV + 4 * DIF_VS, DIF_OST = DIF_WS + 8 * 256, DIF_LDS = DIF_OST + 8 * 4096;
constexpr int ATT_LDS_BYTES = MLA_LDS > DIF_LDS ? MLA_LDS : DIF_LDS;

struct UnitId { int qb, b, h, t0; };
struct MlaT { const bf16* q; const bf16* kv; const bf16* kr; bf16* cat; };
struct DiffT { const bf16* proj; bf16* cat; };
#define MLA_QH(T, D) ((T).q + (size_t)(D).b * 2048 * 576 + (D).h * 96)
#define MLA_KH(T, D) ((T).kv + (size_t)(D).b * 2048 * 768 + (D).h * 128)
#define MLA_KRH(T, D) ((T).kr + (size_t)(D).b * 2048 * 32)
#define MLA_VH(T, D) ((T).kv + (size_t)(D).b * 2048 * 768 + (D).h * 128 + 64)
#define MLA_OH(T, D) ((T).cat + (size_t)(D).b * 2048 * 1024 + 256 + (D).h * 64)
#define DIF_QH(T, D) ((T).proj + (size_t)(D).b * 2048 * 2304 + 1024 + (D).h * 64)
#define DIF_KH(T, D) ((T).proj + ((size_t)(D).b * 2048 + (size_t)(D).t0 * 64) * 2304 + 1408 + (D).h * 64)
#define DIF_VH(T, D) ((T).proj + ((size_t)(D).b * 2048 + (size_t)(D).t0 * 64) * 2304 + 1792 + (D).h * 64)
#define DIF_OH(T, D) ((T).cat + (size_t)(D).b * 2048 * 1024 + 640 + (D).h * 64)

template <int THRL, int PROBE = 0  >
__device__ __forceinline__ void mla_unit(const MlaT& T, const UnitId& U, bool first, bool has_next, const UnitId& UN, bf16x8 (&qr)[6], lds_ptr shm, int tid_in) {
    int tid = tid_in; asm volatile("" : "+v"(tid));
    constexpr int QP = 576, KP = 768, VP = 768, OP = 1024, KS = MLA_KS, VS = MLA_VS;
    const int lane = tid & 63, r32 = lane & 31, hi = lane >> 5; const int wid = __builtin_amdgcn_readfirstlane(tid >> 6);
    const int q0 = U.qb * 256, NT = (q0 + 256) / 64;
    const int tl = NT - 1;
    const bool h2 = wid >= 4;
    const unsigned lds0 = (unsigned)(uintptr_t)shm;
    LAS3 float* wsf = (LAS3 float*)(shm + MLA_WS) + wid * 64;
    const unsigned koff = PROBE == 7 ? (unsigned)((wid * 8 + (lane >> 3)) * KP + (lane & 7) * 8) * 2u : (unsigned)(lane * KP + wid * 8) * 2u;
    const unsigned kroff = (unsigned)(lane * 32 + (wid & 3) * 8) * 2u;
    const unsigned voff = (unsigned)((16 * (wid & 3) + (lane >> 2)) * VP + (wid >> 2) * 32 + (lane & 3) * 8) * 2u;
    const unsigned kdst = lds0 + wid * 1024, krdst = lds0 + (8 + (wid & 3)) * 1024, vdst = lds0 + MLA_LV + wid * 1024;
#define DMA_K_(D, t, off) do { glds16(MLA_KH(T, D) + (size_t)(t) * 64 * KP, koff, (unsigned)__builtin_amdgcn_readfirstlane(kdst + (off))); glds16(MLA_KRH(T, D) + (size_t)(t) * 64 * 32, kroff, (unsigned)__builtin_amdgcn_readfirstlane(krdst + (off))); } while (0)
#define DMA_V_(D, t, off) glds16(MLA_VH(T, D) + (size_t)(t) * 64 * VP, voff, (unsigned)__builtin_amdgcn_readfirstlane(vdst + (off)))
#define DMA_K(t, off) DMA_K_(U, t, off)
#define DMA_V(t, off) DMA_V_(U, t, off)
#define LOAD_Q(D) do { const bf16* Qw_ = MLA_QH(T, D) + (size_t)((D).qb * 256 + wid * 32) * QP; _Pragma("unroll") for (int d0 = 0; d0 < 6; ++d0) qr[d0] = *(const GAS bf16x8*)(Qw_ + (size_t)r32 * QP + d0 * 16 + hi * 8); } while (0)
    const lds_cptr vp0 = (lds_cptr)shm + MLA_LV + ((lane >> 4) & 1) * 32 + (lane & 3) * 8 + (4 * hi + ((lane & 15) >> 2)) * 64;
    const lds_cptr kp0 = (lds_cptr)shm + hi * 1024 + r32 * 16;
    if (first) { DMA_K(0, 0); DMA_V(0, 0); DMA_K(1, KS); DMA_V(1, VS); DMA_K(2, 2 * KS); LOAD_Q(U); }
    float mhat = 0.f, l_reg = 0.f; f32x16 o[2]; o[0] = f32x16{}; o[1] = f32x16{}; f32x16 negm = f32x16{}; PIN(negm);
    const int qrel = wid * 32 + r32; bool resc = false;
    f32x16 pA0, pA1, pB0, pB1; bf16x8 kf[8]; s16x4 vlo[8], vhi[8]; u32x4 pw0, pw1, pw2, pw3;
    if (PROBE >= 4) { _Pragma("unroll") for (int i = 0; i < 8; ++i) { vlo[i] = s16x4{}; vhi[i] = s16x4{}; } }
    WAIT_BAR0();
    DMA_K(3, 3 * KS); DMA_V(2, 2 * VS);
    { pA0 = negm; pA1 = negm;
#pragma unroll
      for (int d0 = 0; d0 < 6; ++d0) { const bf16x8 k0 = *(const LAS3 bf16x8*)(kp0 + d0 * 2048), k1 = *(const LAS3 bf16x8*)(kp0 + d0 * 2048 + 512); pA0 = MFMA(k0, qr[d0], pA0); pA1 = MFMA(k1, qr[d0], pA1); }
      if (NT == 4) cmask(pA0, pA1, 0, qrel, hi);
      const float rm = rowmax(pA0, pA1); mhat = rm;
#pragma unroll
      for (int r = 0; r < 16; ++r) { pA0[r] = EX(pA0[r] - rm); pA1[r] = EX(pA1[r] - rm); negm[r] = -mhat; }
      PIN(negm); }
#pragma unroll
    for (int d0 = 0; d0 < 4; ++d0) { kf[2 * d0] = *(const LAS3 bf16x8*)(kp0 + KS + d0 * 2048); kf[2 * d0 + 1] = *(const LAS3 bf16x8*)(kp0 + KS + d0 * 2048 + 512); }
    WAIT_BAR0();
    if (NT > 4) DMA_K(4, 0);
    if (h2) DMA_V(3, 3 * VS);
#define MEX(v) (PROBE == 1 ? (v) : EX(v))
#define MLA_MIDBAR() asm volatile("s_barrier" ::: "memory")
#define MLA_DECIDE(C0, C1) do { const float dl = big_shift(sacc); resc = false; \
        if (__builtin_expect(__any(dl > 0.f), 0)) { mhat += dl; \
            _Pragma("unroll") for (int r = 0; r < 16; ++r) { C0[r] -= dl; C1[r] -= dl; } \
            _Pragma("unroll") for (int r = 0; r < 16; ++r) negm[r] = -mhat; PIN(negm); \
            const float f = EX(-dl); l_reg *= f; if (hi == 0) wsf[r32] = f; resc = true; } } while (0)
#define MLA_RESC() do { if (resc) { asm volatile("s_waitcnt lgkmcnt(0)" ::: "memory"); _Pragma("unroll") for (int r = 0; r < 16; ++r) { const float f = wsf[crow(r, hi)]; o[0][r] *= f; o[1][r] *= f; } resc = false; } } while (0)
#define MLA_END(t) do { WAIT_BAR0(); MLA_RESC(); \
        if ((t) + 4 < NT) DMA_K((t) + 4, (((t) + 4) & 3) * KS); \
        if (h2) { if ((t) + 3 < NT) DMA_V((t) + 3, (((t) + 3) & 3) * VS); } else { if ((t) + 2 < NT && (t) >= 1) DMA_V((t) + 2, (((t) + 2) & 3) * VS); } } while (0)
#define MLA_DRAIN(P0, P1) do { float sacc = 0.f; \
      _Pragma("unroll") for (int r = 0; r < 16; ++r) sacc += P0[r] + P1[r]; \
      l_reg += sacc; \
      pw0 = (u32x4){cvtpk(P0[0], P0[1]), cvtpk(P0[2], P0[3]), cvtpk(P0[4], P0[5]), cvtpk(P0[6], P0[7])}; pw1 = (u32x4){cvtpk(P0[8], P0[9]), cvtpk(P0[10], P0[11]), cvtpk(P0[12], P0[13]), cvtpk(P0[14], P0[15])}; \
      pw2 = (u32x4){cvtpk(P1[0], P1[1]), cvtpk(P1[2], P1[3]), cvtpk(P1[4], P1[5]), cvtpk(P1[6], P1[7])}; pw3 = (u32x4){cvtpk(P1[8], P1[9]), cvtpk(P1[10], P1[11]), cvtpk(P1[12], P1[13]), cvtpk(P1[14], P1[15])}; \
      const lds_cptr vp_ = vp0 + (tl & 3) * VS; \
      _Pragma("unroll") for (int i = 0; i < 8; ++i) { vlo[i] = vtr(vp_ + (i >> 2) * 4096 + (i & 3) * 1024); vhi[i] = vtr(vp_ + (i >> 2) * 4096 + (i & 3) * 1024 + 512); } \
      o[0] = MFMA(PAF(0), VFR(0), o[0]); o[1] = MFMA(PAF(0), VFR(4), o[1]); o[0] = MFMA(PAF(1), VFR(1), o[0]); o[1] = MFMA(PAF(1), VFR(5), o[1]); \
      o[0] = MFMA(PAF(2), VFR(2), o[0]); o[1] = MFMA(PAF(2), VFR(6), o[1]); o[0] = MFMA(PAF(3), VFR(3), o[0]); o[1] = MFMA(PAF(3), VFR(7), o[1]); } while (0)
#define MLA_EPI() do { l_reg = halfsum(l_reg); \
      int le = lane; asm volatile("" : "+v"(le)); const int r32e = le & 31, hie = le >> 5; \
      if (hie == 0) wsf[32 + r32e] = 1.0f / l_reg; \
      asm volatile("s_waitcnt lgkmcnt(0)" ::: "memory"); \
      f32x16 v0, v1; \
      _Pragma("unroll") for (int r = 0; r < 16; ++r) { const float f = wsf[32 + crow(r, hie)]; v0[r] = o[0][r] * f; v1[r] = o[1][r] * f; } \
      store_o(v0, v1, (LAS3 bf16*)(shm + MLA_OST) + wid * 2048, MLA_OH(T, U) + (size_t)(q0 + wid * 32) * OP, OP, le, r32e, hie); } while (0)
    if (h2) MLA_MIDBAR();
    int t = 1;
    for (; t + 1 <= tl; t += 2) {
        MLA_STEP(pB0, pB1, pA0, pA1, t); MLA_END(t);
        MLA_STEP(pA0, pA1, pB0, pB1, t + 1); MLA_END(t + 1);
    }
    MLA_STEP(pB0, pB1, pA0, pA1, tl);
    if (!h2) MLA_MIDBAR();
    WAIT_BAR0();
    if (has_next) { DMA_K_(UN, 0, 0); DMA_V_(UN, 0, 0); DMA_K_(UN, 1, KS); DMA_V_(UN, 1, VS); DMA_K_(UN, 2, 2 * KS); LOAD_Q(UN); }
    MLA_RESC();
    MLA_DRAIN(pB0, pB1);
    MLA_EPI();
#undef DMA_K_
#undef DMA_V_
#undef DMA_K
#undef DMA_V
#undef LOAD_Q
#undef MEX
#undef MLA_MIDBAR
#undef MLA_DECIDE
#undef MLA_RESC
#undef MLA_END
#undef MLA_DRAIN
#undef MLA_EPI
}

template <int THRL>
__device__ __forceinline__ void diff_unit(const DiffT& T, const UnitId& U, bool first, bool has_next, const UnitId& UN, bf16x8 (&qr)[4], float lam, lds_ptr shm, int tid_in) {
    int tid = tid_in; asm volatile("" : "+v"(tid));
    constexpr int PP = 2304, OP = 1024, KS = DIF_KS, VS = DIF_VS;
    const int lane = tid & 63, r32 = lane & 31, hi = lane >> 5; const int wid = __builtin_amdgcn_readfirstlane(tid >> 6);
    const int q0 = U.qb * 256, NT = (q0 + 256) / 64 - U.t0, kz = 64 * U.t0;
    const int tl = NT - 4 + (wid >> 1);
    const float slope2 = exp2f(-8.0f * (float)(U.h + 1) / 6.0f) * 1.4426950408889634f;
    const unsigned lds0 = (unsigned)(uintptr_t)shm;
    LAS3 float* wsf = (LAS3 float*)(shm + DIF_WS) + wid * 64;
    const unsigned koff = (unsigned)(lane * PP + wid * 8) * 2u;
    const unsigned voff = (unsigned)((16 * (wid & 3) + (lane >> 2)) * PP + (wid >> 2) * 32 + (lane & 3) * 8) * 2u;
    const unsigned kdst = lds0 + wid * 1024, vdst = lds0 + DIF_LV + wid * 1024;
#define DMA_K_(D, t, off) glds16(DIF_KH(T, D) + (size_t)(t) * 64 * PP, koff, (unsigned)__builtin_amdgcn_readfirstlane(kdst + (off)))
#define DMA_V_(D, t, off) glds16(DIF_VH(T, D) + (size_t)(t) * 64 * PP, voff, (unsigned)__builtin_amdgcn_readfirstlane(vdst + (off)))
#define DMA_K(t, off) DMA_K_(U, t, off)
#define DMA_V(t, off) DMA_V_(U, t, off)
#define LOAD_Q(D) do { const bf16* Qw_ = DIF_QH(T, D) + (size_t)((D).qb * 256 + wid * 32) * PP; _Pragma("unroll") for (int d0 = 0; d0 < 4; ++d0) qr[d0] = *(const GAS bf16x8*)(Qw_ + (size_t)r32 * PP + d0 * 16 + hi * 8); } while (0)
    const lds_cptr vp0 = (lds_cptr)shm + DIF_LV + ((lane >> 4) & 1) * 32 + (lane & 3) * 8 + (4 * hi + ((lane & 15) >> 2)) * 64;
    const lds_cptr kp0 = (lds_cptr)shm + hi * 1024 + r32 * 16;
    if (first) { DMA_K(0, 0); DMA_V(0, 0); DMA_K(1, KS); DMA_V(1, VS); DMA_K(2, 2 * KS); LOAD_Q(U); }
    float mh1 = 0.f, mh2 = 0.f, l1 = 0.f, l2 = 0.f; f32x16 o1[2], o2[2]; o1[0] = f32x16{}; o1[1] = f32x16{}; o2[0] = f32x16{}; o2[1] = f32x16{};
    const int qrel = wid * 32 + r32;
    const float tb0 = slope2 * (float)(kz - (q0 + qrel)), tbs = 64.0f * slope2;
    const unsigned sb0 = __float_as_uint(slope2) & 0xffff0000u; const float sr1 = slope2 - __uint_as_float(sb0); const unsigned sb1 = __float_as_uint(sr1) & 0xffff0000u; const float sr2 = sr1 - __uint_as_float(sb1);
    const unsigned s2w = __float_as_uint(sr2);
    u32x4 qxw; qxw.x = __builtin_amdgcn_perm(sb1, sb0, 0x07060302u); qxw.y = 0u; qxw.z = 0u; qxw.w = 0u;
    bf16x8 kx0, kx1; { const unsigned i0 = __float_as_uint((float)r32) >> 16, i1 = __float_as_uint((float)(r32 + 32)) >> 16, one = 0x3f80u; const bool lo = (hi == 0);
        const u32x4 a0 = lo ? (u32x4){i0 | (i0 << 16), i0 | (one << 16), one | (one << 16), 0u} : (u32x4){0u, 0u, 0u, 0u}, a1 = lo ? (u32x4){i1 | (i1 << 16), i1 | (one << 16), one | (one << 16), 0u} : (u32x4){0u, 0u, 0u, 0u};
        kx0 = __builtin_bit_cast(bf16x8, a0); kx1 = __builtin_bit_cast(bf16x8, a1); }
#define QXF() __builtin_bit_cast(bf16x8, qxw)
#define QX_SET(uexpr) do { const float u_ = (uexpr); const unsigned ub_ = __float_as_uint(u_); const float r1_ = u_ - __uint_as_float(ub_ & 0xffff0000u); const unsigned r1b_ = __float_as_uint(r1_); \
        const float r2_ = r1_ - __uint_as_float(r1b_ & 0xffff0000u); qxw.y = __builtin_amdgcn_perm(ub_, s2w, 0x07060302u); qxw.z = __builtin_amdgcn_perm(__float_as_uint(r2_), r1b_, 0x07060302u); PIN(qxw); } while (0)
    const float bmax0 = slope2 * __builtin_fminf((float)(63 + kz - (q0 + qrel)), 0.f);
    f32x16 pA0, pA1, pB0, pB1; bf16x8 kf[4]; s16x4 vlo[8], vhi[8]; u32x4 pw0, pw1, pw2, pw3; bool rescd = false;
    WAIT_BAR0();
    DMA_K(3, 3 * KS); DMA_V(2, 2 * VS);
#pragma unroll
    for (int q = 0; q < 4; ++q) kf[q] = *(const LAS3 bf16x8*)(kp0 + (q >> 1) * 2048 + (q & 1) * 512);
    QX_SET(tb0);
#define DIFF_DECIDE(C0, C1, MP, FIRST, HASPREV) do { rescd = false; \
        if (FIRST) { const float dl = rowmax(C0, C1) - bmax0; if ((MP) == 0) mh1 += dl; else mh2 += dl; \
            _Pragma("unroll") for (int r = 0; r < 16; ++r) { C0[r] -= dl; C1[r] -= dl; } } \
        if (HASPREV) { const float dl = big_shift(sacc); \
            if (__builtin_expect(__any(dl > 0.f), 0)) { const float f = EX(-dl); if ((MP) == 0) { mh2 += dl; l2 *= f; } else { mh1 += dl; l1 *= f; } if (hi == 0) wsf[r32] = f; rescd = true; } } } while (0)
    DIFF_STEP(pA0, pA1, pB0, pB1, o2, 0, 0, 0, 0, 2, mh2, tb0, 0, 1);
    DIFF_STEP(pB0, pB1, pA0, pA1, o1, 1, 0, 0, KS, 0, mh1, tb0 + tbs, 1, 1);
    if (NT > 4) { WAIT_BARN(2); DMA_K(4, 0); DMA_V(3, 3 * VS); } else { WAIT_BAR0(); DMA_V(3, 3 * VS); }
    float tbt = tb0 + tbs;
    for (int t = 1; t <= tl; ++t) {
        DIFF_STEP(pA0, pA1, pB0, pB1, o2, 0, t, ((t - 1) & 3) * VS, (t & 3) * KS, 2, mh2, tbt, 1, 0);
        DIFF_STEP(pB0, pB1, pA0, pA1, o1, 1, t, (t & 3) * VS, ((t + 1) & 3) * KS, 0, mh1, tbt + tbs, 1, 0);
        tbt += tbs;
        if (t + 1 < NT) { if (t + 4 < NT) { WAIT_BARN(2); } else { WAIT_BAR0(); }
            if (t + 4 < NT) DMA_K(t + 4, ((t + 4) & 3) * KS); if (t + 3 < NT) DMA_V(t + 3, ((t + 3) & 3) * VS); }
    }
#define DIFF_DRAIN() do { float sacc = 0.f; \
      _Pragma("unroll") for (int r = 0; r < 16; ++r) sacc += pB0[r] + pB1[r]; \
      l2 += sacc; \
      pw0 = (u32x4){cvtpk(pB0[0], pB0[1]), cvtpk(pB0[2], pB0[3]), cvtpk(pB0[4], pB0[5]), cvtpk(pB0[6], pB0[7])}; pw1 = (u32x4){cvtpk(pB0[8], pB0[9]), cvtpk(pB0[10], pB0[11]), cvtpk(pB0[12], pB0[13]), cvtpk(pB0[14], pB0[15])}; \
      pw2 = (u32x4){cvtpk(pB1[0], pB1[1]), cvtpk(pB1[2], pB1[3]), cvtpk(pB1[4], pB1[5]), cvtpk(pB1[6], pB1[7])}; pw3 = (u32x4){cvtpk(pB1[8], pB1[9]), cvtpk(pB1[10], pB1[11]), cvtpk(pB1[12], pB1[13]), cvtpk(pB1[14], pB1[15])}; \
      const lds_cptr vp_ = vp0 + (tl & 3) * VS; \
      _Pragma("unroll") for (int i = 0; i < 8; ++i) { vlo[i] = vtr(vp_ + (i >> 2) * 4096 + (i & 3) * 1024); vhi[i] = vtr(vp_ + (i >> 2) * 4096 + (i & 3) * 1024 + 512); } \
      o2[0] = MFMA(PAF(0), VFR(0), o2[0]); o2[1] = MFMA(PAF(0), VFR(4), o2[1]); o2[0] = MFMA(PAF(1), VFR(1), o2[0]); o2[1] = MFMA(PAF(1), VFR(5), o2[1]); \
      o2[0] = MFMA(PAF(2), VFR(2), o2[0]); o2[1] = MFMA(PAF(2), VFR(6), o2[1]); o2[0] = MFMA(PAF(3), VFR(3), o2[0]); o2[1] = MFMA(PAF(3), VFR(7), o2[1]); } while (0)
#define DIFF_EPI() do { l1 = halfsum(l1); l2 = halfsum(l2); \
      int le = lane; asm volatile("" : "+v"(le)); const int r32e = le & 31, hie = le >> 5; \
      if (hie == 0) { wsf[r32e] = 1.0f / l1; wsf[32 + r32e] = lam / l2; } \
      asm volatile("s_waitcnt lgkmcnt(0)" ::: "memory"); \
      f32x16 v0, v1; \
      _Pragma("unroll") for (int r = 0; r < 16; ++r) { const float f1 = wsf[crow(r, hie)], f2 = wsf[32 + crow(r, hie)]; v0[r] = o1[0][r] * f1 - o2[0][r] * f2; v1[r] = o1[1][r] * f1 - o2[1][r] * f2; } \
      _Pragma("unroll") for (int r = 0; r < 16; ++r) { float s_ = v0[r] * v0[r] + v1[r] * v1[r]; \
          s_ += __shfl_xor(s_, 1); s_ += __shfl_xor(s_, 2); s_ += __shfl_xor(s_, 4); s_ += __shfl_xor(s_, 8); s_ += __shfl_xor(s_, 16); \
          const float rn = __builtin_amdgcn_rsqf(s_ * (1.0f / 64.0f) + 1e-5f); v0[r] *= rn; v1[r] *= rn; } \
      store_o(v0, v1, (LAS3 bf16*)(shm + DIF_OST) + wid * 2048, DIF_OH(T, U) + (size_t)(q0 + wid * 32) * OP, OP, le, r32e, hie); } while (0)
    const bool early = tl < NT - 1;
    if (!early) { WAIT_BAR0();
        if (has_next) { DMA_K_(UN, 0, 0); DMA_V_(UN, 0, 0); DMA_K_(UN, 1, KS); DMA_V_(UN, 1, VS); DMA_K_(UN, 2, 2 * KS); LOAD_Q(UN); } }
    DIFF_DRAIN(); DIFF_EPI();
    if (early) {
        for (int t2 = tl + 1; t2 <= NT - 2; ++t2) WAIT_BAR0();
        WAIT_BAR0();
        if (has_next) { DMA_K_(UN, 0, 0); DMA_V_(UN, 0, 0); DMA_K_(UN, 1, KS); DMA_V_(UN, 1, VS); DMA_K_(UN, 2, 2 * KS); LOAD_Q(UN); }
    }
#undef DMA_K_
#undef DMA_V_
#undef DMA_K
#undef DMA_V
#undef LOAD_Q
#undef DIFF_DECIDE
#undef DIFF_DRAIN
#undef DIFF_EPI
#undef QXF
#undef QX_SET
}
}
#define XB_TMO      128
#define XB_XCNT(j)  (256  + 64 * (j))
#define XB_XSUB(j)  (1280 + 64 * (j))
#define XB_XGEN(j)  (2304 + 64 * (j))
#define XB_TOP      3328
#define XB_TOPGEN   3392
#define XCD_BAR_WORDS 3456
#define XB_SPIN_CAP (1u << 18)

__device__ __forceinline__ unsigned xb_ld(unsigned* p)              { return __hip_atomic_load(p, __ATOMIC_RELAXED, __HIP_MEMORY_SCOPE_AGENT); }
__device__ __forceinline__ unsigned xb_add(unsigned* p, unsigned v) { return __hip_atomic_fetch_add(p, v, __ATOMIC_RELAXED, __HIP_MEMORY_SCOPE_AGENT); }
__device__ __forceinline__ unsigned xb_xcc_id() { return (unsigned)__builtin_amdgcn_s_getreg((3 << 11) | 20) & 0xFu; }
#define XB_SPIN(cond, bar) do { unsigned _sp = 0; while (cond) { __builtin_amdgcn_s_sleep(1); \
    if ((++_sp & 255u) == 0u) { if (xb_ld(&(bar)[XB_TMO])) break; if (_sp > XB_SPIN_CAP) { atomicAdd(&(bar)[XB_TMO], 1u); break; } } } } while (0)

struct XcdBarrier {
    unsigned* bar; unsigned x;
    volatile LAS unsigned* st;
};

__device__ __forceinline__ XcdBarrier xcd_barrier_post(unsigned* bar, volatile LAS unsigned* st) {
    XcdBarrier b; b.bar = bar; b.x = xb_xcc_id(); b.st = st;
    if (threadIdx.x == 0) (void)xb_add(&bar[XB_XCNT(b.x)], 1u);
    return b;
}
__device__ __forceinline__ void xcd_barrier_complete(unsigned* bar, unsigned x, unsigned& nloc, unsigned& nx) {
    const unsigned G = gridDim.x * gridDim.y * gridDim.z;
    unsigned sum, cnt, mine, sp = 0u;
    for (;;) {
        sum = 0u; cnt = 0u; mine = 0u;
#pragma unroll
        for (unsigned j = 0; j < 16; ++j) { const unsigned c = xb_ld(&bar[XB_XCNT(j)]); sum += c; cnt += (c > 0u) ? 1u : 0u; mine = (j == x) ? c : mine; }
        if (sum == G) break;
        __builtin_amdgcn_s_sleep(1);
        if ((++sp & 255u) == 0u) { if (xb_ld(&bar[XB_TMO])) break; if (sp > XB_SPIN_CAP) { atomicAdd(&bar[XB_TMO], 1u); break; } }
    }
    nloc = mine > 0u ? mine : 1u; nx = cnt > 0u ? cnt : 1u;
}

__device__ __forceinline__ void xcd_barrier(const XcdBarrier& b) {
    asm volatile("s_waitcnt vmcnt(0)" ::: "memory");
    __syncthreads();
    if (threadIdx.x == 0) {
        unsigned* bar = b.bar;
        __builtin_amdgcn_s_waitcnt(0);
        unsigned nloc = b.st[0], nx = b.st[1];
        if (nloc == 0u) { xcd_barrier_complete(bar, b.x, nloc, nx); b.st[0] = nloc; b.st[1] = nx; }
        const unsigned old = xb_add(&bar[XB_XSUB(b.x)], 1u);
        const unsigned gen = old / nloc;
        if (old + 1u == (gen + 1u) * nloc) {
            __builtin_amdgcn_fence(__ATOMIC_RELEASE, "agent");
            asm volatile("s_waitcnt vmcnt(0)" ::: "memory");
            const unsigned og = xb_add(&bar[XB_TOP], 1u);
            const unsigned tg = og / nx;
            if (og + 1u == (tg + 1u) * nx) xb_add(&bar[XB_TOPGEN], 1u);
            else XB_SPIN(xb_ld(&bar[XB_TOPGEN]) == tg, bar);
            __builtin_amdgcn_fence(__ATOMIC_ACQUIRE, "agent");
            xb_add(&bar[XB_XGEN(b.x)], 1u);
            asm volatile("s_waitcnt vmcnt(0)" ::: "memory");
        } else {
            XB_SPIN(xb_ld(&bar[XB_XGEN(b.x)]) == gen, bar);
            __builtin_amdgcn_fence(__ATOMIC_ACQUIRE, "agent");
            asm volatile("s_waitcnt vmcnt(0)" ::: "memory");
        }
    }
    __syncthreads();
}

struct Args { const float* in[29]; float* out; unsigned char* ws; int ph_lo, ph_hi; };
struct Frame {
    LAS unsigned char* lds;
    volatile LAS unsigned* MISC;
    gu32* ctl;
    int tid, lane, wave, vcu, G;
    unsigned char* ws;
    float* out;
};
#define WSP(T, off) ((T*)(F.ws + (off)))

__device__ __forceinline__ int ropeperm(int i) { return (i < 16) ? (8 * (i >> 2) + (i & 3)) : (8 * ((i - 16) >> 2) + 4 + ((i - 16) & 3)); }
__device__ __forceinline__ int dst_row(int mode, int c) {
    if (mode == 1) { if (c < 256) return (c >> 7) * 256 + (c & 127); if (c < 512) return ((c - 256) >> 7) * 256 + 128 + (c & 127);
        if (c < C_KR) return c; if (c < C_KR + 32) return C_KR + ropeperm(c - C_KR); return C_DQ + (c - (C_KR + 32)); }
    if (mode == 2) { const int hh = c / 96, d = c - hh * 96; return hh * 128 + (d < 64 ? d : 64 + ropeperm(d - 64)); }
    if (mode == 3) return (c >> 7) * 256 + (c & 127);
    if (mode == 4) return (c >> 7) * 256 + 128 + (c & 127);
    return c;
}
struct TrDesc { const float* W; bf16* WT; const float* gain; int K, N, Kdst, mode, gmode, item; float gaux, rsc, qs; };
__device__ __forceinline__ void tr_load(const TrDesc& d, int lane, float (&v)[32]) {
    const int nblk = d.N / 32, kb = d.item / nblk, nb = d.item - kb * nblk, k0 = 64 * kb, n0 = 32 * nb;
    const float* p = d.W + (size_t)(k0 + (lane >> 5)) * d.N + n0 + (lane & 31);
#pragma unroll
    for (int i = 0; i < 32; ++i) v[i] = __builtin_nontemporal_load((const GAS float*)p + (size_t)(2 * i) * d.N);
}
__device__ __forceinline__ void tr_store(const TrDesc& d, int lane, const float (&v)[32], LAS float* scr) {
    const int nblk = d.N / 32, kb = d.item / nblk, nb = d.item - kb * nblk, k0 = 64 * kb, n0 = 32 * nb;
#pragma unroll
    for (int i = 0; i < 32; ++i) scr[(2 * i + (lane >> 5)) * 33 + (lane & 31)] = v[i];
    LDS_WAIT(); asm volatile("" ::: "memory");
    const int c = lane & 7; float g[8];
#pragma unroll
    for (int j = 0; j < 8; ++j) { const int k = k0 + 8 * c + j; g[j] = 1.0f;
        if (d.gmode == 1) g[j] = d.gain[k]; else if (d.gmode == 2) g[j] = (k >= 640) ? d.gain[(k - 640) & 63] * d.gaux : 1.0f; }
#pragma unroll
    for (int j = 0; j < 4; ++j) { const int n = (lane >> 3) + 8 * j; const LAS float* s = scr + (8 * c) * 33 + n; const int dr = dst_row(d.mode, n0 + n);
        float sc = 1.0f; if (d.mode == 2) sc = d.rsc; else if (d.mode == 1 && dr >= C_DQ && dr < C_DK) sc = d.rsc;
        if (d.qs > 0.f) { sc = d.qs; v2u o8; o8.x = pk4f8(s[0 * 33] * g[0] * sc, s[1 * 33] * g[1] * sc, s[2 * 33] * g[2] * sc, s[3 * 33] * g[3] * sc); o8.y = pk4f8(s[4 * 33] * g[4] * sc, s[5 * 33] * g[5] * sc, s[6 * 33] * g[6] * sc, s[7 * 33] * g[7] * sc);
            *(GAS v2u*)((unsigned char*)d.WT + (size_t)dr * d.Kdst + k0 + 8 * c) = o8; continue; }
        v4u o; o.x = pkbf(s[0 * 33] * g[0] * sc, s[1 * 33] * g[1] * sc); o.y = pkbf(s[2 * 33] * g[2] * sc, s[3 * 33] * g[3] * sc); o.z = pkbf(s[4 * 33] * g[4] * sc, s[5 * 33] * g[5] * sc); o.w = pkbf(s[6 * 33] * g[6] * sc, s[7 * 33] * g[7] * sc);
        *(GAS v4u*)(d.WT + (size_t)dr * d.Kdst + k0 + 8 * c) = o; }
    LDS_WAIT(); asm volatile("" ::: "memory");
}
__device__ __forceinline__ void zero_rect(bf16* WT, int ld, int r0, int nr, int c0, int nc, int gt, int ngt) {
    const int cpr = nc / 8, tot = nr * cpr;
    for (int i = gt; i < tot; i += ngt) { const int r = i / cpr, c = i - r * cpr; *(GAS v4u*)(WT + (size_t)(r0 + r) * ld + c0 + 8 * c) = (v4u){0u, 0u, 0u, 0u}; }
}
__device__ __forceinline__ void x_row_prep(const float* xrow, bf16* orow, int lane) {
    const GAS f32x4* xr = (const GAS f32x4*)xrow + lane; f32x4 v[4]; float s = 0.f;
#pragma unroll
    for (int j = 0; j < 4; ++j) { v[j] = __builtin_nontemporal_load(xr + 64 * j); s += (v[j].x * v[j].x + v[j].y * v[j].y) + (v[j].z * v[j].z + v[j].w * v[j].w); }
    s = wave_sum(s); const float rs = 1.0f / sqrtf(s * (1.0f / 1024.0f) + RMS_EPS);
    GAS unsigned long long* o8 = (GAS unsigned long long*)orow + lane;
#pragma unroll
    for (int j = 0; j < 4; ++j) o8[64 * j] = (unsigned long long)pkbf(v[j].x * rs, v[j].y * rs) | ((unsigned long long)pkbf(v[j].z * rs, v[j].w * rs) << 32);
}
__device__ __forceinline__ void p0_prologue(Frame& F, const Args& A) {
    { int t_ = F.wave * 64 + (int)__builtin_amdgcn_mbcnt_hi(~0u, __builtin_amdgcn_mbcnt_lo(~0u, 0u)); asm volatile("" : "+v"(t_)); F.tid = t_; F.lane = t_ & 63; unsigned long long w_ = (unsigned long long)F.ws; asm volatile("" : "+s"(w_)); F.ws = (unsigned char*)w_; }
    LAS float* scr = (LAS float*)(F.lds + RING_OFF + F.wave * 16384);
    const int gw = F.vcu * NWAVES + F.wave, NGW = F.G * NWAVES, gt = gw * 64 + F.lane, ngt = NGW * 64;
    constexpr int I_IN = 16 * 65, I_UQ = 4 * 18, I_UKV = 2 * 24, I_PW = 4 * 8, I_OUT = 16 * 32, I_G = 16 * 88, I_D = 44 * 32;
    constexpr int I_LAYER = I_IN + I_UQ + I_UKV + I_PW + I_OUT;
    constexpr int NITEMS = 2 * I_LAYER + 3 * I_G + 8 * 3 * I_G;
    static_assert(I_G == I_D, "item counts");
    const float qsc_mla = 0.10206207261596577f * LOG2E, qsc_diff = 0.17677669529663687f * LOG2E;
#define TR_DESC(d, it_) do { int r = (it_); \
        if (r < 2 * I_LAYER) { const int l = r / I_LAYER; r -= l * I_LAYER; \
            if (r < I_IN) { d = TrDesc{A.in[2] + (size_t)l * 1024 * 2080, WSP(bf16, WS_WIN) + (size_t)l * 2304 * 1024, A.in[1] + l * 1024, 1024, 2080, 1024, 1, 1, r, 0.f, qsc_diff, 0.f}; break; } r -= I_IN; \
            if (r < I_UQ) { d = TrDesc{A.in[11] + (size_t)l * 256 * 576, WSP(bf16, WS_WUQ) + (size_t)l * 768 * 256, A.in[10] + l * 256, 256, 576, 256, 2, 1, r, 0.f, qsc_mla, 0.f}; break; } r -= I_UQ; \
            if (r < I_UKV) { d = TrDesc{A.in[13] + (size_t)l * 128 * 768, WSP(bf16, WS_WUKV) + (size_t)l * 768 * 128, A.in[12] + l * 128, 128, 768, 128, 0, 1, r, 0.f, 1.f, 0.f}; break; } r -= I_UKV; \
            if (r < I_PW) { d = TrDesc{A.in[8] + (size_t)l * 256 * 256, WSP(bf16, WS_WPW) + (size_t)l * 256 * 256, nullptr, 256, 256, 256, 0, 0, r, 0.f, 1.f, 0.f}; break; } r -= I_PW; \
            d = TrDesc{A.in[19] + (size_t)l * 1024 * 1024, WSP(bf16, WS_WOUT) + (size_t)l * 1024 * 1024, A.in[18] + l * 64, 1024, 1024, 1024, 0, 2, r, 1.0f - (l == 0 ? LAM_INIT0 : LAM_INIT1), 1.f, 0.f}; break; } \
        r -= 2 * I_LAYER; \
        if (r < I_G) { d = TrDesc{A.in[21], WSP(bf16, WS_WGUD), A.in[20], 1024, 2816, 1024, 3, 1, r, 0.f, 1.f, 0.f}; break; } r -= I_G; \
        if (r < I_G) { d = TrDesc{A.in[22], WSP(bf16, WS_WGUD), A.in[20], 1024, 2816, 1024, 4, 1, r, 0.f, 1.f, 0.f}; break; } r -= I_G; \
        if (r < I_D) { d = TrDesc{A.in[23], WSP(bf16, WS_WDD), nullptr, 2816, 1024, 2816, 0, 0, r, 0.f, 1.f, QS_D}; break; } r -= I_D; \
        { const int e = r / (3 * I_G); r -= e * 3 * I_G; \
          if (r < I_G) { d = TrDesc{A.in[25] + (size_t)e * 1024 * 2816, WSP(bf16, WS_WGUE) + (size_t)e * 5632 * 512, A.in[20] + 1024, 1024, 2816, 1024, 3, 1, r, 0.f, 1.f, QS_GU}; break; } r -= I_G; \
          if (r < I_G) { d = TrDesc{A.in[26] + (size_t)e * 1024 * 2816, WSP(bf16, WS_WGUE) + (size_t)e * 5632 * 512, A.in[20] + 1024, 1024, 2816, 1024, 4, 1, r, 0.f, 1.f, QS_GU}; break; } r -= I_G; \
          d = TrDesc{A.in[27] + (size_t)e * 2816 * 1024, WSP(bf16, WS_WDE) + (size_t)e * 1024 * 1408, nullptr, 2816, 1024, 2816, 0, 0, r, 0.f, 1.f, QS_D}; } } while (0)
    if (gw < NITEMS) {
        TrDesc dc, dn; float vc[32], vn[32];
        TR_DESC(dc, gw); tr_load(dc, F.lane, vc);
        for (int it = gw; it < NITEMS; it += NGW) {
            const bool more = it + NGW < NITEMS;
            if (more) { TR_DESC(dn, it + NGW); tr_load(dn, F.lane, vn); }
            tr_store(dc, F.lane, vc, scr);
            if (more) { dc = dn;
#pragma unroll
                for (int i = 0; i < 32; ++i) vc[i] = vn[i]; }
        }
    }
#undef TR_DESC
    for (int l = 0; l < 2; ++l) {
        zero_rect(WSP(bf16, WS_WIN) + (size_t)l * 2304 * 1024, 1024, C_KR + 32, 96, 0, 1024, gt, ngt);
        zero_rect(WSP(bf16, WS_WIN) + (size_t)l * 2304 * 1024, 1024, 2176, 128, 0, 1024, gt, ngt);
        for (int hh = 0; hh < 6; ++hh) zero_rect(WSP(bf16, WS_WUQ) + (size_t)l * 768 * 256, 256, hh * 128 + 96, 32, 0, 256, gt, ngt);
    }
    for (int i = gt; i < 2048 * 16; i += ngt) { const int pos = i >> 4, fi = i & 15;
        const float freq = exp2f(-(float)fi * (13.287712379549449f / 16.0f)); const float ang = (float)pos * freq;
        const double rev = (double)ang * 0.15915494309189535; const float fr = (float)(rev - floor(rev));
        float* t = WSP(float, WS_ROPE) + (size_t)i * 2; t[0] = __builtin_amdgcn_cosf(fr); t[1] = __builtin_amdgcn_sinf(fr); }
    for (int i = gt; i < 2 * 512; i += ngt) WSP(float, WS_ROPE + BGLU_OFF)[i] = A.in[3][i];
    for (int i = gt; i < 8 * 1024; i += ngt) { const int e = i >> 10, k = i & 1023; WSP(float, WS_WR)[i] = A.in[20][1024 + k] * A.in[24][(size_t)k * 8 + e]; }
    if (gw == 0) {
        for (int l = 0; l < 2; ++l) { const int j = F.lane & 31;
            float a = A.in[14][l * 32 + j] * A.in[15][l * 32 + j], b = A.in[16][l * 32 + j] * A.in[17][l * 32 + j];
            if (F.lane >= 32) { a = 0.f; b = 0.f; }
            a = wave_sum(a); b = wave_sum(b);
            if (F.lane == 0) WSP(float, WS_LAM)[l] = expf(a) - expf(b) + (l == 0 ? LAM_INIT0 : LAM_INIT1); } }
    for (int m = gw * 2; m < M; m += NGW * 2) {
        x_row_prep(A.in[0] + (size_t)m * D, WSP(bf16, WS_XB) + (size_t)m * D, F.lane);
        x_row_prep(A.in[0] + (size_t)(m + 1) * D, WSP(bf16, WS_XB) + (size_t)(m + 1) * D, F.lane); }
}

__device__ __forceinline__ void conv_phase(Frame& F, const Args& A, int l) {
    { int t_ = F.wave * 64 + (int)__builtin_amdgcn_mbcnt_hi(~0u, __builtin_amdgcn_mbcnt_lo(~0u, 0u)); asm volatile("" : "+v"(t_)); F.tid = t_; F.lane = t_ & 63; unsigned long long w_ = (unsigned long long)F.ws; asm volatile("" : "+s"(w_)); F.ws = (unsigned char*)w_; }
    LAS float* U = (LAS float*)(F.lds + RING_OFF);
    const bf16* proj = WSP(bf16, WS_PROJ); bf16* cb = WSP(bf16, WS_CB);
    const float* b_glu = A.in[3] + l * 512; const float* w_dw = A.in[4] + l * 31 * 256; const float* b_dw = A.in[5] + l * 256;
    const float* lng = A.in[6] + l * 256; const float* lnb = A.in[7] + l * 256;
    const int c8 = F.tid & 31, r0 = F.tid >> 5, c = F.tid & 255, hf = F.tid >> 8;
    float w[31];
#pragma unroll
    for (int j = 0; j < 31; ++j) w[j] = w_dw[j * 256 + c];
    const float bd = b_dw[c];
    const f32x4 g4 = *(const f32x4*)(lng + 4 * F.lane), b4 = *(const f32x4*)(lnb + 4 * F.lane);
    v4u a8[6];
#define CONV_LOAD(unit_) do { const int b_ = (unit_) >> 5, t0_ = ((unit_) & 31) * 64; _Pragma("unroll") for (int k = 0; k < 6; ++k) { const int r = r0 + 16 * k, tok = t0_ - 30 + r; a8[k] = (v4u){0u, 0u, 0u, 0u}; \
        if (r < 94 && tok >= 0) { const bf16* rp = proj + (size_t)(b_ * SEQ + tok) * NPROJ + c8 * 8; a8[k] = *(const GAS v4u*)rp; } } } while (0)
    if (F.vcu < NBATCH * 32) CONV_LOAD(F.vcu);
    for (int unit = F.vcu; unit < NBATCH * 32; unit += F.G) {
        const int b = unit >> 5, t0 = (unit & 31) * 64;
        {
#pragma unroll
          for (int k = 0; k < 6; ++k) { const int r = r0 + 16 * k, tok = t0 - 30 + r;
              if (r < 94) { f32x4 u0 = (f32x4){0.f, 0.f, 0.f, 0.f}, u1 = u0;
                  if (tok >= 0) { u0 = (f32x4){bf_lo(a8[k].x), bf_hi(a8[k].x), bf_lo(a8[k].y), bf_hi(a8[k].y)}; u1 = (f32x4){bf_lo(a8[k].z), bf_hi(a8[k].z), bf_lo(a8[k].w), bf_hi(a8[k].w)}; }
                  *(LAS f32x4*)(U + r * 256 + c8 * 8) = u0; *(LAS f32x4*)(U + r * 256 + c8 * 8 + 4) = u1; } } }
        __syncthreads();
        if (unit + F.G < NBATCH * 32) CONV_LOAD(unit + F.G);
        { float uw[62], o[32];
#pragma unroll
          for (int j = 0; j < 62; ++j) uw[j] = U[(hf * 32 + j) * 256 + c];
#pragma unroll
          for (int i = 0; i < 32; ++i) { float a = bd;
#pragma unroll
              for (int j = 0; j < 31; ++j) a = __builtin_fmaf(w[j], uw[i + j], a);
              o[i] = a; }
          __syncthreads();
#pragma unroll
          for (int i = 0; i < 32; ++i) U[(hf * 32 + i) * 256 + c] = o[i]; }
        __syncthreads();
        { f32x4 v[8]; float s[8];
#pragma unroll
          for (int k = 0; k < 8; ++k) { v[k] = *(LAS f32x4*)(U + (F.wave * 8 + k) * 256 + 4 * F.lane); s[k] = (v[k][0] + v[k][1]) + (v[k][2] + v[k][3]); }
#pragma unroll
          for (int o = 1; o < 64; o <<= 1)
#pragma unroll
              for (int k = 0; k < 8; ++k) s[k] += __shfl_xor(s[k], o);
#pragma unroll
          for (int k = 0; k < 8; ++k) { v[k] = v[k] - s[k] * (1.0f / 256.0f); s[k] = dot4_(v[k]); }
#pragma unroll
          for (int o = 1; o < 64; o <<= 1)
#pragma unroll
              for (int k = 0; k < 8; ++k) s[k] += __shfl_xor(s[k], o);
#pragma unroll
          for (int k = 0; k < 8; ++k) { const float rstd = __builtin_amdgcn_rsqf(s[k] * (1.0f / 256.0f) + LN_EPS); f32x4 y = v[k] * rstd * g4 + b4;
#pragma unroll
              for (int j = 0; j < 4; ++j) y[j] = y[j] * sigmoidf_(y[j]);
              v2u wv; wv.x = pkbf(y[0], y[1]); wv.y = pkbf(y[2], y[3]);
              *(GAS v2u*)(cb + (size_t)(b * SEQ + t0 + F.wave * 8 + k) * 256 + 4 * F.lane) = wv; } }
        __syncthreads();
    }
#undef CONV_LOAD
}

__device__ __forceinline__ void router_phase(Frame& F, const Args& A) {
    { int t_ = F.wave * 64 + (int)__builtin_amdgcn_mbcnt_hi(~0u, __builtin_amdgcn_mbcnt_lo(~0u, 0u)); asm volatile("" : "+v"(t_)); F.tid = t_; F.lane = t_ & 63; unsigned long long w_ = (unsigned long long)F.ws; asm volatile("" : "+s"(w_)); F.ws = (unsigned char*)w_; }
    LAS int* hist = (LAS int*)(F.lds + RING_OFF);
    LAS int* rec_g = hist + 32;
    LAS int* rec_r = rec_g + 512;
    LAS float* rec_w = (LAS float*)(rec_r + 512);
    const bf16* x = WSP(bf16, WS_XB); const float* wr = WSP(float, WS_WR); float* ssf1 = WSP(float, WS_SSF1);
    int* list = WSP(int, WS_LIST); float* wgt = WSP(float, WS_WGT); bf16* hb3 = WSP(bf16, WS_HB3);
    f32x4 wv[8][4];
#pragma unroll
    for (int e = 0; e < 8; ++e)
#pragma unroll
        for (int j = 0; j < 4; ++j) wv[e][j] = *(const f32x4*)(wr + e * 1024 + 256 * j + 4 * F.lane);
    for (int blk = F.vcu; blk < M / 256; blk += F.G) {
        if (F.tid < 8) hist[F.tid] = 0;
        __syncthreads();
        for (int i = 0; i < 32; i += 2) {
            f32x4 v[2][4];
#pragma unroll
            for (int rr = 0; rr < 2; ++rr) { const int m = blk * 256 + F.wave * 32 + i + rr;
#pragma unroll
                for (int j = 0; j < 4; ++j) { const v2u p = *((const GAS v2u*)(x + (size_t)m * D) + F.lane + 64 * j); v[rr][j] = (f32x4){bf_lo(p.x), bf_hi(p.x), bf_lo(p.y), bf_hi(p.y)}; } }
#pragma unroll
            for (int rr = 0; rr < 2; ++rr) { const int lr = F.wave * 32 + i + rr, m = blk * 256 + lr;
                float ss = 0.f, lg[8];
#pragma unroll
                for (int j = 0; j < 4; ++j) ss += dot4_(v[rr][j]);
                ss = wave_sum(ss);
#pragma unroll
                for (int e = 0; e < 8; ++e) { float a = 0.f;
#pragma unroll
                    for (int j = 0; j < 4; ++j) { const f32x4 p = v[rr][j] * wv[e][j]; a += (p[0] + p[1]) + (p[2] + p[3]); }
                    lg[e] = wave_sum(a); }
                const float rs = 1.0f / sqrtf(ss * (1.0f / 1024.0f) + RMS_EPS);
#pragma unroll
                for (int j = 0; j < 4; ++j) { const f32x4 hv = v[rr][j] * rs; *((GAS unsigned*)(hb3 + (size_t)m * (D / 2)) + F.lane + 64 * j) = pk4f8(hv[0], hv[1], hv[2], hv[3]); }
                int e1 = 0; float v1 = lg[0];
#pragma unroll
                for (int e = 1; e < 8; ++e) if (lg[e] > v1) { v1 = lg[e]; e1 = e; }
                int e2 = -1; float v2 = -INFINITY;
#pragma unroll
                for (int e = 0; e < 8; ++e) if (e != e1 && (e2 < 0 || lg[e] > v2)) { v2 = lg[e]; e2 = e; }
                const float ex = __expf((v2 - v1) * rs), w1 = 1.0f / (1.0f + ex), w2 = ex * w1;
                if (F.lane == 0) { ssf1[m] = ss;
                    rec_g[lr * 2] = e1; rec_g[lr * 2 + 1] = e2; rec_w[lr * 2] = w1; rec_w[lr * 2 + 1] = w2;
                    rec_r[lr * 2] = __hip_atomic_fetch_add(hist + e1, 1, __ATOMIC_RELAXED, __HIP_MEMORY_SCOPE_WORKGROUP);
                    rec_r[lr * 2 + 1] = __hip_atomic_fetch_add(hist + e2, 1, __ATOMIC_RELAXED, __HIP_MEMORY_SCOPE_WORKGROUP); } }
        }
        __syncthreads();
        if (F.tid < 8) hist[16 + F.tid] = (int)__hip_atomic_fetch_add((unsigned*)(F.ctl + CW_CNT + 64 * F.tid), (unsigned)hist[F.tid], RLX_AGENT);
        __syncthreads();
        if (F.tid < 256) {
#pragma unroll
            for (int s = 0; s < 2; ++s) { const int g = rec_g[F.tid * 2 + s], pos = hist[16 + g] + rec_r[F.tid * 2 + s];
                list[(size_t)g * M + pos] = (blk * 256 + F.tid) | (s << 16); wgt[(size_t)g * M + pos] = rec_w[F.tid * 2 + s]; } }
        __syncthreads();
    }
}
__device__ __forceinline__ void moe_prefix(Frame& F) {
    if (F.tid == 0) { int p = 0;
        for (int g = 0; g < 8; ++g) { F.MISC[16 + g] = (unsigned)p; const unsigned c = __hip_atomic_load(F.ctl + CW_CNT + 64 * g, RLX_AGENT); F.MISC[36 + g] = c; p += (int)((c + 255u) >> 8); }
        F.MISC[24] = (unsigned)p; F.MISC[32] = (unsigned)p; }
    __syncthreads();
}
__device__ __forceinline__ void final_phase(Frame& F, const Args& A) {
    { int t_ = F.wave * 64 + (int)__builtin_amdgcn_mbcnt_hi(~0u, __builtin_amdgcn_mbcnt_lo(~0u, 0u)); asm volatile("" : "+v"(t_)); F.tid = t_; F.lane = t_ & 63; unsigned long long w_ = (unsigned long long)F.ws; asm volatile("" : "+s"(w_)); F.ws = (unsigned char*)w_; }
    const int gw = F.vcu * NWAVES + F.wave, NGW = F.G * NWAVES; const float* g = A.in[28];
    f32x4 gv[4];
#pragma unroll
    for (int j = 0; j < 4; ++j) gv[j] = *(const f32x4*)(g + 256 * j + 4 * F.lane);
    const bf16* xb = WSP(bf16, WS_XB); const bf16* y1 = WSP(bf16, WS_Y1);
    for (int m0 = gw * 4; m0 < M; m0 += NGW * 4) {
        f32x4 v[4][4];
#pragma unroll
        for (int rr = 0; rr < 4; ++rr)
#pragma unroll
            for (int j = 0; j < 4; ++j) { const v2u p = *((const GAS v2u*)(xb + (size_t)(m0 + rr) * D) + F.lane + 64 * j), q = *((const GAS v2u*)(y1 + (size_t)(m0 + rr) * D) + F.lane + 64 * j);
                v[rr][j] = (f32x4){bf_lo(p.x), bf_hi(p.x), bf_lo(p.y), bf_hi(p.y)} + (f32x4){bf_lo(q.x), bf_hi(q.x), bf_lo(q.y), bf_hi(q.y)}; }
#pragma unroll
        for (int rr = 0; rr < 4; ++rr) { float ss = 0.f;
#pragma unroll
            for (int j = 0; j < 4; ++j) ss += dot4_(v[rr][j]);
            ss = wave_sum(ss); const float rs = 1.0f / sqrtf(ss * (1.0f / 1024.0f) + RMS_EPS);
#pragma unroll
            for (int j = 0; j < 4; ++j) *((GAS f32x4*)(F.out + (size_t)(m0 + rr) * D) + F.lane + 64 * j) = v[rr][j] * rs * gv[j]; }
    }
}

__device__ __forceinline__ void attn_coords(int i, bool contig, int per, int vcu, int G, int& b, int& h, int& qb) {
    const int p = contig ? vcu * per + (i >> 1) : vcu + (i >> 1) * G; const int bh = p >> 2, s = p & 3; b = bh / 6; h = bh - b * 6; qb = (i & 1) ? s : 7 - s;
}
template <int MODE, int PROBE = 0>
__device__ __forceinline__ void attn_phase(Frame& F, int l) {
    static_assert(att::ATT_LDS_BYTES <= RING_BYTES, "attention LDS");
    { unsigned long long w_ = (unsigned long long)F.ws; asm volatile("" : "+s"(w_)); F.ws = (unsigned char*)w_; }
    const att::bf16* proj = (const att::bf16*)WSP(bf16, WS_PROJ); const att::bf16* qb_ = (const att::bf16*)WSP(bf16, WS_Q); const att::bf16* kv = (const att::bf16*)WSP(bf16, WS_KV);
    const att::bf16* kr = (const att::bf16*)WSP(bf16, WS_KR); att::bf16* cat = (att::bf16*)WSP(bf16, WS_CAT);
    const float lam = WSP(float, WS_LAM)[l];
    int tid = F.wave * 64 + (int)__builtin_amdgcn_mbcnt_hi(~0u, __builtin_amdgcn_mbcnt_lo(~0u, 0u)); asm volatile("" : "+v"(tid));
    constexpr int NPAIR = NBATCH * 6 * 4;
    const bool contig = (NPAIR % F.G) == 0; const int per = NPAIR / F.G;
    const int npairs = contig ? per : (F.vcu < NPAIR ? (NPAIR - 1 - F.vcu) / F.G + 1 : 0), nun = 2 * npairs;
    if (F.wave >= 4) __builtin_amdgcn_s_setprio(1);
    att::UnitId U{0, 0, 0, 0}, UN{0, 0, 0, 0};
    if (MODE == 0) {
        if (nun > 0) attn_coords(0, contig, per, F.vcu, F.G, UN.b, UN.h, UN.qb);
        att::bf16x8 qr[6]; const att::MlaT T{qb_, kv, kr, cat};
        for (int i = 0; i < nun; ++i) { U = UN; if (i + 1 < nun) attn_coords(i + 1, contig, per, F.vcu, F.G, UN.b, UN.h, UN.qb);
            att::mla_unit<8, PROBE>(T, U, i == 0, i + 1 < nun, UN, qr, (att::lds_ptr)(F.lds + RING_OFF), tid); }
    } else {
        static constexpr unsigned char TAB[8][6] = {{47, 44, 15, 18, 2, 0}, {39, 36, 14, 10, 41, 9}, {31, 28, 13, 7, 33, 1}, {23, 20, 12, 6, 25, 40},
                                                    {46, 45, 43, 11, 17, 32}, {38, 37, 35, 42, 5, 24}, {30, 29, 27, 34, 4, 16}, {22, 21, 19, 26, 3, 8}};
        const bool tab = (F.G == 256); const int n2 = tab ? 6 : nun;
#define DIFF_ID(D, i) do { if (tab) { const int e_ = TAB[F.vcu & 7][i]; (D).b = F.vcu >> 3; (D).h = e_ >> 3; (D).qb = e_ & 7; } else attn_coords(i, contig, per, F.vcu, F.G, (D).b, (D).h, (D).qb); \
        { const float s2_ = exp2f(-8.0f * (float)((D).h + 1) / 6.0f) * LOG2E; const int z_ = (int)floorf(((float)((D).qb * 256 - 63) - 200.0f / s2_) * (1.0f / 64.0f)) + 1; (D).t0 = z_ > 0 ? (z_ & ~3) : 0; } } while (0)
        if (n2 > 0) DIFF_ID(UN, 0);
        att::bf16x8 qr[4]; const att::DiffT T{proj, cat};
        for (int i = 0; i < n2; ++i) { U = UN; if (i + 1 < n2) DIFF_ID(UN, i + 1);
            att::diff_unit<8>(T, U, i == 0, i + 1 < n2, UN, qr, lam, (att::lds_ptr)(F.lds + RING_OFF), tid); }
#undef DIFF_ID
    }
    __builtin_amdgcn_s_setprio(0);
    asm volatile("s_waitcnt vmcnt(0) lgkmcnt(0)" ::: "memory"); __syncthreads();
}

__global__ void __launch_bounds__(NWAVES * 64, 2) fwd_kernel(Args args) {
    extern __shared__ __attribute__((aligned(16))) unsigned char lds[];
    Frame F;
    F.lds = (LAS unsigned char*)lds;
    F.MISC = (volatile LAS unsigned*)(F.lds + MISC_OFF);
    F.tid = threadIdx.x; F.lane = F.tid & 63; F.wave = __builtin_amdgcn_readfirstlane(F.tid >> 6);
    F.G = gridDim.x; { const int bx = blockIdx.x; F.vcu = (F.G % 8 == 0) ? (bx % 8) * (F.G / 8) + bx / 8 : bx; }
    F.ws = args.ws; F.ctl = (gu32*)(args.ws + WS_CTL); F.out = args.out;
    for (int u = F.tid; u < (LDS_BYTES - LDSCTL_OFF) / 4; u += NWAVES * 64) ((LAS unsigned*)(F.lds + LDSCTL_OFF))[u] = 0u;
    __syncthreads();
    const int lo = args.ph_lo, hi = args.ph_hi;
    XcdBarrier bar = xcd_barrier_post((unsigned*)(F.ctl + CW_BAR), F.MISC + 8);
#ifndef SITE_MASK
#define SITE_MASK 0xffffffffu
#endif
#define EN(n) (((SITE_MASK) >> (n)) & 1u)
#ifndef DUP_MASK
#define DUP_MASK 0u
#endif
#define DUP(n) (((DUP_MASK) >> (n)) & 1u)
#define IN(k) (lo <= (k) && (k) < hi)
#define WS_OPQ() do { unsigned long long w_ = (unsigned long long)F.ws; asm volatile("" : "+s"(w_)); F.ws = (unsigned char*)w_; } while (0)
#ifndef DUP_BAR
#define DUP_BAR 0
#endif
#define SEAM(k) do { if (IN(k) && IN((k) + 1)) { xcd_barrier(bar); if (DUP_BAR) xcd_barrier(bar); } } while (0)
    const int bx = (int)blockIdx.x;

    if (IN(0) && EN(0)) p0_prologue(F, args);
    if (IN(0) && DUP(0)) p0_prologue(F, args);
    SEAM(0);

#define rope WSP(float, WS_ROPE)
#define ss_x (WSP(float, WS_SSX) + (size_t)l * M * 16)
#define ss_cq (WSP(float, WS_SSCQ) + (size_t)l * M * 4)
#define ss_ckv (WSP(float, WS_SSCKV) + (size_t)l * M * 4)
    { constexpr int l = 0;
        const int pb = l == 0 ? 1 : 7;
        for (int rep_ = 0; rep_ < 1 + (int)DUP(1); ++rep_) if (IN(pb) && EN(1)) {
            WS_OPQ(); pg8::Gemm g{WSP(bf16, WS_XB), WSP(bf16, WS_WIN) + (size_t)l * NPROJ * 1024, 1024, 1024}; pg8::StaticOrder S; S.init(M, NPROJ, F.G, bx);
            pg8::EpiProj E{WSP(bf16, WS_PROJ), l == 0 ? nullptr : ss_x, ss_cq, ss_ckv, WSP(bf16, WS_KR), rope, (const LAS float*)(F.lds + RING_OFF + RSBUF_OFF)};
            pg8::gemm_phase<pg8::EpiProj, pg8::StaticOrder, true, true>(F.lds + RING_OFF, g, S, E, F.wave);
        }
        SEAM(pb);
        if (IN(pb + 1)) {
            if (EN(2)) conv_phase(F, args, l);
            if (DUP(2)) conv_phase(F, args, l);
            for (int rep_ = 0; rep_ < 1 + (int)DUP(3); ++rep_) if (EN(3)) { WS_OPQ(); pg8::Gemm g{WSP(bf16, WS_PROJ) + C_CQ, WSP(bf16, WS_WUQ) + (size_t)l * 768 * 256, NPROJ, 256}; pg8::StaticOrder S; S.init(M, 768, F.G, bx);
              pg8::EpiQ E{WSP(bf16, WS_Q), ss_cq, rope, (const LAS float*)(F.lds + RING_OFF + RSBUF_OFF)};
              pg8::gemm_phase<pg8::EpiQ, pg8::StaticOrder, true, true>(F.lds + RING_OFF, g, S, E, F.wave); }
            for (int rep_ = 0; rep_ < 1 + (int)DUP(4); ++rep_) if (EN(4)) { WS_OPQ(); pg8::Gemm g{WSP(bf16, WS_PROJ) + C_CKV, WSP(bf16, WS_WUKV) + (size_t)l * 768 * 128, NPROJ, 128}; pg8::StaticOrder S; S.init(M, 768, F.G, bx);
              pg8::EpiStore E{WSP(bf16, WS_KV), KVW, nullptr, ss_ckv, 4, 1.0f / 128.0f, RMS_EPS, (const LAS float*)(F.lds + RING_OFF + RSBUF_OFF)};
              pg8::gemm_phase<pg8::EpiStore, pg8::StaticOrder, true, true>(F.lds + RING_OFF, g, S, E, F.wave); }
        }
        SEAM(pb + 1);
        if (IN(pb + 2)) {
            if (DUP(21)) attn_phase<0, 1>(F, l);
            if (DUP(22)) attn_phase<0, 4>(F, l);
            if (DUP(23)) attn_phase<0, 5>(F, l);
            if (DUP(24)) attn_phase<0, 6>(F, l);
            if (DUP(25)) attn_phase<0, 7>(F, l);
            if (DUP(5)) attn_phase<0>(F, l);
            if (EN(5)) attn_phase<0>(F, l);
            if (EN(6)) attn_phase<1>(F, l);
            if (DUP(6)) attn_phase<1>(F, l);
            for (int rep_ = 0; rep_ < 1 + (int)DUP(7); ++rep_) if (EN(7)) { WS_OPQ(); pg8::Gemm g{WSP(bf16, WS_CB), WSP(bf16, WS_WPW) + (size_t)l * 256 * 256, 256, 256}; pg8::StaticOrder S; S.init(M, 256, F.G, bx);
              pg8::EpiStore E{WSP(bf16, WS_CAT), D, args.in[9] + l * 256, nullptr, 1, 0.f, 0.f};
              pg8::gemm_phase<pg8::EpiStore, pg8::StaticOrder, true, true>(F.lds + RING_OFF, g, S, E, F.wave); }
        }
        SEAM(pb + 2);
        if (IN(pb + 3) && EN(8)) {
            WS_OPQ(); pg8::Gemm g{WSP(bf16, WS_CAT), WSP(bf16, WS_WOUT) + (size_t)l * 1024 * 1024, 1024, 1024}; pg8::StaticOrder S; S.init(M, D, F.G, bx);
            pg8::EpiResid E{l == 0 ? args.in[0] : nullptr, WSP(bf16, WS_XB), l == 0 ? WSP(float, WS_SSF) : nullptr};
            pg8::gemm_phase<pg8::EpiResid, pg8::StaticOrder, true, true>(F.lds + RING_OFF, g, S, E, F.wave);
            if (DUP(8)) { pg8::EpiResid E2{nullptr, WSP(bf16, WS_PROJ), nullptr};
                pg8::gemm_phase<pg8::EpiResid, pg8::StaticOrder, true, true>(F.lds + RING_OFF, g, S, E2, F.wave); }
        }
        SEAM(pb + 3);
        if (l == 0) {
            if (IN(5) && DUP(16)) { WS_OPQ(); pg8::Gemm g{WSP(bf16, WS_XB), WSP(bf16, WS_WGUD), 1024, 1024}; pg8::StaticOrder S; S.init(M, NGU, F.G, bx);
                pg8::EpiNull E; pg8::gemm_phase<pg8::EpiNull, pg8::StaticOrder, true, true>(F.lds + RING_OFF, g, S, E, F.wave); }
            if (IN(5) && DUP(20)) { WS_OPQ(); pg8::Gemm g{WSP(bf16, WS_XB), WSP(bf16, WS_WGUD), 1024, 1024}; pg8::FixedOrder S; S.init(M, NGU, F.G, bx);
                pg8::EpiNull E; pg8::gemm_phase<pg8::EpiNull, pg8::FixedOrder, true, true>(F.lds + RING_OFF, g, S, E, F.wave); }
            if (IN(5) && DUP(17)) { WS_OPQ(); pg8::Gemm g{WSP(bf16, WS_XB), WSP(bf16, WS_WGUD), 1024, 1024}; pg8::StaticOrder S; S.init(M, NGU, F.G, bx);
                pg8::EpiSwiGLU_<1> E{WSP(bf16, WS_ACT), WSP(float, WS_SSF), 16, 22}; pg8::gemm_phase<pg8::EpiSwiGLU_<1>, pg8::StaticOrder, true, true>(F.lds + RING_OFF, g, S, E, F.wave); }
            if (IN(5) && DUP(18)) { WS_OPQ(); pg8::Gemm g{WSP(bf16, WS_XB), WSP(bf16, WS_WGUD), 1024, 1024}; pg8::StaticOrder S; S.init(M, NGU, F.G, bx);
                pg8::EpiSwiGLU_<2> E{WSP(bf16, WS_ACT), WSP(float, WS_SSF), 16, 22}; pg8::gemm_phase<pg8::EpiSwiGLU_<2>, pg8::StaticOrder, true, true>(F.lds + RING_OFF, g, S, E, F.wave); }
            if (IN(5) && EN(9) && !DUP(19)) {
                WS_OPQ(); pg8::Gemm g{WSP(bf16, WS_XB), WSP(bf16, WS_WGUD), 1024, 1024}; pg8::StaticOrder S; S.init(M, NGU, F.G, bx);
                pg8::EpiSwiGLUd8 E{WSP(bf16, WS_ACT), WSP(float, WS_SSF), 16, 22, (const LAS float*)(F.lds + RING_OFF + RSBUF_OFF)};
                pg8::gemm_phase<pg8::EpiSwiGLUd8, pg8::StaticOrder, true, true>(F.lds + RING_OFF, g, S, E, F.wave);
            }
            if (IN(5) && EN(9) && DUP(19)) {
                WS_OPQ(); pg8::Gemm g{WSP(bf16, WS_XB), WSP(bf16, WS_WGUD), 1024, 1024}; pg8::RangeOrder S; S.init(M, NGU, F.G, bx); S.i0 = 0; S.i1 = 11;
                pg8::EpiSwiGLU E{WSP(bf16, WS_ACT), WSP(float, WS_SSF), 16, 22};
                pg8::gemm_phase<pg8::EpiSwiGLU, pg8::RangeOrder, true, true>(F.lds + RING_OFF, g, S, E, F.wave);
                xcd_barrier(bar);
                S.i0 = 11; S.i1 = 22;
                pg8::gemm_phase<pg8::EpiSwiGLU, pg8::RangeOrder, true, true>(F.lds + RING_OFF, g, S, E, F.wave);
            }
            SEAM(5);
            if (IN(6) && EN(10)) {
                WS_OPQ(); pg8::Gemm g{WSP(bf16, WS_ACT), WSP(bf16, WS_WDD), FF / 2, FF / 2}; pg8::StaticOrder S; S.init(M, D, F.G, bx);
                pg8::EpiResid E{nullptr, WSP(bf16, WS_XB), WSP(float, WS_SSX) + (size_t)M * 16, 1.0f / (QS_ACT * QS_D)};
                pg8::gemm_phase<pg8::EpiResid, pg8::StaticOrder, true, true, false, true>(F.lds + RING_OFF, g, S, E, F.wave);
                if (DUP(10)) { pg8::EpiResid E2{nullptr, WSP(bf16, WS_KV), nullptr};
                    pg8::gemm_phase<pg8::EpiResid, pg8::StaticOrder, true, true>(F.lds + RING_OFF, g, S, E2, F.wave); }
            }
            SEAM(6);
        }
    }
    { constexpr int l = 1;
        const int pb = l == 0 ? 1 : 7;
        for (int rep_ = 0; rep_ < 1 + (int)DUP(1); ++rep_) if (IN(pb) && EN(1)) {
            WS_OPQ(); pg8::Gemm g{WSP(bf16, WS_XB), WSP(bf16, WS_WIN) + (size_t)l * NPROJ * 1024, 1024, 1024}; pg8::StaticOrder S; S.init(M, NPROJ, F.G, bx);
            pg8::EpiProj E{WSP(bf16, WS_PROJ), l == 0 ? nullptr : ss_x, ss_cq, ss_ckv, WSP(bf16, WS_KR), rope, (const LAS float*)(F.lds + RING_OFF + RSBUF_OFF)};
            pg8::gemm_phase<pg8::EpiProj, pg8::StaticOrder, true, true>(F.lds + RING_OFF, g, S, E, F.wave);
        }
        SEAM(pb);
        if (IN(pb + 1)) {
            if (EN(2)) conv_phase(F, args, l);
            if (DUP(2)) conv_phase(F, args, l);
            for (int rep_ = 0; rep_ < 1 + (int)DUP(3); ++rep_) if (EN(3)) { WS_OPQ(); pg8::Gemm g{WSP(bf16, WS_PROJ) + C_CQ, WSP(bf16, WS_WUQ) + (size_t)l * 768 * 256, NPROJ, 256}; pg8::StaticOrder S; S.init(M, 768, F.G, bx);
              pg8::EpiQ E{WSP(bf16, WS_Q), ss_cq, rope, (const LAS float*)(F.lds + RING_OFF + RSBUF_OFF)};
              pg8::gemm_phase<pg8::EpiQ, pg8::StaticOrder, true, true>(F.lds + RING_OFF, g, S, E, F.wave); }
            for (int rep_ = 0; rep_ < 1 + (int)DUP(4); ++rep_) if (EN(4)) { WS_OPQ(); pg8::Gemm g{WSP(bf16, WS_PROJ) + C_CKV, WSP(bf16, WS_WUKV) + (size_t)l * 768 * 128, NPROJ, 128}; pg8::StaticOrder S; S.init(M, 768, F.G, bx);
              pg8::EpiStore E{WSP(bf16, WS_KV), KVW, nullptr, ss_ckv, 4, 1.0f / 128.0f, RMS_EPS, (const LAS float*)(F.lds + RING_OFF + RSBUF_OFF)};
              pg8::gemm_phase<pg8::EpiStore, pg8::StaticOrder, true, true>(F.lds + RING_OFF, g, S, E, F.wave); }
        }
        SEAM(pb + 1);
        if (IN(pb + 2)) {
            if (DUP(21)) attn_phase<0, 1>(F, l);
            if (DUP(22)) attn_phase<0, 4>(F, l);
            if (DUP(23)) attn_phase<0, 5>(F, l);
            if (DUP(24)) attn_phase<0, 6>(F, l);
            if (DUP(25)) attn_phase<0, 7>(F, l);
            if (DUP(5)) attn_phase<0>(F, l);
            if (EN(5)) attn_phase<0>(F, l);
            if (EN(6)) attn_phase<1>(F, l);
            if (DUP(6)) attn_phase<1>(F, l);
            for (int rep_ = 0; rep_ < 1 + (int)DUP(7); ++rep_) if (EN(7)) { WS_OPQ(); pg8::Gemm g{WSP(bf16, WS_CB), WSP(bf16, WS_WPW) + (size_t)l * 256 * 256, 256, 256}; pg8::StaticOrder S; S.init(M, 256, F.G, bx);
              pg8::EpiStore E{WSP(bf16, WS_CAT), D, args.in[9] + l * 256, nullptr, 1, 0.f, 0.f};
              pg8::gemm_phase<pg8::EpiStore, pg8::StaticOrder, true, true>(F.lds + RING_OFF, g, S, E, F.wave); }
        }
        SEAM(pb + 2);
        if (IN(pb + 3) && EN(8)) {
            WS_OPQ(); pg8::Gemm g{WSP(bf16, WS_CAT), WSP(bf16, WS_WOUT) + (size_t)l * 1024 * 1024, 1024, 1024}; pg8::StaticOrder S; S.init(M, D, F.G, bx);
            pg8::EpiResid E{l == 0 ? args.in[0] : nullptr, WSP(bf16, WS_XB), l == 0 ? WSP(float, WS_SSF) : nullptr};
            pg8::gemm_phase<pg8::EpiResid, pg8::StaticOrder, true, true>(F.lds + RING_OFF, g, S, E, F.wave);
            if (DUP(8)) { pg8::EpiResid E2{nullptr, WSP(bf16, WS_PROJ), nullptr};
                pg8::gemm_phase<pg8::EpiResid, pg8::StaticOrder, true, true>(F.lds + RING_OFF, g, S, E2, F.wave); }
        }
        SEAM(pb + 3);
        if (l == 0) {
            if (IN(5) && DUP(16)) { WS_OPQ(); pg8::Gemm g{WSP(bf16, WS_XB), WSP(bf16, WS_WGUD), 1024, 1024}; pg8::StaticOrder S; S.init(M, NGU, F.G, bx);
                pg8::EpiNull E; pg8::gemm_phase<pg8::EpiNull, pg8::StaticOrder, true, true>(F.lds + RING_OFF, g, S, E, F.wave); }
            if (IN(5) && DUP(20)) { WS_OPQ(); pg8::Gemm g{WSP(bf16, WS_XB), WSP(bf16, WS_WGUD), 1024, 1024}; pg8::FixedOrder S; S.init(M, NGU, F.G, bx);
                pg8::EpiNull E; pg8::gemm_phase<pg8::EpiNull, pg8::FixedOrder, true, true>(F.lds + RING_OFF, g, S, E, F.wave); }
            if (IN(5) && DUP(17)) { WS_OPQ(); pg8::Gemm g{WSP(bf16, WS_XB), WSP(bf16, WS_WGUD), 1024, 1024}; pg8::StaticOrder S; S.init(M, NGU, F.G, bx);
                pg8::EpiSwiGLU_<1> E{WSP(bf16, WS_ACT), WSP(float, WS_SSF), 16, 22}; pg8::gemm_phase<pg8::EpiSwiGLU_<1>, pg8::StaticOrder, true, true>(F.lds + RING_OFF, g, S, E, F.wave); }
            if (IN(5) && DUP(18)) { WS_OPQ(); pg8::Gemm g{WSP(bf16, WS_XB), WSP(bf16, WS_WGUD), 1024, 1024}; pg8::StaticOrder S; S.init(M, NGU, F.G, bx);
                pg8::EpiSwiGLU_<2> E{WSP(bf16, WS_ACT), WSP(float, WS_SSF), 16, 22}; pg8::gemm_phase<pg8::EpiSwiGLU_<2>, pg8::StaticOrder, true, true>(F.lds + RING_OFF, g, S, E, F.wave); }
            if (IN(5) && EN(9) && !DUP(19)) {
                WS_OPQ(); pg8::Gemm g{WSP(bf16, WS_XB), WSP(bf16, WS_WGUD), 1024, 1024}; pg8::StaticOrder S; S.init(M, NGU, F.G, bx);
                pg8::EpiSwiGLUd8 E{WSP(bf16, WS_ACT), WSP(float, WS_SSF), 16, 22, (const LAS float*)(F.lds + RING_OFF + RSBUF_OFF)};
                pg8::gemm_phase<pg8::EpiSwiGLUd8, pg8::StaticOrder, true, true>(F.lds + RING_OFF, g, S, E, F.wave);
            }
            if (IN(5) && EN(9) && DUP(19)) {
                WS_OPQ(); pg8::Gemm g{WSP(bf16, WS_XB), WSP(bf16, WS_WGUD), 1024, 1024}; pg8::RangeOrder S; S.init(M, NGU, F.G, bx); S.i0 = 0; S.i1 = 11;
                pg8::EpiSwiGLU E{WSP(bf16, WS_ACT), WSP(float, WS_SSF), 16, 22};
                pg8::gemm_phase<pg8::EpiSwiGLU, pg8::RangeOrder, true, true>(F.lds + RING_OFF, g, S, E, F.wave);
                xcd_barrier(bar);
                S.i0 = 11; S.i1 = 22;
                pg8::gemm_phase<pg8::EpiSwiGLU, pg8::RangeOrder, true, true>(F.lds + RING_OFF, g, S, E, F.wave);
            }
            SEAM(5);
            if (IN(6) && EN(10)) {
                WS_OPQ(); pg8::Gemm g{WSP(bf16, WS_ACT), WSP(bf16, WS_WDD), FF / 2, FF / 2}; pg8::StaticOrder S; S.init(M, D, F.G, bx);
                pg8::EpiResid E{nullptr, WSP(bf16, WS_XB), WSP(float, WS_SSX) + (size_t)M * 16, 1.0f / (QS_ACT * QS_D)};
                pg8::gemm_phase<pg8::EpiResid, pg8::StaticOrder, true, true, false, true>(F.lds + RING_OFF, g, S, E, F.wave);
                if (DUP(10)) { pg8::EpiResid E2{nullptr, WSP(bf16, WS_KV), nullptr};
                    pg8::gemm_phase<pg8::EpiResid, pg8::StaticOrder, true, true>(F.lds + RING_OFF, g, S, E2, F.wave); }
            }
            SEAM(6);
        }
    }
    if (IN(11) && EN(11)) router_phase(F, args);
    SEAM(11);
    for (int k = 0; k < 6; ++k) {
        const int ph = 12 + k;
        if (IN(ph)) {
            moe_prefix(F);
            const int TT = (int)F.MISC[32];
            if (k >= 1 && EN(14)) { const int c = k - 1, ta = c * 128 < TT ? c * 128 : TT, tb = (c + 1) * 128 < TT ? (c + 1) * 128 : TT;
                WS_OPQ(); pg8::Gemm g{WSP(bf16, (c & 1) ? WS_ACT1 : WS_ACT0), WSP(bf16, WS_WDE), FF / 2, FF / 2};
                pg8::MoeOrder S{tb - ta, 4, ta, F.G, bx, (const PG8_LAS int*)(F.lds + MISC_OFF + 64), WSP(int, WS_LIST)};
                pg8::EpiScatter E{WSP(bf16, WS_XB), WSP(bf16, WS_Y1), WSP(int, WS_LIST), WSP(float, WS_WGT), 1.0f / (QS_ACT * QS_D)};
                pg8::gemm_phase<pg8::EpiScatter, pg8::MoeOrder, true, true, false, true>(F.lds + RING_OFF, g, S, E, F.wave); }
            if (k <= 4 && EN(13)) { const int c = k, ta = c * 128 < TT ? c * 128 : TT, tb = (c + 1) * 128 < TT ? (c + 1) * 128 : TT;
                WS_OPQ(); pg8::Gemm g{WSP(bf16, WS_HB3), WSP(bf16, WS_WGUE), 512, 512};
                pg8::MoeOrder S{tb - ta, 22, ta, F.G, bx, (const PG8_LAS int*)(F.lds + MISC_OFF + 64), WSP(int, WS_LIST)};
                pg8::EpiSwiGLU8 E{WSP(bf16, (c & 1) ? WS_ACT1 : WS_ACT0), nullptr, 1, 22};
                pg8::gemm_phase<pg8::EpiSwiGLU8, pg8::MoeOrder, true, true, true, true>(F.lds + RING_OFF, g, S, E, F.wave);
                if (DUP(13)) pg8::gemm_phase<pg8::EpiSwiGLU8, pg8::MoeOrder, true, true, true, true>(F.lds + RING_OFF, g, S, E, F.wave);
                if (DUP(19)) { pg8::EpiNull E0; pg8::gemm_phase<pg8::EpiNull, pg8::MoeOrder, true, true, true, true>(F.lds + RING_OFF, g, S, E0, F.wave); } }
        }
        SEAM(ph);
    }
    if (IN(18) && EN(15)) final_phase(F, args);
#undef rope
#undef ss_x
#undef ss_cq
#undef ss_ckv
#undef IN
#undef SEAM
}

#ifndef MK_N_LAUNCHES
#define MK_N_LAUNCHES 1
#endif
extern "C" void kernel_launch(void* const* d_in, const int* in_sizes, int n_in, void* d_out, int out_size, void* d_ws, size_t ws_size, hipStream_t stream) {
    static int grid = 0;
    if (grid == 0) {
        if (n_in != 29 || in_sizes[0] != M * D || out_size != M * D || ws_size < WS_END) { fprintf(stderr, "kernel_launch: unexpected sizes: n_in %d in0 %d out %d ws %zu (need %zu)\n", n_in, n_in > 0 ? in_sizes[0] : -1, out_size, ws_size, (size_t)WS_END); grid = -1; return; }
        int dev = 0, cus = 0, per_cu = 0;
        if (hipGetDevice(&dev) != hipSuccess || hipDeviceGetAttribute(&cus, hipDeviceAttributeMultiprocessorCount, dev) != hipSuccess) { grid = -1; return; }
        if (hipFuncSetAttribute((const void*)fwd_kernel, hipFuncAttributeMaxDynamicSharedMemorySize, LDS_BYTES) != hipSuccess) { fprintf(stderr, "kernel_launch: hipFuncSetAttribute failed\n"); grid = -1; return; }
        if (hipOccupancyMaxActiveBlocksPerMultiprocessor(&per_cu, (const void*)fwd_kernel, NWAVES * 64, LDS_BYTES) != hipSuccess || per_cu < 1)
            fprintf(stderr, "kernel_launch: note: occupancy query reports %d workgroups per CU\n", per_cu);
        (void)hipGetLastError();
        grid = cus;
    }
    if (grid < 0) return;
    if (hipMemsetAsync((char*)d_ws + WS_CTL, 0, CTL_ZERO_BYTES, stream) != hipSuccess) return;
    Args a{};
    for (int i = 0; i < 29; ++i) a.in[i] = (const float*)d_in[i];
    a.out = (float*)d_out; a.ws = (unsigned char*)d_ws;
#if MK_N_LAUNCHES == 1
    a.ph_lo = 0; a.ph_hi = NPHASE;
    hipLaunchKernelGGL(fwd_kernel, dim3(grid), dim3(NWAVES * 64), LDS_BYTES, stream, a);
#else
    for (int p = 0; p < NPHASE; ++p) { a.ph_lo = p; a.ph_hi = p + 1; hipLaunchKernelGGL(fwd_kernel, dim3(grid), dim3(NWAVES * 64), LDS_BYTES, stream, a); }
#endif
}
```

```cpp
#include <hip/hip_runtime.h>
#include <cstdio>
#include <cstdint>
namespace pg8 {
#define PG8_LAS __attribute__((address_space(3)))
typedef unsigned short bf16_t;
typedef short bf16x8 __attribute__((ext_vector_type(8)));
typedef float f32x4 __attribute__((ext_vector_type(4)));
typedef unsigned u32x4 __attribute__((ext_vector_type(4)));
constexpr int BM = 256, BK = 64, HALF = 128, HTB = HALF * BK * 2  , STAGE_BYTES = 8 * HTB, NXCD = 8, WGM = 8;

__host__ __device__ __forceinline__ int lds_byte(int r, int c) { const int st = (r >> 4) * 2 + (c >> 5), rr = r & 15, cc = c & 31, ob = rr * 64 + cc * 2; return st * 1024 + (ob ^ (((ob >> 9) & 1) << 5)); }
__host__ __device__ __forceinline__ void stage_rc(int b, int& R, int& C) { const int st = b / 1024, sb = b % 1024, swz = sb ^ (((sb >> 9) & 1) << 5); R = (st >> 1) * 16 + swz / 64; C = (st & 1) * 32 + (swz % 64) / 2; }
__host__ __device__ __forceinline__ int perm32(int rho) { const int n = rho >> 4, i = rho & 15; return 8 * (i >> 2) + 4 * n + (i & 3); }

struct Unit { int pm, pn, aux, aux2, aux3; };
struct Gemm { const bf16_t* A; const bf16_t* Bt; int lda, K; };

struct StaticOrder {
    int nM, nN, nwg, G, c;
    __host__ __device__ void init(int M, int N, int G_, int c_) { nM = M / BM; nN = N / BM; nwg = nM * nN; G = G_; c = c_; }
    __host__ __device__ bool next(int i, Unit& u) const {
        const long L = (long)i * G + c; if (L >= nwg) return false;
        int wgid = (int)L; { const int q = nwg / NXCD, r = nwg % NXCD, xcd = wgid % NXCD, off = wgid / NXCD; wgid = (xcd < r ? xcd * (q + 1) : r * (q + 1) + (xcd - r) * q) + off; }
        const int nig = WGM * nN, gid = wgid / nig, fm = gid * WGM, gsz = (nM - fm) < WGM ? (nM - fm) : WGM;
        u.pm = fm + ((wgid % nig) % gsz); u.pn = (wgid % nig) / gsz; return true;
    }
    __device__ __forceinline__ void a_ready(const Unit&) const {}
    __device__ __forceinline__ void done(const Unit&) const {}
};

__device__ __forceinline__ unsigned cvt_pk_bf16(float lo, float hi) { unsigned r; asm volatile("v_cvt_pk_bf16_f32 %0, %1, %2" : "=v"(r) : "v"(lo), "v"(hi)); return r; }
typedef float f32x2 __attribute__((ext_vector_type(2)));
typedef int i32x4 __attribute__((ext_vector_type(4)));
typedef int i32x8 __attribute__((ext_vector_type(8)));
#define PG8_RSBUF 147456
#define PG8_TOKBUF (131072 + 4096)
#ifndef FP8_SCALE1
#define FP8_SCALE1 0
#endif
__device__ __forceinline__ i32x8 cat8(bf16x8 a, bf16x8 b) { return __builtin_shufflevector(__builtin_bit_cast(i32x4, a), __builtin_bit_cast(i32x4, b), 0, 1, 2, 3, 4, 5, 6, 7); }
typedef float f32x8 __attribute__((ext_vector_type(8)));
typedef float f32x16 __attribute__((ext_vector_type(16)));
typedef float f32x32 __attribute__((ext_vector_type(32)));
__device__ __forceinline__ f32x32 cat32(f32x4 a, f32x4 b, f32x4 c, f32x4 d, f32x4 e, f32x4 f, f32x4 g, f32x4 h) {
    const f32x8 p = __builtin_shufflevector(a, b, 0, 1, 2, 3, 4, 5, 6, 7), q = __builtin_shufflevector(c, d, 0, 1, 2, 3, 4, 5, 6, 7), r = __builtin_shufflevector(e, f, 0, 1, 2, 3, 4, 5, 6, 7), s = __builtin_shufflevector(g, h, 0, 1, 2, 3, 4, 5, 6, 7);
    const f32x16 u = __builtin_shufflevector(p, q, 0, 1, 2, 3, 4, 5, 6, 7, 8, 9, 10, 11, 12, 13, 14, 15), v = __builtin_shufflevector(r, s, 0, 1, 2, 3, 4, 5, 6, 7, 8, 9, 10, 11, 12, 13, 14, 15);
    return __builtin_shufflevector(u, v, 0, 1, 2, 3, 4, 5, 6, 7, 8, 9, 10, 11, 12, 13, 14, 15, 16, 17, 18, 19, 20, 21, 22, 23, 24, 25, 26, 27, 28, 29, 30, 31); }
template <class Epi, class Sched, bool ALIGN_EPI = false, bool SP2 = false, bool GATHER = false, bool FP8 = false>
__device__ __forceinline__ void gemm_phase(PG8_LAS unsigned char* lds, const Gemm g, const Sched& S, const Epi& E, int wave_idx) {
    int tid_ = wave_idx * 64 + (int)__builtin_amdgcn_mbcnt_hi(~0u, __builtin_amdgcn_mbcnt_lo(~0u, 0u)); asm volatile("" : "+v"(tid_));
    const int tid = tid_, wid = __builtin_amdgcn_readfirstlane(tid >> 6), lane = tid & 63, wr = wid >> 2, wc = wid & 3, fr = lane & 15, fq = lane >> 4;
    const int K = g.K, lda = g.lda; int nt_ = K / BK; asm volatile("" : "+s"(nt_)); const int nt = nt_;
    unsigned voffA[2], voffB[2]; int rA_[2]; unsigned cA_[2]; unsigned gcur[2][2], gnxt[2][2];
#pragma unroll
    for (int i = 0; i < 2; ++i) { int R, C; stage_rc(tid * 16 + i * 8192, R, C); const int Rb = Epi::PERM ? ((R & ~31) + perm32(R & 31)) : R;
        voffA[i] = (unsigned)(R * lda + C) * 2u; rA_[i] = R; cA_[i] = (unsigned)C * 2u; voffB[i] = (unsigned)(Rb * K + C) * 2u; }
    const size_t kstep = (size_t)(BK * 2);
    const size_t hstepA = (size_t)HALF * lda * 2, hstepB = (size_t)HALF * K * 2;
    const size_t tstepA = GATHER ? 0 : 2 * hstepA, tstepB = 2 * hstepB;
    const unsigned ldsw = (unsigned)wid * 1024u;
    const int aoff = lds_byte(wr * 64 + fr, fq * 8), boff = lds_byte(wc * 32 + fr, fq * 8);
#define PG8_SA(b, h) (((b) * 2 + (h)) * HTB)
#define PG8_SB(b, h) ((4 + (b) * 2 + (h)) * HTB)
#define PG8_STAGE(bufoff, gbase, voff) do { _Pragma("unroll") for (int _i = 0; _i < 2; ++_i) \
        __builtin_amdgcn_global_load_lds((const unsigned*)((const char*)(gbase) + (voff)[_i]), (PG8_LAS unsigned*)(lds + (bufoff) + ldsw + _i * 8192), 16, 0, 0); } while (0)
#define PG8_STAGE_A(bufoff, gbase, h, NX) do { if constexpr (GATHER) { _Pragma("unroll") for (int _i = 0; _i < 2; ++_i) { const unsigned o_ = (NX) ? gnxt[h][_i] : gcur[h][_i]; \
        __builtin_amdgcn_global_load_lds((const unsigned*)((const char*)(gbase) + o_), (PG8_LAS unsigned*)(lds + (bufoff) + ldsw + _i * 8192), 16, 0, 0); } } \
    else { PG8_STAGE(bufoff, (const char*)(gbase) + (h) * hstepA, voffA); } } while (0)
#define PG8_LDA(dst, b, h) do { _Pragma("unroll") for (int m = 0; m < 4; ++m) _Pragma("unroll") for (int k = 0; k < 2; ++k) dst[m][k] = *(const PG8_LAS bf16x8*)(lds + PG8_SA(b, h) + aoff + m * 2048 + k * 1024); } while (0)
#define PG8_LDB(dst, b, h) do { _Pragma("unroll") for (int n = 0; n < 2; ++n) _Pragma("unroll") for (int k = 0; k < 2; ++k) dst[n][k] = *(const PG8_LAS bf16x8*)(lds + PG8_SB(b, h) + boff + n * 2048 + k * 1024); } while (0)
#define PG8_MMA(ai, bj, At, Bt) do { if constexpr (FP8 && bj == 0) { PG8_FRAG_ANCHOR("v[160:191]", At[0][0], At[0][1], At[1][0], At[1][1], At[2][0], At[2][1], At[3][0], At[3][1]); PG8_FRAG_ANCHOR("v[128:159]", B0[0][0], B0[0][1], B0[1][0], B0[1][1], B1[0][0], B1[0][1], B1[1][0], B1[1][1]); } \
        __builtin_amdgcn_s_setprio(1); _Pragma("unroll") for (int m = 0; m < 4; ++m) _Pragma("unroll") for (int n = 0; n < 2; ++n) { \
        if constexpr (FP8) acc[ai][bj][m][n] = __builtin_amdgcn_mfma_scale_f32_16x16x128_f8f6f4(cat8(Bt[n][0], Bt[n][1]), cat8(At[m][0], At[m][1]), acc[ai][bj][m][n], 0, 0, 0, FP8_SCALE1, 0, FP8_SCALE1); \
        else { _Pragma("unroll") for (int k = 0; k < 2; ++k) acc[ai][bj][m][n] = __builtin_amdgcn_mfma_f32_16x16x32_bf16(Bt[n][k], At[m][k], acc[ai][bj][m][n], 0, 0, 0); } } __builtin_amdgcn_s_setprio(0); } while (0)
#define PG8_FRAG_ANCHOR(REG, f0, f1, f2, f3, f4, f5, f6, f7) do { f32x32 big_ = cat32(__builtin_bit_cast(f32x4, f0), __builtin_bit_cast(f32x4, f1), __builtin_bit_cast(f32x4, f2), __builtin_bit_cast(f32x4, f3), __builtin_bit_cast(f32x4, f4), __builtin_bit_cast(f32x4, f5), __builtin_bit_cast(f32x4, f6), __builtin_bit_cast(f32x4, f7)); asm volatile("" : "+{" REG "}"(big_)); \
        f0 = __builtin_bit_cast(bf16x8, (f32x4)__builtin_shufflevector(big_, big_, 0, 1, 2, 3)); f1 = __builtin_bit_cast(bf16x8, (f32x4)__builtin_shufflevector(big_, big_, 4, 5, 6, 7)); f2 = __builtin_bit_cast(bf16x8, (f32x4)__builtin_shufflevector(big_, big_, 8, 9, 10, 11)); f3 = __builtin_bit_cast(bf16x8, (f32x4)__builtin_shufflevector(big_, big_, 12, 13, 14, 15)); \
        f4 = __builtin_bit_cast(bf16x8, (f32x4)__builtin_shufflevector(big_, big_, 16, 17, 18, 19)); f5 = __builtin_bit_cast(bf16x8, (f32x4)__builtin_shufflevector(big_, big_, 20, 21, 22, 23)); f6 = __builtin_bit_cast(bf16x8, (f32x4)__builtin_shufflevector(big_, big_, 24, 25, 26, 27)); f7 = __builtin_bit_cast(bf16x8, (f32x4)__builtin_shufflevector(big_, big_, 28, 29, 30, 31)); } while (0)
#define PG8_WAIT_V(n) asm volatile("s_waitcnt vmcnt(" #n ")" ::: "memory")
#define PG8_WAIT_L(n) asm volatile("s_waitcnt lgkmcnt(" #n ")" ::: "memory")
#define PG8_BAR __builtin_amdgcn_s_barrier()
#define PG8_SCHED __builtin_amdgcn_sched_barrier(0)
    Unit cur, nxt; int ui = 0;
    if (!S.next(0, cur)) return;
    if constexpr (GATHER) {
#pragma unroll
        for (int h_ = 0; h_ < 2; ++h_)
#pragma unroll
            for (int i_ = 0; i_ < 2; ++i_) { gcur[h_][i_] = (unsigned)S.row_tok(cur, h_ * HALF + rA_[i_]) * (unsigned)(lda * 2) + cA_[i_]; gnxt[h_][i_] = gcur[h_][i_]; } }
#define PG8_ANCHOR() do { if constexpr (FP8) { _Pragma("unroll") for (int a_ = 0; a_ < 2; ++a_) _Pragma("unroll") for (int b_ = 0; b_ < 2; ++b_) { \
        f32x32 big_ = cat32(acc[a_][b_][0][0], acc[a_][b_][0][1], acc[a_][b_][1][0], acc[a_][b_][1][1], acc[a_][b_][2][0], acc[a_][b_][2][1], acc[a_][b_][3][0], acc[a_][b_][3][1]); if (a_ == 0 && b_ == 0) asm volatile("" : "+{v[0:31]}"(big_)); else if (a_ == 0) asm volatile("" : "+{v[32:63]}"(big_)); else if (b_ == 0) asm volatile("" : "+{v[64:95]}"(big_)); else asm volatile("" : "+{v[96:127]}"(big_)); \
        acc[a_][b_][0][0] = __builtin_shufflevector(big_, big_, 0, 1, 2, 3); acc[a_][b_][0][1] = __builtin_shufflevector(big_, big_, 4, 5, 6, 7); acc[a_][b_][1][0] = __builtin_shufflevector(big_, big_, 8, 9, 10, 11); acc[a_][b_][1][1] = __builtin_shufflevector(big_, big_, 12, 13, 14, 15); \
        acc[a_][b_][2][0] = __builtin_shufflevector(big_, big_, 16, 17, 18, 19); acc[a_][b_][2][1] = __builtin_shufflevector(big_, big_, 20, 21, 22, 23); acc[a_][b_][3][0] = __builtin_shufflevector(big_, big_, 24, 25, 26, 27); acc[a_][b_][3][1] = __builtin_shufflevector(big_, big_, 28, 29, 30, 31); } } } while (0)
    f32x4 acc[2][2][4][2];
#pragma unroll
    for (int a = 0; a < 2; ++a)
#pragma unroll
        for (int b = 0; b < 2; ++b)
#pragma unroll
            for (int m = 0; m < 4; ++m)
#pragma unroll
                for (int n = 0; n < 2; ++n) acc[a][b][m][n] = (f32x4){0.f, 0.f, 0.f, 0.f};
    PG8_ANCHOR();
    bf16x8 At[4][2], B0[2][2], B1[2][2];
    const char* cA = (const char*)g.A + (size_t)cur.pm * tstepA; const char* cB = (const char*)g.Bt + (size_t)cur.pn * tstepB;
    S.a_ready(cur);
    if constexpr (SP2) {
        PG8_STAGE(PG8_SB(0, 0), cB, voffB); PG8_STAGE(PG8_SB(0, 1), cB + hstepB, voffB); PG8_STAGE_A(PG8_SA(0, 0), cA, 0, false); PG8_STAGE_A(PG8_SA(0, 1), cA, 1, false);
        if (wr == 1) PG8_BAR;
        PG8_WAIT_V(2); PG8_BAR;
        PG8_STAGE(PG8_SB(1, 0), cB + kstep, voffB); PG8_STAGE_A(PG8_SA(1, 0), cA + kstep, 0, false); PG8_STAGE(PG8_SB(1, 1), cB + hstepB + kstep, voffB);
        PG8_WAIT_V(6); PG8_BAR;
    } else {
        PG8_STAGE(PG8_SB(0, 0), cB, voffB); PG8_STAGE_A(PG8_SA(0, 0), cA, 0, false); PG8_STAGE(PG8_SB(0, 1), cB + hstepB, voffB); PG8_STAGE_A(PG8_SA(0, 1), cA, 1, false);
        if (wr == 1) PG8_BAR;
        PG8_WAIT_V(4); PG8_BAR;
        PG8_STAGE(PG8_SB(1, 0), cB + kstep, voffB); PG8_STAGE_A(PG8_SA(1, 0), cA + kstep, 0, false); PG8_STAGE(PG8_SB(1, 1), cB + hstepB + kstep, voffB);
        PG8_WAIT_V(6); PG8_BAR;
    }
    for (;;) {
        bool has_next = false; const char* nA = cA; const char* nB = cB;
        _Pragma("nounroll") for (int t = 0; t < nt; t += 2) {
            const bool last = (t == nt - 2);
            const char* a1 = cA + (size_t)(t + 1) * kstep;
            if constexpr (SP2) {
            PG8_LDB(B0, 0, 0); PG8_LDB(B1, 0, 1); PG8_SCHED; PG8_LDA(At, 0, 0); PG8_STAGE_A(PG8_SA(1, 1), a1, 1, false);
            PG8_WAIT_V(8); PG8_WAIT_L(0); PG8_BAR; PG8_MMA(0, 0, At, B0); PG8_MMA(0, 1, At, B1); PG8_BAR; PG8_SCHED;
            if (t == 0) {
        if constexpr (Epi::RSNP == 16) { const char* rp_ = (const char*)E.rs_src(cur);
            if (rp_) { _Pragma("unroll") for (int i_ = 0; i_ < 2; ++i_) __builtin_amdgcn_global_load_lds((const unsigned*)(rp_ + tid * 16 + i_ * 8192), (PG8_LAS unsigned*)(lds + PG8_RSBUF + wid * 1024 + i_ * 8192), 16, 0, 0); } }
        if constexpr (Epi::RSNP == 4) { const char* rp_ = (const char*)E.rs_src(cur);
            if (rp_ && wid < 4) __builtin_amdgcn_global_load_lds((const unsigned*)(rp_ + tid * 16), (PG8_LAS unsigned*)(lds + PG8_RSBUF + wid * 1024), 16, 0, 0); }
has_next = S.next(ui + 1, nxt);
        if constexpr (GATHER) { if (has_next && wid < 4) {
            __builtin_amdgcn_global_load_lds((const unsigned*)(S.row_ptr(nxt) + tid), (PG8_LAS unsigned*)(lds + PG8_TOKBUF + wid * 256), 4, 0, 0); } }
        nA = has_next ? (const char*)g.A + (size_t)nxt.pm * tstepA : cA; nB = has_next ? (const char*)g.Bt + (size_t)nxt.pn * tstepB : cB;
            }
            const char* a2 = last ? nA : cA + (size_t)(t + 2) * kstep; const char* b2 = last ? nB : cB + (size_t)(t + 2) * kstep;
            const char* a3 = a2 + kstep; const char* b3 = b2 + kstep;
            if (last && has_next) S.a_ready(nxt);
            if constexpr (GATHER) { if (last && has_next) { asm volatile("" ::: "memory");
#pragma unroll
                for (int h_ = 0; h_ < 2; ++h_)
#pragma unroll
                    for (int i_ = 0; i_ < 2; ++i_) { const int tk_ = *(const PG8_LAS int*)(lds + PG8_TOKBUF + (h_ * HALF + rA_[i_]) * 4); gnxt[h_][i_] = (unsigned)(tk_ & 0xffff) * (unsigned)(lda * 2) + cA_[i_]; } } }
            PG8_LDA(At, 0, 1); PG8_STAGE(PG8_SB(0, 0), b2, voffB); PG8_STAGE(PG8_SB(0, 1), b2 + hstepB, voffB); PG8_STAGE_A(PG8_SA(0, 0), a2, 0, last);
            PG8_WAIT_V(8); PG8_WAIT_L(0); PG8_BAR; PG8_MMA(1, 0, At, B0); PG8_MMA(1, 1, At, B1); PG8_BAR; PG8_SCHED;
            PG8_LDB(B0, 1, 0); PG8_LDB(B1, 1, 1); PG8_SCHED; PG8_LDA(At, 1, 0); PG8_STAGE_A(PG8_SA(0, 1), a2, 1, last);
            PG8_WAIT_V(8); PG8_WAIT_L(0); PG8_BAR; PG8_MMA(0, 0, At, B0); PG8_MMA(0, 1, At, B1); PG8_BAR; PG8_SCHED;
            PG8_LDA(At, 1, 1); PG8_STAGE(PG8_SB(1, 0), b3, voffB); PG8_STAGE(PG8_SB(1, 1), b3 + hstepB, voffB); PG8_STAGE_A(PG8_SA(1, 0), a3, 0, last);
            PG8_WAIT_V(8); PG8_WAIT_L(0); PG8_BAR; PG8_MMA(1, 0, At, B0); PG8_MMA(1, 1, At, B1); PG8_BAR; PG8_SCHED;
            } else {
            if (t == 0) {
        if constexpr (Epi::RSNP == 16) { const char* rp_ = (const char*)E.rs_src(cur);
            if (rp_) { _Pragma("unroll") for (int i_ = 0; i_ < 2; ++i_) __builtin_amdgcn_global_load_lds((const unsigned*)(rp_ + tid * 16 + i_ * 8192), (PG8_LAS unsigned*)(lds + PG8_RSBUF + wid * 1024 + i_ * 8192), 16, 0, 0); } }
        if constexpr (Epi::RSNP == 4) { const char* rp_ = (const char*)E.rs_src(cur);
            if (rp_ && wid < 4) __builtin_amdgcn_global_load_lds((const unsigned*)(rp_ + tid * 16), (PG8_LAS unsigned*)(lds + PG8_RSBUF + wid * 1024), 16, 0, 0); }
has_next = S.next(ui + 1, nxt);
        if constexpr (GATHER) { if (has_next && wid < 4) {
            __builtin_amdgcn_global_load_lds((const unsigned*)(S.row_ptr(nxt) + tid), (PG8_LAS unsigned*)(lds + PG8_TOKBUF + wid * 256), 4, 0, 0); } }
        nA = has_next ? (const char*)g.A + (size_t)nxt.pm * tstepA : cA; nB = has_next ? (const char*)g.Bt + (size_t)nxt.pn * tstepB : cB;
            }
            const char* a2 = last ? nA : cA + (size_t)(t + 2) * kstep; const char* b2 = last ? nB : cB + (size_t)(t + 2) * kstep;
            const char* a3 = a2 + kstep; const char* b3 = b2 + kstep;
            if (last && has_next) S.a_ready(nxt);
            if constexpr (GATHER) { if (last && has_next) { asm volatile("" ::: "memory");
#pragma unroll
                for (int h_ = 0; h_ < 2; ++h_)
#pragma unroll
                    for (int i_ = 0; i_ < 2; ++i_) { const int tk_ = *(const PG8_LAS int*)(lds + PG8_TOKBUF + (h_ * HALF + rA_[i_]) * 4); gnxt[h_][i_] = (unsigned)(tk_ & 0xffff) * (unsigned)(lda * 2) + cA_[i_]; } } }
            PG8_LDB(B0, 0, 0); PG8_SCHED; PG8_LDA(At, 0, 0); PG8_STAGE_A(PG8_SA(1, 1), a1, 1, false);
            PG8_WAIT_L(8); PG8_BAR; PG8_WAIT_L(0); PG8_MMA(0, 0, At, B0); PG8_BAR; PG8_SCHED;
            PG8_LDB(B1, 0, 1); PG8_STAGE(PG8_SB(0, 0), b2, voffB);
            PG8_BAR; PG8_WAIT_L(0); PG8_MMA(0, 1, At, B1); PG8_BAR;
            PG8_LDA(At, 0, 1); PG8_STAGE_A(PG8_SA(0, 0), a2, 0, last);
            PG8_BAR; PG8_WAIT_L(0); PG8_MMA(1, 0, At, B0); PG8_BAR; PG8_SCHED;
            PG8_STAGE(PG8_SB(0, 1), b2 + hstepB, voffB);
            PG8_WAIT_V(6); PG8_BAR; PG8_MMA(1, 1, At, B1); PG8_BAR;
            PG8_LDB(B0, 1, 0); PG8_SCHED; PG8_LDA(At, 1, 0); PG8_STAGE_A(PG8_SA(0, 1), a2, 1, last);
            PG8_WAIT_L(8); PG8_BAR; PG8_WAIT_L(0); PG8_MMA(0, 0, At, B0); PG8_BAR; PG8_SCHED;
            PG8_LDB(B1, 1, 1); PG8_STAGE(PG8_SB(1, 0), b3, voffB);
            PG8_BAR; PG8_WAIT_L(0); PG8_MMA(0, 1, At, B1); PG8_BAR;
            PG8_LDA(At, 1, 1); PG8_STAGE_A(PG8_SA(1, 0), a3, 0, last);
            PG8_BAR; PG8_WAIT_L(0); PG8_MMA(1, 0, At, B0); PG8_BAR; PG8_SCHED;
            PG8_STAGE(PG8_SB(1, 1), b3 + hstepB, voffB);
            PG8_WAIT_V(6); PG8_BAR; PG8_MMA(1, 1, At, B1); PG8_BAR;
            }
        }
        if constexpr (ALIGN_EPI) { if (wr == 0) PG8_BAR; }
        if constexpr (!Epi::AFTER_DRAIN) { E(acc, cur, wr, wc, fr, fq); S.done(cur); }
        if (!has_next) break;
#pragma unroll
        for (int a = 0; a < 2; ++a)
#pragma unroll
            for (int b = 0; b < 2; ++b)
#pragma unroll
                for (int m = 0; m < 4; ++m)
#pragma unroll
                    for (int n = 0; n < 2; ++n) acc[a][b][m][n] = (f32x4){0.f, 0.f, 0.f, 0.f};
    PG8_ANCHOR();
        cur = nxt; cA = nA; cB = nB; ++ui;
        if constexpr (GATHER) {
#pragma unroll
            for (int h_ = 0; h_ < 2; ++h_)
#pragma unroll
                for (int i_ = 0; i_ < 2; ++i_) gcur[h_][i_] = gnxt[h_][i_]; }
        if constexpr (ALIGN_EPI) { if (wr == 1) PG8_BAR; }
    }
    PG8_WAIT_V(0);
    if constexpr (!ALIGN_EPI) { if (wr == 0) PG8_BAR; }
    PG8_BAR;
    if constexpr (Epi::AFTER_DRAIN) { E.fused(acc, cur, wr, wc, fr, fq, lds, wid, lane); S.done(cur); }
#undef PG8_SA
#undef PG8_SB
#undef PG8_STAGE
#undef PG8_STAGE_A
#undef PG8_LDA
#undef PG8_LDB
#undef PG8_MMA
#undef PG8_WAIT_V
#undef PG8_WAIT_L
#undef PG8_BAR
#undef PG8_SCHED
}
}

constexpr int NWAVES = 8;
constexpr int M = 65536, SEQ = 2048, NBATCH = 32, D = 1024;
constexpr int NPROJ = 2304, FF = 2816, NGU = 2 * FF, NEXP = 8;
constexpr int C_CQ = 512, C_CKV = 768, C_KR = 896, C_DQ = 1024, C_DK = 1408, C_DV = 1792;
constexpr int QW = 576, KVW = 768;
constexpr float LOG2E = 1.4426950408889634f;
constexpr float RMS_EPS = 1e-6f, LN_EPS = 1e-5f;
constexpr float LAM_INIT0 = 0.2f, LAM_INIT1 = 0.35550906759096926f;
constexpr int NPHASE = 19;
constexpr int MOE_CHUNK_TILES = 128, MOE_MAX_TILES = 528;

constexpr size_t MiB = 1u << 20;
constexpr size_t WS_CTL = 0, CTL_ZERO_BYTES = 40960;
constexpr size_t WS_SSX = 4 * MiB;
constexpr size_t WS_SSF = 12 * MiB;
constexpr size_t WS_SSCQ = 16 * MiB;
constexpr size_t WS_SSCKV = 18 * MiB;
constexpr size_t WS_SSF1 = 20 * MiB;
constexpr size_t WS_ROPE = 21 * MiB;
constexpr size_t BGLU_OFF = 320 * 1024;
constexpr size_t WS_WR = 21 * MiB + 512 * 1024;
constexpr size_t WS_LAM = 21 * MiB + 768 * 1024;
constexpr size_t WS_WIN = 22 * MiB;
constexpr size_t WS_WUQ = 31 * MiB;
constexpr size_t WS_WUKV = WS_WUQ + 768 * 1024;
constexpr size_t WS_WPW = WS_WUKV + 768 * 1024;
constexpr size_t WS_WOUT = 33 * MiB;
constexpr size_t WS_WGUD = 37 * MiB;
constexpr size_t WS_WDD = 48 * MiB;
constexpr size_t WS_WGUE = 54 * MiB;
constexpr size_t WS_WDE = 142 * MiB;
constexpr size_t WS_XB = 186 * MiB;
constexpr size_t WS_PROJ = 314 * MiB;
constexpr size_t WS_Q = 602 * MiB;
constexpr size_t WS_KV = 674 * MiB;
constexpr size_t WS_KR = 770 * MiB;
constexpr size_t WS_CB = 774 * MiB;
constexpr size_t WS_CAT = 806 * MiB;
constexpr size_t WS_ACT = 314 * MiB;
constexpr size_t WS_HB3 = 314 * MiB;
constexpr size_t WS_Y1 = 442 * MiB;
constexpr size_t WS_ACT0 = 570 * MiB;
constexpr size_t WS_ACT1 = 746 * MiB;
constexpr size_t WS_LIST = 922 * MiB;
constexpr size_t WS_WGT = 926 * MiB;
constexpr size_t WS_END = 934 * MiB;
static_assert(WS_WPW + 2 * 256 * 256 * 2 <= WS_WOUT && WS_WDD + (size_t)1024 * 2816 * 2 <= WS_WGUE && WS_WGUE + (size_t)8 * 5632 * 1024 * 2 <= WS_WDE && WS_WDE + (size_t)8 * 1024 * 2816 * 2 <= WS_XB, "weights map");
static_assert(WS_ACT + (size_t)M * FF * 2 <= WS_KV && WS_ACT0 + (size_t)MOE_CHUNK_TILES * 256 * FF * 2 <= WS_ACT1 && WS_ACT1 + (size_t)MOE_CHUNK_TILES * 256 * FF * 2 <= WS_LIST && WS_WGT + 4 * MiB <= WS_END, "overlay map");
constexpr int CW_TMO = 0, CW_CODE = 1;
constexpr int CW_BAR = 4096;
constexpr int CW_CNT = 8192;
static_assert((CW_CNT + 8 * 64) * 4 <= (int)CTL_ZERO_BYTES && (CW_BAR + 3456) * 4 <= CW_CNT * 4, "control words inside the memset region");

constexpr int RING_OFF = 0, RING_BYTES = 131072;
constexpr int LDSCTL_OFF = RING_BYTES, MISC_OFF = LDSCTL_OFF + 320;
constexpr int RSBUF_OFF = 147456;
constexpr int LDS_BYTES = 163840;
static_assert(MISC_OFF + 64 * 4 <= LDS_BYTES, "LDS map");

#define GAS __attribute__((address_space(1)))
#define LAS __attribute__((address_space(3)))
typedef unsigned short bf16;
typedef unsigned v4u __attribute__((ext_vector_type(4)));
typedef unsigned v2u __attribute__((ext_vector_type(2)));
typedef float f32x4 __attribute__((ext_vector_type(4)));
typedef short bf16x8 __attribute__((ext_vector_type(8)));
typedef GAS unsigned gu32;
#define RLX_AGENT __ATOMIC_RELAXED, __HIP_MEMORY_SCOPE_AGENT
#define LDS_WAIT() asm volatile("s_waitcnt lgkmcnt(0)" ::: "memory")
#define VM_WAIT() asm volatile("s_waitcnt vmcnt(0)" ::: "memory")
__device__ __forceinline__ unsigned pkbf(float lo, float hi) { return pg8::cvt_pk_bf16(lo, hi); }
__device__ __forceinline__ float bf_lo(unsigned w) { return __uint_as_float(w << 16); }
__device__ __forceinline__ float bf_hi(unsigned w) { return __uint_as_float(w & 0xffff0000u); }
__device__ __forceinline__ float sigmoidf_(float x) { return __builtin_amdgcn_rcpf(1.0f + __builtin_amdgcn_exp2f(-x * LOG2E)); }
__device__ __forceinline__ float wave_sum(float v) {
#pragma unroll
    for (int o = 1; o < 64; o <<= 1) v += __shfl_xor(v, o);
    return v;
}
constexpr float QS_GU = 32.f, QS_D = 64.f, QS_ACT = 4.f;
__device__ __forceinline__ float clamp8(float x) { return __builtin_fminf(__builtin_fmaxf(x, -448.f), 448.f); }
__device__ __forceinline__ unsigned pk4f8(float a, float b, float c, float d) {
    int p = 0; p = __builtin_amdgcn_cvt_pk_fp8_f32(clamp8(a), clamp8(b), p, false); p = __builtin_amdgcn_cvt_pk_fp8_f32(clamp8(c), clamp8(d), p, true); return (unsigned)p; }
__device__ __forceinline__ float dot4_(f32x4 v) { return (v[0] * v[0] + v[1] * v[1]) + (v[2] * v[2] + v[3] * v[3]); }

namespace pg8 {
typedef unsigned u32x2 __attribute__((ext_vector_type(2)));
__device__ __forceinline__ float red_fq(float s) {
    const auto a = __builtin_amdgcn_permlane16_swap(__float_as_uint(s), __float_as_uint(s), false, false); s = __uint_as_float(a[0]) + __uint_as_float(a[1]);
    const auto b = __builtin_amdgcn_permlane32_swap(__float_as_uint(s), __float_as_uint(s), false, false); return __uint_as_float(b[0]) + __uint_as_float(b[1]);
}
__device__ __forceinline__ void load_rs8(const float* ssp_, int np, int row0, int fq, float inv_n, float eps, float (&rs)[2][4]) {
    const GAS float* ssp = (const GAS float*)ssp_;
    if (np == 16) { f32x4 t[2][4];
#pragma unroll
        for (int ai = 0; ai < 2; ++ai)
#pragma unroll
            for (int m = 0; m < 4; ++m) t[ai][m] = *(const GAS f32x4*)((const GAS char*)ssp + ((unsigned)(row0 + ai * HALF + m * 16) * 64u + 16u * fq));
#pragma unroll
        for (int ai = 0; ai < 2; ++ai)
#pragma unroll
            for (int m = 0; m < 4; ++m) rs[ai][m] = (t[ai][m][0] + t[ai][m][1]) + (t[ai][m][2] + t[ai][m][3]);
    } else if (np == 4) {
#pragma unroll
        for (int ai = 0; ai < 2; ++ai)
#pragma unroll
            for (int m = 0; m < 4; ++m) rs[ai][m] = *(const GAS float*)((const GAS char*)ssp + ((unsigned)(row0 + ai * HALF + m * 16) * 16u + 4u * fq));
    } else {
#pragma unroll
        for (int ai = 0; ai < 2; ++ai)
#pragma unroll
            for (int m = 0; m < 4; ++m) rs[ai][m] = (fq == 0) ? ssp[row0 + ai * HALF + m * 16] : 0.f;
    }
#pragma unroll
    for (int ai = 0; ai < 2; ++ai)
#pragma unroll
        for (int m = 0; m < 4; ++m) rs[ai][m] = __builtin_amdgcn_rsqf(red_fq(rs[ai][m]) * inv_n + eps);
}
__device__ __forceinline__ void load_rs8_lds(const PG8_LAS float* rsl, int trow0, int fq, float inv_n, float eps, float (&rs)[2][4]) {
    f32x4 t[2][4];
#pragma unroll
    for (int ai = 0; ai < 2; ++ai)
#pragma unroll
        for (int m = 0; m < 4; ++m) t[ai][m] = *(const PG8_LAS f32x4*)(rsl + (trow0 + ai * HALF + m * 16) * 16 + 4 * fq);
#pragma unroll
    for (int ai = 0; ai < 2; ++ai)
#pragma unroll
        for (int m = 0; m < 4; ++m) rs[ai][m] = __builtin_amdgcn_rsqf(red_fq((t[ai][m][0] + t[ai][m][1]) + (t[ai][m][2] + t[ai][m][3])) * inv_n + eps);
}
__device__ __forceinline__ void load_rs8_lds4(const PG8_LAS float* rsl, int trow0, int fq, float inv_n, float eps, float (&rs)[2][4]) {
#pragma unroll
    for (int ai = 0; ai < 2; ++ai)
#pragma unroll
        for (int m = 0; m < 4; ++m) rs[ai][m] = rsl[(trow0 + ai * HALF + m * 16) * 4 + fq];
#pragma unroll
    for (int ai = 0; ai < 2; ++ai)
#pragma unroll
        for (int m = 0; m < 4; ++m) rs[ai][m] = __builtin_amdgcn_rsqf(red_fq(rs[ai][m]) * inv_n + eps);
}
__device__ __forceinline__ float dot4(f32x4 v) { return (v[0] * v[0] + v[1] * v[1]) + (v[2] * v[2] + v[3] * v[3]); }

__device__ __forceinline__ void rope4(f32x4& x1, f32x4& x2, const float* rope, int pos, int g) {
    const GAS f32x4* t = (const GAS f32x4*)(rope + ((size_t)pos * 16 + 4 * g) * 2); const f32x4 t0 = t[0], t1 = t[1];
    const f32x4 c = (f32x4){t0[0], t0[2], t1[0], t1[2]}, s = (f32x4){t0[1], t0[3], t1[1], t1[3]};
    const f32x4 a = x1 * c - x2 * s, b = x1 * s + x2 * c; x1 = a; x2 = b;
}
__device__ __forceinline__ void rope4v(f32x4& x1, f32x4& x2, f32x4 t0, f32x4 t1) {
    const f32x4 c = (f32x4){t0[0], t0[2], t1[0], t1[2]}, s = (f32x4){t0[1], t0[3], t1[1], t1[3]};
    const f32x4 a = x1 * c - x2 * s, b = x1 * s + x2 * c; x1 = a; x2 = b;
}
__device__ __forceinline__ u32x4 pack8(f32x4 v0, f32x4 v1) { u32x4 w; w.x = cvt_pk_bf16(v0[0], v0[1]); w.y = cvt_pk_bf16(v0[2], v0[3]); w.z = cvt_pk_bf16(v1[0], v1[1]); w.w = cvt_pk_bf16(v1[2], v1[3]); return w; }

struct EpiStore {
    static constexpr bool PERM = true, AFTER_DRAIN = false;
    static constexpr int RSNP = 4;
    bf16_t* O; int ldc; const float* bias; const float* ss; int np; float inv_n, eps; const PG8_LAS float* rsl = nullptr;
    __device__ __forceinline__ const float* rs_src(const Unit& u) const { return (ss && rsl && np == 4) ? ss + (size_t)u.pm * BM * 4 : nullptr; }
    __device__ __forceinline__ void operator()(const f32x4 (&acc)[2][2][4][2], const Unit& u, int wr, int wc, int fr, int fq) const {
        const int row0 = u.pm * BM + wr * 64 + fr, col0 = u.pn * BM + wc * 32 + 8 * fq;
        f32x4 bv[2][2];
#pragma unroll
        for (int bj = 0; bj < 2; ++bj)
#pragma unroll
            for (int n = 0; n < 2; ++n) bv[bj][n] = bias ? *(const GAS f32x4*)(bias + col0 + bj * HALF + 4 * n) : (f32x4){0.f, 0.f, 0.f, 0.f};
        float rsv[2][4];
        if (ss) { if (rsl && np == 4) load_rs8_lds4(rsl, wr * 64 + fr, fq, inv_n, eps, rsv); else load_rs8(ss, np, row0, fq, inv_n, eps, rsv); }
        else {
#pragma unroll
            for (int ai = 0; ai < 2; ++ai)
#pragma unroll
                for (int m = 0; m < 4; ++m) rsv[ai][m] = 1.0f; }
#pragma unroll
        for (int ai = 0; ai < 2; ++ai)
#pragma unroll
            for (int m = 0; m < 4; ++m) { const int row = row0 + ai * HALF + m * 16; const float rs = rsv[ai][m];
                const unsigned ob = ((unsigned)row * (unsigned)ldc + (unsigned)col0) * 2u;
#pragma unroll
                for (int bj = 0; bj < 2; ++bj) *(GAS u32x4*)((GAS char*)O + (ob + bj * HALF * 2)) = pack8(acc[ai][bj][m][0] * rs + bv[bj][0], acc[ai][bj][m][1] * rs + bv[bj][1]); }
    }
};
struct EpiProj {
    static constexpr bool PERM = true, AFTER_DRAIN = false;
    static constexpr int RSNP = 16;
    bf16_t* proj; const float* ss_x; float* ss_cq; float* ss_ckv; bf16_t* krope; const float* rope; const PG8_LAS float* rsl = nullptr;
    __device__ __forceinline__ const float* rs_src(const Unit& u) const { return (ss_x && rsl) ? ss_x + (size_t)u.pm * BM * 16 : nullptr; }
    __device__ __forceinline__ void operator()(const f32x4 (&acc)[2][2][4][2], const Unit& u, int wr, int wc, int fr, int fq) const {
        const int row0 = u.pm * BM + wr * 64 + fr, col0 = u.pn * BM + wc * 32 + 8 * fq;
        float rsv[2][4];
        if (ss_x) { if (rsl) load_rs8_lds(rsl, wr * 64 + fr, fq, 1.0f / 1024.0f, 1e-6f, rsv); else load_rs8(ss_x, 16, row0, fq, 1.0f / 1024.0f, 1e-6f, rsv); }
        else {
#pragma unroll
            for (int ai = 0; ai < 2; ++ai)
#pragma unroll
                for (int m = 0; m < 4; ++m) rsv[ai][m] = 1.0f; }
        const bool glu_ = u.pn < 2;
        f32x4 gb[2][2];
        { const int c0 = (glu_ ? u.pn : 0) * 128 + wc * 32 + 8 * fq; const float* bglu = (const float*)((const char*)rope + BGLU_OFF) + (ss_x ? 512 : 0);
#pragma unroll
          for (int n = 0; n < 2; ++n) { gb[0][n] = *(const GAS f32x4*)(bglu + c0 + 4 * n); gb[1][n] = *(const GAS f32x4*)(bglu + 256 + c0 + 4 * n); } }
#pragma unroll
        for (int ai = 0; ai < 2; ++ai)
#pragma unroll
            for (int m = 0; m < 4; ++m) { const int row = row0 + ai * HALF + m * 16; const float rs = rsv[ai][m];
                const unsigned ob = ((unsigned)row * 2304u + (unsigned)col0) * 2u; float sq0 = 0.f, sq1 = 0.f;
                if (glu_) { f32x4 o_[2];
#pragma unroll
                    for (int n = 0; n < 2; ++n) { f32x4 t_ = (acc[ai][1][m][n] * rs + gb[1][n]) * -1.4426950408889634f;
#pragma unroll
                        for (int j = 0; j < 4; ++j) t_[j] = __builtin_amdgcn_rcpf(1.0f + __builtin_amdgcn_exp2f(t_[j]));
                        o_[n] = (acc[ai][0][m][n] * rs + gb[0][n]) * t_; }
                    *(GAS u32x4*)((GAS char*)proj + ((unsigned)row * 2304u + (unsigned)(u.pn * 128 + wc * 32 + 8 * fq)) * 2u) = pack8(o_[0], o_[1]); continue; }
#pragma unroll
                for (int bj = 0; bj < 2; ++bj) { f32x4 v0 = acc[ai][bj][m][0] * rs, v1 = acc[ai][bj][m][1] * rs;
                    if (u.pn == 2 || u.pn == 3) { if (bj == 0) sq0 = dot4(v0) + dot4(v1); else sq1 = dot4(v0) + dot4(v1); }
                    if (!(bj == 1 && ((u.pn == 3 && wc >= 1) || u.pn == 8))) *(GAS u32x4*)((GAS char*)proj + (ob + bj * HALF * 2)) = pack8(v0, v1);
 }
                if (u.pn == 2) { const float s = red_fq(sq0 + sq1); if (fq == 0) *(GAS float*)((GAS char*)ss_cq + ((unsigned)row * 16u + 4u * wc)) = s; }
                else if (u.pn == 3) { const float s = red_fq(sq0); if (fq == 0) *(GAS float*)((GAS char*)ss_ckv + ((unsigned)row * 16u + 4u * wc)) = s; } }
        if (u.pn == 3 && wc == 0) {
            f32x4 tr[2][4][2];
#pragma unroll
            for (int ai = 0; ai < 2; ++ai)
#pragma unroll
                for (int m = 0; m < 4; ++m) { const GAS f32x4* t = (const GAS f32x4*)(rope + ((size_t)((row0 + ai * HALF + m * 16) & 2047) * 16 + 4 * fq) * 2); tr[ai][m][0] = t[0]; tr[ai][m][1] = t[1]; }
#pragma unroll
            for (int ai = 0; ai < 2; ++ai)
#pragma unroll
                for (int m = 0; m < 4; ++m) { const int row = row0 + ai * HALF + m * 16; const float rs = rsv[ai][m];
                    f32x4 v0 = acc[ai][1][m][0] * rs, v1 = acc[ai][1][m][1] * rs; rope4v(v0, v1, tr[ai][m][0], tr[ai][m][1]); *(GAS u32x4*)((GAS char*)krope + ((unsigned)row * 64u + 16u * fq)) = pack8(v0, v1); } }
    }
};
struct EpiQ {
    static constexpr bool PERM = true, AFTER_DRAIN = false;
    static constexpr int RSNP = 4;
    bf16_t* q; const float* ss_cq; const float* rope; const PG8_LAS float* rsl = nullptr;
    __device__ __forceinline__ const float* rs_src(const Unit& u) const { return rsl ? ss_cq + (size_t)u.pm * BM * 4 : nullptr; }
    __device__ __forceinline__ void operator()(const f32x4 (&acc)[2][2][4][2], const Unit& u, int wr, int wc, int fr, int fq) const {
        if (wc == 3) return;
        const int row0 = u.pm * BM + wr * 64 + fr;
        f32x4 tr[2][4][2];
        if (wc == 2) {
#pragma unroll
            for (int ai = 0; ai < 2; ++ai)
#pragma unroll
                for (int m = 0; m < 4; ++m) { const GAS f32x4* t = (const GAS f32x4*)(rope + ((size_t)((row0 + ai * HALF + m * 16) & 2047) * 16 + 4 * fq) * 2); tr[ai][m][0] = t[0]; tr[ai][m][1] = t[1]; } }
        float rsv[2][4]; if (rsl) load_rs8_lds4(rsl, wr * 64 + fr, fq, 1.0f / 256.0f, 1e-6f, rsv); else load_rs8(ss_cq, 4, row0, fq, 1.0f / 256.0f, 1e-6f, rsv);
#pragma unroll
        for (int ai = 0; ai < 2; ++ai)
#pragma unroll
            for (int m = 0; m < 4; ++m) { const int row = row0 + ai * HALF + m * 16; const float rs = rsv[ai][m];
#pragma unroll
                for (int bj = 0; bj < 2; ++bj) { f32x4 v0 = acc[ai][bj][m][0] * rs, v1 = acc[ai][bj][m][1] * rs;
                    if (wc == 2) rope4v(v0, v1, tr[ai][m][0], tr[ai][m][1]);
                    *(GAS u32x4*)((GAS char*)q + ((unsigned)row * 1152u + (unsigned)((2 * u.pn + bj) * 96 + wc * 32 + 8 * fq) * 2u)) = pack8(v0, v1); } }
    }
};
__device__ __forceinline__ f32x4 unpk_lo(u32x4 p) { return (f32x4){__uint_as_float(p.x << 16), __uint_as_float(p.x & 0xffff0000u), __uint_as_float(p.y << 16), __uint_as_float(p.y & 0xffff0000u)}; }
__device__ __forceinline__ f32x4 unpk_hi(u32x4 p) { return (f32x4){__uint_as_float(p.z << 16), __uint_as_float(p.z & 0xffff0000u), __uint_as_float(p.w << 16), __uint_as_float(p.w & 0xffff0000u)}; }
struct EpiResid {
    static constexpr bool PERM = true, AFTER_DRAIN = false;
    static constexpr int RSNP = 0;
    const float* xin; bf16_t* xb; float* ss; float asc = 1.0f;
    __device__ __forceinline__ void operator()(const f32x4 (&acc)[2][2][4][2], const Unit& u, int wr, int wc, int fr, int fq) const {
        const int row0 = u.pm * BM + wr * 64 + fr, col0 = u.pn * BM + wc * 32 + 8 * fq;
        if (xin) {
            f32x4 pre[4][2][2];
#pragma unroll
            for (int m = 0; m < 4; ++m) { const unsigned oe = (unsigned)(row0 + m * 16) * 1024u + (unsigned)col0;
#pragma unroll
                for (int bj = 0; bj < 2; ++bj)
#pragma unroll
                    for (int n = 0; n < 2; ++n) pre[m][bj][n] = __builtin_nontemporal_load((const GAS f32x4*)((const GAS char*)xin + (oe + bj * HALF + n * 4) * 4u)); }
#pragma unroll
            for (int ai = 0; ai < 2; ++ai)
#pragma unroll
                for (int m = 0; m < 4; ++m) { const int row = row0 + ai * HALF + m * 16; const unsigned oe = (unsigned)row * 1024u + (unsigned)col0; float sq = 0.f;
                    f32x4 v[2][2];
#pragma unroll
                    for (int bj = 0; bj < 2; ++bj)
#pragma unroll
                        for (int n = 0; n < 2; ++n) v[bj][n] = pre[m][bj][n] + acc[ai][bj][m][n];
                    if (ai == 0) { const unsigned oe2 = oe + (unsigned)HALF * 1024u;
#pragma unroll
                        for (int bj = 0; bj < 2; ++bj)
#pragma unroll
                            for (int n = 0; n < 2; ++n) pre[m][bj][n] = __builtin_nontemporal_load((const GAS f32x4*)((const GAS char*)xin + (oe2 + bj * HALF + n * 4) * 4u)); }
#pragma unroll
                    for (int bj = 0; bj < 2; ++bj) { sq += dot4(v[bj][0]) + dot4(v[bj][1]); *(GAS u32x4*)((GAS char*)xb + (oe + bj * HALF) * 2u) = pack8(v[bj][0], v[bj][1]); }
                    if (ss) { const float s = red_fq(sq); if (fq == 0) *(GAS float*)((GAS char*)ss + ((unsigned)row * 64u + (unsigned)(4 * u.pn + wc) * 4u)) = s; } }
        } else {
            u32x4 pre[2][4][2];
#pragma unroll
            for (int ai = 0; ai < 2; ++ai)
#pragma unroll
                for (int m = 0; m < 4; ++m) { const unsigned ob = ((unsigned)(row0 + ai * HALF + m * 16) * 1024u + (unsigned)col0) * 2u;
#pragma unroll
                    for (int bj = 0; bj < 2; ++bj) pre[ai][m][bj] = *(const GAS u32x4*)((const GAS char*)xb + (ob + bj * HALF * 2)); }
#pragma unroll
            for (int ai = 0; ai < 2; ++ai)
#pragma unroll
                for (int m = 0; m < 4; ++m) { const int row = row0 + ai * HALF + m * 16; const unsigned ob = ((unsigned)row * 1024u + (unsigned)col0) * 2u; float sq = 0.f;
#pragma unroll
                    for (int bj = 0; bj < 2; ++bj) { const u32x4 p = pre[ai][m][bj]; const f32x4 v0 = unpk_lo(p) + acc[ai][bj][m][0] * asc, v1 = unpk_hi(p) + acc[ai][bj][m][1] * asc;
                        sq += dot4(v0) + dot4(v1); *(GAS u32x4*)((GAS char*)xb + (ob + bj * HALF * 2)) = pack8(v0, v1); }
                    if (ss) { const float s = red_fq(sq); if (fq == 0) *(GAS float*)((GAS char*)ss + ((unsigned)row * 64u + (unsigned)(4 * u.pn + wc) * 4u)) = s; } }
        }
    }
};
template <int PROBE = 0  , bool NORS = false  , int F8 = 0  > struct EpiSwiGLU_ {
    static constexpr bool PERM = true, AFTER_DRAIN = false;
    static constexpr int RSNP = NORS ? 0 : 16;
    bf16_t* act; const float* ss; int np; int nct; const PG8_LAS float* rsl = nullptr;
    __device__ __forceinline__ const float* rs_src(const Unit& u) const { return (ss && rsl) ? ss + (size_t)u.pm * BM * 16 : nullptr; }
    __device__ __forceinline__ void operator()(const f32x4 (&acc)[2][2][4][2], const Unit& u, int wr, int wc, int fr, int fq) const {
        const int row0 = u.pm * BM + wr * 64 + fr, col0 = (u.pn % nct) * 128 + wc * 32 + 8 * fq;
        float rsv[2][4];
        if (PROBE == 2 || !ss) {
#pragma unroll
            for (int ai = 0; ai < 2; ++ai)
#pragma unroll
                for (int m = 0; m < 4; ++m) rsv[ai][m] = PROBE == 2 ? 0.03f : 1.0f; }
        else if (rsl) load_rs8_lds(rsl, wr * 64 + fr, fq, 1.0f / 1024.0f, 1e-6f, rsv);
        else load_rs8(ss, np, row0, fq, 1.0f / 1024.0f, 1e-6f, rsv);
#pragma unroll
        for (int ai = 0; ai < 2; ++ai)
#pragma unroll
            for (int m = 0; m < 4; ++m) { const int row = row0 + ai * HALF + m * 16; const float rs = rsv[ai][m];
                f32x4 a[2];
#pragma unroll
                for (int n = 0; n < 2; ++n) {
                    if constexpr (F8 != 0) {
                        const float sg = F8 == 1 ? 1.0f / QS_GU : rs, ce = -1.4426950408889634f * sg, ci = F8 == 1 ? QS_GU * QS_GU / QS_ACT : __builtin_amdgcn_rcpf(sg * sg * QS_ACT), lci = F8 == 1 ? 8.0f : __builtin_amdgcn_logf(ci);
                        static_assert(F8 != 1 || QS_GU * QS_GU / QS_ACT == 256.0f, "log2 of the MoE scale constant");
                        const f32x4 G = acc[ai][0][m][n], U = acc[ai][1][m][n]; f32x4 t;
#pragma unroll
                        for (int j = 0; j < 4; ++j) t[j] = __builtin_amdgcn_exp2f(__builtin_fmaf(G[j], ce, lci));
                        t = t + ci;
#pragma unroll
                        for (int j = 0; j < 4; ++j) t[j] = __builtin_amdgcn_rcpf(t[j]);
                        a[n] = (G * U) * t; }
                    else { const f32x4 g = NORS ? acc[ai][0][m][n] : acc[ai][0][m][n] * rs, up = NORS ? acc[ai][1][m][n] : acc[ai][1][m][n] * rs;
#pragma unroll
                        for (int j = 0; j < 4; ++j) a[n][j] = g[j] * __builtin_amdgcn_rcpf(1.0f + __builtin_amdgcn_exp2f(-g[j] * 1.4426950408889634f)) * up[j]; } }
                if constexpr (F8 != 0) { v2u w8; w8.x = pk4f8(a[0][0], a[0][1], a[0][2], a[0][3]); w8.y = pk4f8(a[1][0], a[1][1], a[1][2], a[1][3]);
                    *(GAS v2u*)((GAS char*)act + ((unsigned)row * 2816u + (unsigned)col0)) = w8; }
                else { const u32x4 w = pack8(a[0], a[1]);
                    if (PROBE == 1) asm volatile("" :: "v"(w)); else *(GAS u32x4*)(act + (size_t)row * 2816 + col0) = w; } }
    }
};
typedef EpiSwiGLU_<0> EpiSwiGLU;
typedef EpiSwiGLU_<0, true> EpiSwiGLUn;
typedef EpiSwiGLU_<0, true, 1> EpiSwiGLU8;
typedef EpiSwiGLU_<0, false, 2> EpiSwiGLUd8;
struct EpiScatter {
    static constexpr bool PERM = true, AFTER_DRAIN = false;
    static constexpr int RSNP = 0;
    bf16_t* xb; bf16_t* y1; const int* list; const float* wgt; float wsc;
    __device__ __forceinline__ void operator()(const f32x4 (&acc)[2][2][4][2], const Unit& u, int wr, int wc, int fr, int fq) const {
        const int tr0 = wr * 64 + fr, col0 = (u.pn & 3) * BM + wc * 32 + 8 * fq; const unsigned y1off = (unsigned)((const char*)y1 - (const char*)xb);
        int tok[2][4]; float wg[2][4];
#pragma unroll
        for (int ai = 0; ai < 2; ++ai)
#pragma unroll
            for (int m = 0; m < 4; ++m) { const int tr = tr0 + ai * HALF + m * 16; const bool ok = tr < u.aux3; tok[ai][m] = ok ? ((const GAS int*)list)[u.aux2 + tr] : -1; wg[ai][m] = ok ? ((const GAS float*)wgt)[u.aux2 + tr] * wsc : 0.f; }
        u32x4 pre[2][4][2];
#pragma unroll
        for (int ai = 0; ai < 2; ++ai)
#pragma unroll
            for (int m = 0; m < 4; ++m) { const int tv = tok[ai][m]; const unsigned ob = ((unsigned)(tv < 0 ? 0 : (tv & 0xffff)) * 1024u + (unsigned)col0) * 2u;
#pragma unroll
                for (int bj = 0; bj < 2; ++bj) pre[ai][m][bj] = (tv >= 0 && (tv >> 16) == 0) ? *(const GAS u32x4*)((const GAS char*)xb + (ob + bj * HALF * 2)) : (u32x4){0u, 0u, 0u, 0u}; }
#pragma unroll
        for (int ai = 0; ai < 2; ++ai)
#pragma unroll
            for (int m = 0; m < 4; ++m) { const int tv = tok[ai][m]; const float w = wg[ai][m];
                if (tv >= 0) { const unsigned ob = ((unsigned)(tv & 0xffff) * 1024u + (unsigned)col0) * 2u + ((tv >> 16) == 0 ? 0u : y1off);
#pragma unroll
                    for (int bj = 0; bj < 2; ++bj) { const u32x4 p = pre[ai][m][bj];
                        *(GAS u32x4*)((GAS char*)xb + (ob + bj * HALF * 2)) = pack8(unpk_lo(p) + acc[ai][bj][m][0] * w, unpk_hi(p) + acc[ai][bj][m][1] * w); } } }
    }
};
struct RangeOrder : StaticOrder {
    int i0, i1;
    __device__ __forceinline__ bool next(int i, Unit& u) const { return (i0 + i < i1) && StaticOrder::next(i0 + i, u); }
};
struct FixedOrder : StaticOrder {
    __device__ __forceinline__ bool next(int i, Unit& u) const { const bool ok = StaticOrder::next(i, u); u.pm = 0; u.pn = 0; return ok; }
};
struct EpiNull {
    static constexpr bool PERM = true, AFTER_DRAIN = false;
    static constexpr int RSNP = 0;
    __device__ __forceinline__ void operator()(const f32x4 (&acc)[2][2][4][2], const Unit& u, int wr, int wc, int fr, int fq) const {
#pragma unroll
        for (int ai = 0; ai < 2; ++ai)
#pragma unroll
            for (int bj = 0; bj < 2; ++bj)
#pragma unroll
                for (int m = 0; m < 4; ++m)
#pragma unroll
                    for (int n = 0; n < 2; ++n) { f32x4 v = acc[ai][bj][m][n]; asm volatile("" :: "v"(v)); }
    }
};
struct MoeOrder {
    int nrt, nct, ta, G, c; const PG8_LAS int* P; const int* list;
    __device__ __forceinline__ bool next(int i, Unit& u) const {
        const long L = (long)i * G + c; const int nwg = nrt * nct; if (L >= nwg) return false;
        int wgid = (int)L; { const int q = nwg / NXCD, r = nwg % NXCD, xcd = wgid % NXCD, off = wgid / NXCD; wgid = (xcd < r ? xcd * (q + 1) : r * (q + 1) + (xcd - r) * q) + off; }
        const int nig = WGM * nct, gid = wgid / nig, fm = gid * WGM, gsz = (nrt - fm) < WGM ? (nrt - fm) : WGM;
        const int pm = fm + ((wgid % nig) % gsz), pn = (wgid % nig) / gsz;
        const int rt = ta + pm; int g = 0;
#pragma unroll
        for (int k = 1; k < 8; ++k) g += (P[k] <= rt) ? 1 : 0;
        const int j = rt - P[g], left = P[20 + g] - j * BM;
        u.pm = pm; u.pn = g * nct + pn; u.aux = 0; u.aux2 = g * 65536 + j * BM; u.aux3 = left < BM ? left : BM; return true;
    }
    __device__ __forceinline__ const int* row_ptr(const Unit& u) const { return list + u.aux2; }
    __device__ __forceinline__ int row_tok(const Unit& u, int r) const { return r < u.aux3 ? (((const GAS int*)list)[u.aux2 + r] & 0xffff) : 0; }
    __device__ __forceinline__ void a_ready(const Unit&) const {}
    __device__ __forceinline__ void done(const Unit&) const {}
};
}

namespace att {
using bf16x8 = __attribute__((ext_vector_type(8))) short;
using s16x4 = __attribute__((ext_vector_type(4))) short;
using f32x16 = __attribute__((ext_vector_type(16))) float;
using u32x4 = __attribute__((ext_vector_type(4))) unsigned;
typedef __attribute__((address_space(3))) const char* lds_cptr;
typedef __attribute__((address_space(3))) char* lds_ptr;
typedef short v4i16_t __attribute__((ext_vector_type(4)));
typedef unsigned short bf16;
#define LAS3 __attribute__((address_space(3)))
__device__ __forceinline__ int crow(int r, int hi) { return (r & 3) + 8 * (r >> 2) + 4 * hi; }
__device__ __forceinline__ void glds16(const void* sbase, unsigned voff, unsigned lds_dst) { unsigned keep;
    asm volatile("s_mov_b32 %0, m0\n\ts_mov_b32 m0, %3\n\ts_nop 0\n\tglobal_load_lds_dwordx4 %1, %2\n\ts_mov_b32 m0, %0" : "=&s"(keep) : "v"(voff), "s"(sbase), "s"(lds_dst) : "memory"); }
__device__ __forceinline__ s16x4 vtr(lds_cptr p) { return __builtin_bit_cast(s16x4, __builtin_amdgcn_ds_read_tr16_b64_v4i16((LAS3 v4i16_t*)p)); }
typedef float f32x2_t __attribute__((ext_vector_type(2))); typedef __bf16 bf16x2_t __attribute__((ext_vector_type(2)));
__device__ __forceinline__ unsigned cvtpk(float lo, float hi) { f32x2_t v = {lo, hi}; bf16x2_t b = __builtin_convertvector(v, bf16x2_t); return __builtin_bit_cast(unsigned, b); }
#define MFMA(a, b, c) __builtin_amdgcn_mfma_f32_32x32x16_bf16(a, b, c, 0, 0, 0)
#define SBAR() __builtin_amdgcn_sched_barrier(0)
#define PIN(x) asm volatile("" : "+v"(x))
#define EX(v) __builtin_amdgcn_exp2f(v)
#define WAIT_BAR0() asm volatile("s_waitcnt vmcnt(0) lgkmcnt(0)\n\ts_barrier" ::: "memory")
#define WAIT_BARN(N) asm volatile("s_waitcnt vmcnt(" #N ") lgkmcnt(0)\n\ts_barrier" ::: "memory")
#define MX3(a, b, c) __builtin_fmaxf(__builtin_fmaxf((a), (b)), (c))
#define PAF(k) __builtin_bit_cast(bf16x8, pw##k)
#define VFR(i) (bf16x8){vlo[i][0], vlo[i][1], vlo[i][2], vlo[i][3], vhi[i][0], vhi[i][1], vhi[i][2], vhi[i][3]}
__device__ __forceinline__ float rowmax(const f32x16& p0, const f32x16& p1) {
    float a = MX3(p0[0], p0[1], p1[0]), b = MX3(p0[2], p0[3], p1[1]); a = MX3(a, p1[2], p1[3]);
#pragma unroll
    for (int r = 4; r < 16; r += 4) { a = MX3(a, p0[r], p0[r + 1]); b = MX3(b, p0[r + 2], p0[r + 3]); a = MX3(a, p1[r], p1[r + 1]); b = MX3(b, p1[r + 2], p1[r + 3]); }
    float m = __builtin_fmaxf(a, b); auto rr = __builtin_amdgcn_permlane32_swap(__float_as_uint(m), __float_as_uint(m), false, false);
    return __builtin_fmaxf(__uint_as_float(rr[0]), __uint_as_float(rr[1])); }
__device__ __forceinline__ float big_shift(float sacc) {
    auto rr = __builtin_amdgcn_permlane32_swap(__float_as_uint(sacc), __float_as_uint(sacc), false, false);
    const float m = __builtin_fmaxf(__uint_as_float(rr[0]), __uint_as_float(rr[1]));
    return m > 1073741824.0f ? (float)((int)(__float_as_uint(m) >> 23) - 127) : 0.f;
}
__device__ __forceinline__ float halfsum(float v) { auto rr = __builtin_amdgcn_permlane32_swap(__float_as_uint(v), __float_as_uint(v), false, false); return __uint_as_float(rr[0]) + __uint_as_float(rr[1]); }
__device__ __forceinline__ void cmask(f32x16& p0, f32x16& p1, int jb, int qrel, int hi) {
    const int kb = 64 * jb + 4 * hi;
#pragma unroll
    for (int r = 0; r < 16; ++r) { const int kv = kb + (r & 3) + 8 * (r >> 2); if (kv > qrel) p0[r] = -INFINITY; if (kv + 32 > qrel) p1[r] = -INFINITY; } }
__device__ __forceinline__ void store_o(const f32x16& v0, const f32x16& v1, LAS3 bf16* stg, bf16* Ow, int op, int lane, int r32, int hi) {
#pragma unroll
    for (int r = 0; r < 16; ++r) { const int orow = crow(r, hi);
        stg[orow * 64 + r32] = (bf16)(cvtpk(v0[r], 0.f) & 0xffffu); stg[orow * 64 + 32 + r32] = (bf16)(cvtpk(v1[r], 0.f) & 0xffffu); }
    asm volatile("s_waitcnt lgkmcnt(0)" ::: "memory");
#pragma unroll
    for (int i = 0; i < 4; ++i) { const int row = i * 8 + (lane >> 3), ch = lane & 7; const u32x4 v = *(const LAS3 u32x4*)(stg + row * 64 + ch * 8); *(GAS u32x4*)(Ow + (size_t)row * op + ch * 8) = v; }
    asm volatile("s_waitcnt lgkmcnt(0)" ::: "memory");
}
#define MLA_STEP(C0, C1, P0, P1, t) do { SBAR(); \
    const int sl_knext = (((t) + 1) & 3) * KS; const lds_cptr vp_ = vp0 + (((t) - 1) & 3) * VS; const lds_cptr kr_ = kp0 + ((t) & 3) * KS + 8192; \
    float sacc = (P0[0] + P0[1]); \
    C0 = MFMA(kf[0], qr[0], negm); sacc += P0[2]; sacc += P0[3]; sacc += P0[4]; PIN(sacc); pw0[0] = cvtpk(P0[0], P0[1]); pw0[1] = cvtpk(P0[2], P0[3]); PIN(pw0); SBAR(); \
    C1 = MFMA(kf[1], qr[0], negm); sacc += P0[5]; sacc += P0[6]; sacc += P0[7]; PIN(sacc); pw0[2] = cvtpk(P0[4], P0[5]); pw0[3] = cvtpk(P0[6], P0[7]); PIN(pw0); SBAR(); \
    C0 = MFMA(kf[2], qr[1], C0); sacc += P0[8]; sacc += P0[9]; sacc += P0[10]; PIN(sacc); pw1[0] = cvtpk(P0[8], P0[9]); PIN(pw1); SBAR(); \
    C1 = MFMA(kf[3], qr[1], C1); sacc += P0[11]; sacc += P0[12]; sacc += P0[13]; PIN(sacc); pw1[1] = cvtpk(P0[10], P0[11]); PIN(pw1); SBAR(); \
    kf[0] = *(const LAS3 bf16x8*)(kr_ + 0); SBAR(); C0 = MFMA(kf[4], qr[2], C0); sacc += P0[14]; sacc += P0[15]; sacc += P1[0]; PIN(sacc); pw1[2] = cvtpk(P0[12], P0[13]); PIN(pw1); SBAR(); \
    kf[1] = *(const LAS3 bf16x8*)(kr_ + 512); SBAR(); C1 = MFMA(kf[5], qr[2], C1); sacc += P1[1]; sacc += P1[2]; sacc += P1[3]; PIN(sacc); pw1[3] = cvtpk(P0[14], P0[15]); PIN(pw1); SBAR(); \
    kf[2] = *(const LAS3 bf16x8*)(kr_ + 2048); SBAR(); C0 = MFMA(kf[6], qr[3], C0); sacc += P1[4]; sacc += P1[5]; PIN(sacc); pw2[0] = cvtpk(P1[0], P1[1]); pw2[1] = cvtpk(P1[2], P1[3]); PIN(pw2); SBAR(); \
    kf[3] = *(const LAS3 bf16x8*)(kr_ + 2560); SBAR(); C1 = MFMA(kf[7], qr[3], C1); sacc += P1[6]; sacc += P1[7]; PIN(sacc); pw2[2] = cvtpk(P1[4], P1[5]); pw2[3] = cvtpk(P1[6], P1[7]); PIN(pw2); SBAR(); \
    C0 = MFMA(kf[0], qr[4], C0); sacc += P1[8]; sacc += P1[9]; PIN(sacc); pw3[0] = cvtpk(P1[8], P1[9]); PIN(pw3); SBAR(); \
    C1 = MFMA(kf[1], qr[4], C1); sacc += P1[10]; sacc += P1[11]; PIN(sacc); pw3[1] = cvtpk(P1[10], P1[11]); PIN(pw3); SBAR(); \
    if (PROBE != 4) { vlo[0] = vtr(vp_ + 0); vhi[0] = vtr(vp_ + 512); } SBAR(); C0 = MFMA(kf[2], qr[5], C0); sacc += P1[12]; sacc += P1[13]; PIN(sacc); pw3[2] = cvtpk(P1[12], P1[13]); PIN(pw3); SBAR(); \
    if (PROBE != 4) { vlo[4] = vtr(vp_ + 4096); vhi[4] = vtr(vp_ + 4608); } SBAR(); C1 = MFMA(kf[3], qr[5], C1); sacc += P1[14]; sacc += P1[15]; PIN(sacc); pw3[3] = cvtpk(P1[14], P1[15]); PIN(pw3); SBAR(); \
    l_reg += sacc; \
    if ((t) - (NT - 4) >= (wid >> 1)) cmask(C0, C1, (t) - (NT - 4), qrel, hi); \
    MLA_DECIDE(C0, C1); SBAR(); MLA_MIDBAR(); SBAR(); \
    if (PROBE != 4) { vlo[1] = vtr(vp_ + 1024); vhi[1] = vtr(vp_ + 1536); } SBAR(); if (PROBE != 6) o[0] = MFMA(PAF(0), VFR(0), o[0]); C0[0] = MEX(C0[0]); C0[1] = MEX(C0[1]); C0[2] = MEX(C0[2]); C0[3] = MEX(C0[3]); PIN(C0); SBAR(); \
    if (PROBE != 4) { vlo[5] = vtr(vp_ + 5120); vhi[5] = vtr(vp_ + 5632); } SBAR(); if (PROBE != 5) { kf[0] = *(const LAS3 bf16x8*)(kp0 + sl_knext + 0); kf[1] = *(const LAS3 bf16x8*)(kp0 + sl_knext + 512); } SBAR(); if (PROBE != 6) o[1] = MFMA(PAF(0), VFR(4), o[1]); C0[4] = MEX(C0[4]); C0[5] = MEX(C0[5]); C0[6] = MEX(C0[6]); C0[7] = MEX(C0[7]); PIN(C0); SBAR(); \
    if (PROBE != 4) { vlo[2] = vtr(vp_ + 2048); vhi[2] = vtr(vp_ + 2560); } SBAR(); if (PROBE != 5) { kf[2] = *(const LAS3 bf16x8*)(kp0 + sl_knext + 2048); kf[3] = *(const LAS3 bf16x8*)(kp0 + sl_knext + 2560); } SBAR(); if (PROBE != 6) o[0] = MFMA(PAF(1), VFR(1), o[0]); C0[8] = MEX(C0[8]); C0[9] = MEX(C0[9]); C0[10] = MEX(C0[10]); C0[11] = MEX(C0[11]); PIN(C0); SBAR(); \
    if (PROBE != 4) { vlo[6] = vtr(vp_ + 6144); vhi[6] = vtr(vp_ + 6656); } SBAR(); if (PROBE != 5) { kf[4] = *(const LAS3 bf16x8*)(kp0 + sl_knext + 4096); kf[5] = *(const LAS3 bf16x8*)(kp0 + sl_knext + 4608); } SBAR(); if (PROBE != 6) o[1] = MFMA(PAF(1), VFR(5), o[1]); C0[12] = MEX(C0[12]); C0[13] = MEX(C0[13]); C0[14] = MEX(C0[14]); C0[15] = MEX(C0[15]); PIN(C0); SBAR(); \
    if (PROBE != 4) { vlo[3] = vtr(vp_ + 3072); vhi[3] = vtr(vp_ + 3584); } SBAR(); if (PROBE != 5) { kf[6] = *(const LAS3 bf16x8*)(kp0 + sl_knext + 6144); kf[7] = *(const LAS3 bf16x8*)(kp0 + sl_knext + 6656); } SBAR(); if (PROBE != 6) o[0] = MFMA(PAF(2), VFR(2), o[0]); C1[0] = MEX(C1[0]); C1[1] = MEX(C1[1]); C1[2] = MEX(C1[2]); C1[3] = MEX(C1[3]); PIN(C1); SBAR(); \
    if (PROBE != 4) { vlo[7] = vtr(vp_ + 7168); vhi[7] = vtr(vp_ + 7680); } SBAR(); if (PROBE != 6) o[1] = MFMA(PAF(2), VFR(6), o[1]); C1[4] = MEX(C1[4]); C1[5] = MEX(C1[5]); C1[6] = MEX(C1[6]); C1[7] = MEX(C1[7]); PIN(C1); SBAR(); \
    if (PROBE != 6) o[0] = MFMA(PAF(3), VFR(3), o[0]); C1[8] = MEX(C1[8]); C1[9] = MEX(C1[9]); C1[10] = MEX(C1[10]); C1[11] = MEX(C1[11]); PIN(C1); SBAR(); \
    if (PROBE != 6) o[1] = MFMA(PAF(3), VFR(7), o[1]); C1[12] = MEX(C1[12]); C1[13] = MEX(C1[13]); C1[14] = MEX(C1[14]); C1[15] = MEX(C1[15]); PIN(C1); SBAR(); \
    } while (0)

#define DIFF_STEP(C0, C1, P0, P1, OP, MP, t, VSL, KNEXT, KND0, NMH, TBN, HASPREV, FIRST) do { SBAR(); \
    const lds_cptr vp_ = vp0 + (VSL); float sacc = 0.f; \
    C0 = MFMA(kx0, QXF(), (f32x16){}); if (HASPREV) { sacc += P0[0]; sacc += P0[1]; sacc += P0[2]; sacc += P0[3]; sacc += P0[4]; sacc += P0[5]; PIN(sacc); pw0[0] = cvtpk(P0[0], P0[1]); pw0[1] = cvtpk(P0[2], P0[3]); pw0[2] = cvtpk(P0[4], P0[5]); PIN(pw0); } SBAR(); \
    C1 = MFMA(kx1, QXF(), (f32x16){}); if (HASPREV) { sacc += P0[6]; sacc += P0[7]; sacc += P0[8]; sacc += P0[9]; sacc += P0[10]; sacc += P0[11]; PIN(sacc); pw0[3] = cvtpk(P0[6], P0[7]); pw1[0] = cvtpk(P0[8], P0[9]); pw1[1] = cvtpk(P0[10], P0[11]); PIN(pw0); PIN(pw1); } SBAR(); \
    C0 = MFMA(kf[0], qr[2 * (MP)], C0); if (HASPREV) { sacc += P0[12]; sacc += P0[13]; sacc += P0[14]; sacc += P0[15]; sacc += P1[0]; PIN(sacc); pw1[2] = cvtpk(P0[12], P0[13]); pw1[3] = cvtpk(P0[14], P0[15]); pw2[0] = cvtpk(P1[0], P1[1]); PIN(pw1); PIN(pw2); } SBAR(); \
    C1 = MFMA(kf[1], qr[2 * (MP)], C1); if (HASPREV) { sacc += P1[1]; sacc += P1[2]; sacc += P1[3]; sacc += P1[4]; sacc += P1[5]; PIN(sacc); pw2[1] = cvtpk(P1[2], P1[3]); pw2[2] = cvtpk(P1[4], P1[5]); pw2[3] = cvtpk(P1[6], P1[7]); PIN(pw2); } SBAR(); \
    if (HASPREV) { vlo[0] = vtr(vp_ + 0); vhi[0] = vtr(vp_ + 512); } SBAR(); C0 = MFMA(kf[2], qr[2 * (MP) + 1], C0); if (HASPREV) { sacc += P1[6]; sacc += P1[7]; sacc += P1[8]; sacc += P1[9]; sacc += P1[10]; PIN(sacc); pw3[0] = cvtpk(P1[8], P1[9]); pw3[1] = cvtpk(P1[10], P1[11]); PIN(pw3); } SBAR(); \
    if (HASPREV) { vlo[4] = vtr(vp_ + 4096); vhi[4] = vtr(vp_ + 4608); } SBAR(); C1 = MFMA(kf[3], qr[2 * (MP) + 1], C1); if (HASPREV) { sacc += P1[11]; sacc += P1[12]; sacc += P1[13]; sacc += P1[14]; sacc += P1[15]; PIN(sacc); pw3[2] = cvtpk(P1[12], P1[13]); pw3[3] = cvtpk(P1[14], P1[15]); PIN(pw3); } SBAR(); \
    if (HASPREV) { if ((MP) == 0) l2 += sacc; else l1 += sacc; } \
    if ((t) - (NT - 4) >= (wid >> 1)) cmask(C0, C1, (t) - (NT - 4), qrel, hi); \
    DIFF_DECIDE(C0, C1, MP, FIRST, HASPREV); SBAR(); \
    if (HASPREV) { vlo[1] = vtr(vp_ + 1024); vhi[1] = vtr(vp_ + 1536); } SBAR(); if (HASPREV) OP[0] = MFMA(PAF(0), VFR(0), OP[0]); C0[0] = EX(C0[0]); C0[1] = EX(C0[1]); C0[2] = EX(C0[2]); C0[3] = EX(C0[3]); PIN(C0); QX_SET((TBN) - (NMH)); SBAR(); \
    if (HASPREV) { vlo[5] = vtr(vp_ + 5120); vhi[5] = vtr(vp_ + 5632); } SBAR(); kf[0] = *(const LAS3 bf16x8*)(kp0 + (KNEXT) + ((KND0) + 0) * 2048 + 0); SBAR(); if (HASPREV) OP[1] = MFMA(PAF(0), VFR(4), OP[1]); C0[4] = EX(C0[4]); C0[5] = EX(C0[5]); C0[6] = EX(C0[6]); C0[7] = EX(C0[7]); PIN(C0); SBAR(); \
    if (HASPREV) { vlo[2] = vtr(vp_ + 2048); vhi[2] = vtr(vp_ + 2560); } SBAR(); kf[1] = *(const LAS3 bf16x8*)(kp0 + (KNEXT) + ((KND0) + 0) * 2048 + 512); SBAR(); if (HASPREV) OP[0] = MFMA(PAF(1), VFR(1), OP[0]); C0[8] = EX(C0[8]); C0[9] = EX(C0[9]); C0[10] = EX(C0[10]); C0[11] = EX(C0[11]); PIN(C0); SBAR(); \
    if (HASPREV) { vlo[6] = vtr(vp_ + 6144); vhi[6] = vtr(vp_ + 6656); } SBAR(); kf[2] = *(const LAS3 bf16x8*)(kp0 + (KNEXT) + ((KND0) + 1) * 2048 + 0); SBAR(); if (HASPREV) OP[1] = MFMA(PAF(1), VFR(5), OP[1]); C0[12] = EX(C0[12]); C0[13] = EX(C0[13]); C0[14] = EX(C0[14]); C0[15] = EX(C0[15]); PIN(C0); SBAR(); \
    if (HASPREV) { vlo[3] = vtr(vp_ + 3072); vhi[3] = vtr(vp_ + 3584); } SBAR(); kf[3] = *(const LAS3 bf16x8*)(kp0 + (KNEXT) + ((KND0) + 1) * 2048 + 512); SBAR(); if (HASPREV) OP[0] = MFMA(PAF(2), VFR(2), OP[0]); C1[0] = EX(C1[0]); C1[1] = EX(C1[1]); C1[2] = EX(C1[2]); C1[3] = EX(C1[3]); PIN(C1); SBAR(); \
    if (HASPREV) { vlo[7] = vtr(vp_ + 7168); vhi[7] = vtr(vp_ + 7680); } SBAR(); if (HASPREV) OP[1] = MFMA(PAF(2), VFR(6), OP[1]); C1[4] = EX(C1[4]); C1[5] = EX(C1[5]); C1[6] = EX(C1[6]); C1[7] = EX(C1[7]); PIN(C1); SBAR(); \
    if (HASPREV) OP[0] = MFMA(PAF(3), VFR(3), OP[0]); C1[8] = EX(C1[8]); C1[9] = EX(C1[9]); C1[10] = EX(C1[10]); C1[11] = EX(C1[11]); PIN(C1); SBAR(); \
    if (HASPREV) OP[1] = MFMA(PAF(3), VFR(7), OP[1]); C1[12] = EX(C1[12]); C1[13] = EX(C1[13]); C1[14] = EX(C1[14]); C1[15] = EX(C1[15]); PIN(C1); SBAR(); \
    if (rescd) { asm volatile("s_waitcnt lgkmcnt(0)" ::: "memory"); _Pragma("unroll") for (int r = 0; r < 16; ++r) { const float g_ = wsf[crow(r, hi)]; OP[0][r] *= g_; OP[1][r] *= g_; } asm volatile("s_waitcnt lgkmcnt(0)" ::: "memory"); } \
    } while (0)


constexpr int MLA_KS = 12288, MLA_VS = 8192, MLA_LV = 4 * MLA_KS, MLA_WS = MLA_LV + 4 * MLA_VS, MLA_OST = MLA_WS + 8 * 256, MLA_LDS = MLA_OST + 8 * 4096;
constexpr int DIF_KS = 8192, DIF_VS = 8192, DIF_LV = 4 * DIF_KS, DIF_WS = DIF_LV + 4 * DIF_VS, DIF_OST = DIF_WS + 8 * 256, DIF_LDS = DIF_OST + 8 * 4096;
constexpr int ATT_LDS_BYTES = MLA_LDS > DIF_LDS ? MLA_LDS : DIF_LDS;

struct UnitId { int qb, b, h, t0; };
struct MlaT { const bf16* q; const bf16* kv; const bf16* kr; bf16* cat; };
struct DiffT { const bf16* proj; bf16* cat; };
#define MLA_QH(T, D) ((T).q + (size_t)(D).b * 2048 * 576 + (D).h * 96)
#define MLA_KH(T, D) ((T).kv + (size_t)(D).b * 2048 * 768 + (D).h * 128)
#define MLA_KRH(T, D) ((T).kr + (size_t)(D).b * 2048 * 32)
#define MLA_VH(T, D) ((T).kv + (size_t)(D).b * 2048 * 768 + (D).h * 128 + 64)
#define MLA_OH(T, D) ((T).cat + (size_t)(D).b * 2048 * 1024 + 256 + (D).h * 64)
#define DIF_QH(T, D) ((T).proj + (size_t)(D).b * 2048 * 2304 + 1024 + (D).h * 64)
#define DIF_KH(T, D) ((T).proj + ((size_t)(D).b * 2048 + (size_t)(D).t0 * 64) * 2304 + 1408 + (D).h * 64)
#define DIF_VH(T, D) ((T).proj + ((size_t)(D).b * 2048 + (size_t)(D).t0 * 64) * 2304 + 1792 + (D).h * 64)
#define DIF_OH(T, D) ((T).cat + (size_t)(D).b * 2048 * 1024 + 640 + (D).h * 64)

template <int THRL, int PROBE = 0  >
__device__ __forceinline__ void mla_unit(const MlaT& T, const UnitId& U, bool first, bool has_next, const UnitId& UN, bf16x8 (&qr)[6], lds_ptr shm, int tid_in) {
    int tid = tid_in; asm volatile("" : "+v"(tid));
    constexpr int QP = 576, KP = 768, VP = 768, OP = 1024, KS = MLA_KS, VS = MLA_VS;
    const int lane = tid & 63, r32 = lane & 31, hi = lane >> 5; const int wid = __builtin_amdgcn_readfirstlane(tid >> 6);
    const int q0 = U.qb * 256, NT = (q0 + 256) / 64;
    const int tl = NT - 1;
    const bool h2 = wid >= 4;
    const unsigned lds0 = (unsigned)(uintptr_t)shm;
    LAS3 float* wsf = (LAS3 float*)(shm + MLA_WS) + wid * 64;
    const unsigned koff = PROBE == 7 ? (unsigned)((wid * 8 + (lane >> 3)) * KP + (lane & 7) * 8) * 2u : (unsigned)(lane * KP + wid * 8) * 2u;
    const unsigned kroff = (unsigned)(lane * 32 + (wid & 3) * 8) * 2u;
    const unsigned voff = (unsigned)((16 * (wid & 3) + (lane >> 2)) * VP + (wid >> 2) * 32 + (lane & 3) * 8) * 2u;
    const unsigned kdst = lds0 + wid * 1024, krdst = lds0 + (8 + (wid & 3)) * 1024, vdst = lds0 + MLA_LV + wid * 1024;
#define DMA_K_(D, t, off) do { glds16(MLA_KH(T, D) + (size_t)(t) * 64 * KP, koff, (unsigned)__builtin_amdgcn_readfirstlane(kdst + (off))); glds16(MLA_KRH(T, D) + (size_t)(t) * 64 * 32, kroff, (unsigned)__builtin_amdgcn_readfirstlane(krdst + (off))); } while (0)
#define DMA_V_(D, t, off) glds16(MLA_VH(T, D) + (size_t)(t) * 64 * VP, voff, (unsigned)__builtin_amdgcn_readfirstlane(vdst + (off)))
#define DMA_K(t, off) DMA_K_(U, t, off)
#define DMA_V(t, off) DMA_V_(U, t, off)
#define LOAD_Q(D) do { const bf16* Qw_ = MLA_QH(T, D) + (size_t)((D).qb * 256 + wid * 32) * QP; _Pragma("unroll") for (int d0 = 0; d0 < 6; ++d0) qr[d0] = *(const GAS bf16x8*)(Qw_ + (size_t)r32 * QP + d0 * 16 + hi * 8); } while (0)
    const lds_cptr vp0 = (lds_cptr)shm + MLA_LV + ((lane >> 4) & 1) * 32 + (lane & 3) * 8 + (4 * hi + ((lane & 15) >> 2)) * 64;
    const lds_cptr kp0 = (lds_cptr)shm + hi * 1024 + r32 * 16;
    if (first) { DMA_K(0, 0); DMA_V(0, 0); DMA_K(1, KS); DMA_V(1, VS); DMA_K(2, 2 * KS); LOAD_Q(U); }
    float mhat = 0.f, l_reg = 0.f; f32x16 o[2]; o[0] = f32x16{}; o[1] = f32x16{}; f32x16 negm = f32x16{}; PIN(negm);
    const int qrel = wid * 32 + r32; bool resc = false;
    f32x16 pA0, pA1, pB0, pB1; bf16x8 kf[8]; s16x4 vlo[8], vhi[8]; u32x4 pw0, pw1, pw2, pw3;
    if (PROBE >= 4) { _Pragma("unroll") for (int i = 0; i < 8; ++i) { vlo[i] = s16x4{}; vhi[i] = s16x4{}; } }
    WAIT_BAR0();
    DMA_K(3, 3 * KS); DMA_V(2, 2 * VS);
    { pA0 = negm; pA1 = negm;
#pragma unroll
      for (int d0 = 0; d0 < 6; ++d0) { const bf16x8 k0 = *(const LAS3 bf16x8*)(kp0 + d0 * 2048), k1 = *(const LAS3 bf16x8*)(kp0 + d0 * 2048 + 512); pA0 = MFMA(k0, qr[d0], pA0); pA1 = MFMA(k1, qr[d0], pA1); }
      if (NT == 4) cmask(pA0, pA1, 0, qrel, hi);
      const float rm = rowmax(pA0, pA1); mhat = rm;
#pragma unroll
      for (int r = 0; r < 16; ++r) { pA0[r] = EX(pA0[r] - rm); pA1[r] = EX(pA1[r] - rm); negm[r] = -mhat; }
      PIN(negm); }
#pragma unroll
    for (int d0 = 0; d0 < 4; ++d0) { kf[2 * d0] = *(const LAS3 bf16x8*)(kp0 + KS + d0 * 2048); kf[2 * d0 + 1] = *(const LAS3 bf16x8*)(kp0 + KS + d0 * 2048 + 512); }
    WAIT_BAR0();
    if (NT > 4) DMA_K(4, 0);
    if (h2) DMA_V(3, 3 * VS);
#define MEX(v) (PROBE == 1 ? (v) : EX(v))
#define MLA_MIDBAR() asm volatile("s_barrier" ::: "memory")
#define MLA_DECIDE(C0, C1) do { const float dl = big_shift(sacc); resc = false; \
        if (__builtin_expect(__any(dl > 0.f), 0)) { mhat += dl; \
            _Pragma("unroll") for (int r = 0; r < 16; ++r) { C0[r] -= dl; C1[r] -= dl; } \
            _Pragma("unroll") for (int r = 0; r < 16; ++r) negm[r] = -mhat; PIN(negm); \
            const float f = EX(-dl); l_reg *= f; if (hi == 0) wsf[r32] = f; resc = true; } } while (0)
#define MLA_RESC() do { if (resc) { asm volatile("s_waitcnt lgkmcnt(0)" ::: "memory"); _Pragma("unroll") for (int r = 0; r < 16; ++r) { const float f = wsf[crow(r, hi)]; o[0][r] *= f; o[1][r] *= f; } resc = false; } } while (0)
#define MLA_END(t) do { WAIT_BAR0(); MLA_RESC(); \
        if ((t) + 4 < NT) DMA_K((t) + 4, (((t) + 4) & 3) * KS); \
        if (h2) { if ((t) + 3 < NT) DMA_V((t) + 3, (((t) + 3) & 3) * VS); } else { if ((t) + 2 < NT && (t) >= 1) DMA_V((t) + 2, (((t) + 2) & 3) * VS); } } while (0)
#define MLA_DRAIN(P0, P1) do { float sacc = 0.f; \
      _Pragma("unroll") for (int r = 0; r < 16; ++r) sacc += P0[r] + P1[r]; \
      l_reg += sacc; \
      pw0 = (u32x4){cvtpk(P0[0], P0[1]), cvtpk(P0[2], P0[3]), cvtpk(P0[4], P0[5]), cvtpk(P0[6], P0[7])}; pw1 = (u32x4){cvtpk(P0[8], P0[9]), cvtpk(P0[10], P0[11]), cvtpk(P0[12], P0[13]), cvtpk(P0[14], P0[15])}; \
      pw2 = (u32x4){cvtpk(P1[0], P1[1]), cvtpk(P1[2], P1[3]), cvtpk(P1[4], P1[5]), cvtpk(P1[6], P1[7])}; pw3 = (u32x4){cvtpk(P1[8], P1[9]), cvtpk(P1[10], P1[11]), cvtpk(P1[12], P1[13]), cvtpk(P1[14], P1[15])}; \
      const lds_cptr vp_ = vp0 + (tl & 3) * VS; \
      _Pragma("unroll") for (int i = 0; i < 8; ++i) { vlo[i] = vtr(vp_ + (i >> 2) * 4096 + (i & 3) * 1024); vhi[i] = vtr(vp_ + (i >> 2) * 4096 + (i & 3) * 1024 + 512); } \
      o[0] = MFMA(PAF(0), VFR(0), o[0]); o[1] = MFMA(PAF(0), VFR(4), o[1]); o[0] = MFMA(PAF(1), VFR(1), o[0]); o[1] = MFMA(PAF(1), VFR(5), o[1]); \
      o[0] = MFMA(PAF(2), VFR(2), o[0]); o[1] = MFMA(PAF(2), VFR(6), o[1]); o[0] = MFMA(PAF(3), VFR(3), o[0]); o[1] = MFMA(PAF(3), VFR(7), o[1]); } while (0)
#define MLA_EPI() do { l_reg = halfsum(l_reg); \
      int le = lane; asm volatile("" : "+v"(le)); const int r32e = le & 31, hie = le >> 5; \
      if (hie == 0) wsf[32 + r32e] = 1.0f / l_reg; \
      asm volatile("s_waitcnt lgkmcnt(0)" ::: "memory"); \
      f32x16 v0, v1; \
      _Pragma("unroll") for (int r = 0; r < 16; ++r) { const float f = wsf[32 + crow(r, hie)]; v0[r] = o[0][r] * f; v1[r] = o[1][r] * f; } \
      store_o(v0, v1, (LAS3 bf16*)(shm + MLA_OST) + wid * 2048, MLA_OH(T, U) + (size_t)(q0 + wid * 32) * OP, OP, le, r32e, hie); } while (0)
    if (h2) MLA_MIDBAR();
    int t = 1;
    for (; t + 1 <= tl; t += 2) {
        MLA_STEP(pB0, pB1, pA0, pA1, t); MLA_END(t);
        MLA_STEP(pA0, pA1, pB0, pB1, t + 1); MLA_END(t + 1);
    }
    MLA_STEP(pB0, pB1, pA0, pA1, tl);
    if (!h2) MLA_MIDBAR();
    WAIT_BAR0();
    if (has_next) { DMA_K_(UN, 0, 0); DMA_V_(UN, 0, 0); DMA_K_(UN, 1, KS); DMA_V_(UN, 1, VS); DMA_K_(UN, 2, 2 * KS); LOAD_Q(UN); }
    MLA_RESC();
    MLA_DRAIN(pB0, pB1);
    MLA_EPI();
#undef DMA_K_
#undef DMA_V_
#undef DMA_K
#undef DMA_V
#undef LOAD_Q
#undef MEX
#undef MLA_MIDBAR
#undef MLA_DECIDE
#undef MLA_RESC
#undef MLA_END
#undef MLA_DRAIN
#undef MLA_EPI
}

template <int THRL>
__device__ __forceinline__ void diff_unit(const DiffT& T, const UnitId& U, bool first, bool has_next, const UnitId& UN, bf16x8 (&qr)[4], float lam, lds_ptr shm, int tid_in) {
    int tid = tid_in; asm volatile("" : "+v"(tid));
    constexpr int PP = 2304, OP = 1024, KS = DIF_KS, VS = DIF_VS;
    const int lane = tid & 63, r32 = lane & 31, hi = lane >> 5; const int wid = __builtin_amdgcn_readfirstlane(tid >> 6);
    const int q0 = U.qb * 256, NT = (q0 + 256) / 64 - U.t0, kz = 64 * U.t0;
    const int tl = NT - 4 + (wid >> 1);
    const float slope2 = exp2f(-8.0f * (float)(U.h + 1) / 6.0f) * 1.4426950408889634f;
    const unsigned lds0 = (unsigned)(uintptr_t)shm;
    LAS3 float* wsf = (LAS3 float*)(shm + DIF_WS) + wid * 64;
    const unsigned koff = (unsigned)(lane * PP + wid * 8) * 2u;
    const unsigned voff = (unsigned)((16 * (wid & 3) + (lane >> 2)) * PP + (wid >> 2) * 32 + (lane & 3) * 8) * 2u;
    const unsigned kdst = lds0 + wid * 1024, vdst = lds0 + DIF_LV + wid * 1024;
#define DMA_K_(D, t, off) glds16(DIF_KH(T, D) + (size_t)(t) * 64 * PP, koff, (unsigned)__builtin_amdgcn_readfirstlane(kdst + (off)))
#define DMA_V_(D, t, off) glds16(DIF_VH(T, D) + (size_t)(t) * 64 * PP, voff, (unsigned)__builtin_amdgcn_readfirstlane(vdst + (off)))
#define DMA_K(t, off) DMA_K_(U, t, off)
#define DMA_V(t, off) DMA_V_(U, t, off)
#define LOAD_Q(D) do { const bf16* Qw_ = DIF_QH(T, D) + (size_t)((D).qb * 256 + wid * 32) * PP; _Pragma("unroll") for (int d0 = 0; d0 < 4; ++d0) qr[d0] = *(const GAS bf16x8*)(Qw_ + (size_t)r32 * PP + d0 * 16 + hi * 8); } while (0)
    const lds_cptr vp0 = (lds_cptr)shm + DIF_LV + ((lane >> 4) & 1) * 32 + (lane & 3) * 8 + (4 * hi + ((lane & 15) >> 2)) * 64;
    const lds_cptr kp0 = (lds_cptr)shm + hi * 1024 + r32 * 16;
    if (first) { DMA_K(0, 0); DMA_V(0, 0); DMA_K(1, KS); DMA_V(1, VS); DMA_K(2, 2 * KS); LOAD_Q(U); }
    float mh1 = 0.f, mh2 = 0.f, l1 = 0.f, l2 = 0.f; f32x16 o1[2], o2[2]; o1[0] = f32x16{}; o1[1] = f32x16{}; o2[0] = f32x16{}; o2[1] = f32x16{};
    const int qrel = wid * 32 + r32;
    const float tb0 = slope2 * (float)(kz - (q0 + qrel)), tbs = 64.0f * slope2;
    const unsigned sb0 = __float_as_uint(slope2) & 0xffff0000u; const float sr1 = slope2 - __uint_as_float(sb0); const unsigned sb1 = __float_as_uint(sr1) & 0xffff0000u; const float sr2 = sr1 - __uint_as_float(sb1);
    const unsigned s2w = __float_as_uint(sr2);
    u32x4 qxw; qxw.x = __builtin_amdgcn_perm(sb1, sb0, 0x07060302u); qxw.y = 0u; qxw.z = 0u; qxw.w = 0u;
    bf16x8 kx0, kx1; { const unsigned i0 = __float_as_uint((float)r32) >> 16, i1 = __float_as_uint((float)(r32 + 32)) >> 16, one = 0x3f80u; const bool lo = (hi == 0);
        const u32x4 a0 = lo ? (u32x4){i0 | (i0 << 16), i0 | (one << 16), one | (one << 16), 0u} : (u32x4){0u, 0u, 0u, 0u}, a1 = lo ? (u32x4){i1 | (i1 << 16), i1 | (one << 16), one | (one << 16), 0u} : (u32x4){0u, 0u, 0u, 0u};
        kx0 = __builtin_bit_cast(bf16x8, a0); kx1 = __builtin_bit_cast(bf16x8, a1); }
#define QXF() __builtin_bit_cast(bf16x8, qxw)
#define QX_SET(uexpr) do { const float u_ = (uexpr); const unsigned ub_ = __float_as_uint(u_); const float r1_ = u_ - __uint_as_float(ub_ & 0xffff0000u); const unsigned r1b_ = __float_as_uint(r1_); \
        const float r2_ = r1_ - __uint_as_float(r1b_ & 0xffff0000u); qxw.y = __builtin_amdgcn_perm(ub_, s2w, 0x07060302u); qxw.z = __builtin_amdgcn_perm(__float_as_uint(r2_), r1b_, 0x07060302u); PIN(qxw); } while (0)
    const float bmax0 = slope2 * __builtin_fminf((float)(63 + kz - (q0 + qrel)), 0.f);
    f32x16 pA0, pA1, pB0, pB1; bf16x8 kf[4]; s16x4 vlo[8], vhi[8]; u32x4 pw0, pw1, pw2, pw3; bool rescd = false;
    WAIT_BAR0();
    DMA_K(3, 3 * KS); DMA_V(2, 2 * VS);
#pragma unroll
    for (int q = 0; q < 4; ++q) kf[q] = *(const LAS3 bf16x8*)(kp0 + (q >> 1) * 2048 + (q & 1) * 512);
    QX_SET(tb0);
#define DIFF_DECIDE(C0, C1, MP, FIRST, HASPREV) do { rescd = false; \
        if (FIRST) { const float dl = rowmax(C0, C1) - bmax0; if ((MP) == 0) mh1 += dl; else mh2 += dl; \
            _Pragma("unroll") for (int r = 0; r < 16; ++r) { C0[r] -= dl; C1[r] -= dl; } } \
        if (HASPREV) { const float dl = big_shift(sacc); \
            if (__builtin_expect(__any(dl > 0.f), 0)) { const float f = EX(-dl); if ((MP) == 0) { mh2 += dl; l2 *= f; } else { mh1 += dl; l1 *= f; } if (hi == 0) wsf[r32] = f; rescd = true; } } } while (0)
    DIFF_STEP(pA0, pA1, pB0, pB1, o2, 0, 0, 0, 0, 2, mh2, tb0, 0, 1);
    DIFF_STEP(pB0, pB1, pA0, pA1, o1, 1, 0, 0, KS, 0, mh1, tb0 + tbs, 1, 1);
    if (NT > 4) { WAIT_BARN(2); DMA_K(4, 0); DMA_V(3, 3 * VS); } else { WAIT_BAR0(); DMA_V(3, 3 * VS); }
    float tbt = tb0 + tbs;
    for (int t = 1; t <= tl; ++t) {
        DIFF_STEP(pA0, pA1, pB0, pB1, o2, 0, t, ((t - 1) & 3) * VS, (t & 3) * KS, 2, mh2, tbt, 1, 0);
        DIFF_STEP(pB0, pB1, pA0, pA1, o1, 1, t, (t & 3) * VS, ((t + 1) & 3) * KS, 0, mh1, tbt + tbs, 1, 0);
        tbt += tbs;
        if (t + 1 < NT) { if (t + 4 < NT) { WAIT_BARN(2); } else { WAIT_BAR0(); }
            if (t + 4 < NT) DMA_K(t + 4, ((t + 4) & 3) * KS); if (t + 3 < NT) DMA_V(t + 3, ((t + 3) & 3) * VS); }
    }
#define DIFF_DRAIN() do { float sacc = 0.f; \
      _Pragma("unroll") for (int r = 0; r < 16; ++r) sacc += pB0[r] + pB1[r]; \
      l2 += sacc; \
      pw0 = (u32x4){cvtpk(pB0[0], pB0[1]), cvtpk(pB0[2], pB0[3]), cvtpk(pB0[4], pB0[5]), cvtpk(pB0[6], pB0[7])}; pw1 = (u32x4){cvtpk(pB0[8], pB0[9]), cvtpk(pB0[10], pB0[11]), cvtpk(pB0[12], pB0[13]), cvtpk(pB0[14], pB0[15])}; \
      pw2 = (u32x4){cvtpk(pB1[0], pB1[1]), cvtpk(pB1[2], pB1[3]), cvtpk(pB1[4], pB1[5]), cvtpk(pB1[6], pB1[7])}; pw3 = (u32x4){cvtpk(pB1[8], pB1[9]), cvtpk(pB1[10], pB1[11]), cvtpk(pB1[12], pB1[13]), cvtpk(pB1[14], pB1[15])}; \
      const lds_cptr vp_ = vp0 + (tl & 3) * VS; \
      _Pragma("unroll") for (int i = 0; i < 8; ++i) { vlo[i] = vtr(vp_ + (i >> 2) * 4096 + (i & 3) * 1024); vhi[i] = vtr(vp_ + (i >> 2) * 4096 + (i & 3) * 1024 + 512); } \
      o2[0] = MFMA(PAF(0), VFR(0), o2[0]); o2[1] = MFMA(PAF(0), VFR(4), o2[1]); o2[0] = MFMA(PAF(1), VFR(1), o2[0]); o2[1] = MFMA(PAF(1), VFR(5), o2[1]); \
      o2[0] = MFMA(PAF(2), VFR(2), o2[0]); o2[1] = MFMA(PAF(2), VFR(6), o2[1]); o2[0] = MFMA(PAF(3), VFR(3), o2[0]); o2[1] = MFMA(PAF(3), VFR(7), o2[1]); } while (0)
#define DIFF_EPI() do { l1 = halfsum(l1); l2 = halfsum(l2); \
      int le = lane; asm volatile("" : "+v"(le)); const int r32e = le & 31, hie = le >> 5; \
      if (hie == 0) { wsf[r32e] = 1.0f / l1; wsf[32 + r32e] = lam / l2; } \
      asm volatile("s_waitcnt lgkmcnt(0)" ::: "memory"); \
      f32x16 v0, v1; \
      _Pragma("unroll") for (int r = 0; r < 16; ++r) { const float f1 = wsf[crow(r, hie)], f2 = wsf[32 + crow(r, hie)]; v0[r] = o1[0][r] * f1 - o2[0][r] * f2; v1[r] = o1[1][r] * f1 - o2[1][r] * f2; } \
      _Pragma("unroll") for (int r = 0; r < 16; ++r) { float s_ = v0[r] * v0[r] + v1[r] * v1[r]; \
          s_ += __shfl_xor(s_, 1); s_ += __shfl_xor(s_, 2); s_ += __shfl_xor(s_, 4); s_ += __shfl_xor(s_, 8); s_ += __shfl_xor(s_, 16); \
          const float rn = __builtin_amdgcn_rsqf(s_ * (1.0f / 64.0f) + 1e-5f); v0[r] *= rn; v1[r] *= rn; } \
      store_o(v0, v1, (LAS3 bf16*)(shm + DIF_OST) + wid * 2048, DIF_OH(T, U) + (size_t)(q0 + wid * 32) * OP, OP, le, r32e, hie); } while (0)
    const bool early = tl < NT - 1;
    if (!early) { WAIT_BAR0();
        if (has_next) { DMA_K_(UN, 0, 0); DMA_V_(UN, 0, 0); DMA_K_(UN, 1, KS); DMA_V_(UN, 1, VS); DMA_K_(UN, 2, 2 * KS); LOAD_Q(UN); } }
    DIFF_DRAIN(); DIFF_EPI();
    if (early) {
        for (int t2 = tl + 1; t2 <= NT - 2; ++t2) WAIT_BAR0();
        WAIT_BAR0();
        if (has_next) { DMA_K_(UN, 0, 0); DMA_V_(UN, 0, 0); DMA_K_(UN, 1, KS); DMA_V_(UN, 1, VS); DMA_K_(UN, 2, 2 * KS); LOAD_Q(UN); }
    }
#undef DMA_K_
#undef DMA_V_
#undef DMA_K
#undef DMA_V
#undef LOAD_Q
#undef DIFF_DECIDE
#undef DIFF_DRAIN
#undef DIFF_EPI
#undef QXF
#undef QX_SET
}
}
#define XB_TMO      128
#define XB_XCNT(j)  (256  + 64 * (j))
#define XB_XSUB(j)  (1280 + 64 * (j))
#define XB_XGEN(j)  (2304 + 64 * (j))
#define XB_TOP      3328
#define XB_TOPGEN   3392
#define XCD_BAR_WORDS 3456
#define XB_SPIN_CAP (1u << 18)

__device__ __forceinline__ unsigned xb_ld(unsigned* p)              { return __hip_atomic_load(p, __ATOMIC_RELAXED, __HIP_MEMORY_SCOPE_AGENT); }
__device__ __forceinline__ unsigned xb_add(unsigned* p, unsigned v) { return __hip_atomic_fetch_add(p, v, __ATOMIC_RELAXED, __HIP_MEMORY_SCOPE_AGENT); }
__device__ __forceinline__ unsigned xb_xcc_id() { return (unsigned)__builtin_amdgcn_s_getreg((3 << 11) | 20) & 0xFu; }
#define XB_SPIN(cond, bar) do { unsigned _sp = 0; while (cond) { __builtin_amdgcn_s_sleep(1); \
    if ((++_sp & 255u) == 0u) { if (xb_ld(&(bar)[XB_TMO])) break; if (_sp > XB_SPIN_CAP) { atomicAdd(&(bar)[XB_TMO], 1u); break; } } } } while (0)

struct XcdBarrier {
    unsigned* bar; unsigned x;
    volatile LAS unsigned* st;
};

__device__ __forceinline__ XcdBarrier xcd_barrier_post(unsigned* bar, volatile LAS unsigned* st) {
    XcdBarrier b; b.bar = bar; b.x = xb_xcc_id(); b.st = st;
    if (threadIdx.x == 0) (void)xb_add(&bar[XB_XCNT(b.x)], 1u);
    return b;
}
__device__ __forceinline__ void xcd_barrier_complete(unsigned* bar, unsigned x, unsigned& nloc, unsigned& nx) {
    const unsigned G = gridDim.x * gridDim.y * gridDim.z;
    unsigned sum, cnt, mine, sp = 0u;
    for (;;) {
        sum = 0u; cnt = 0u; mine = 0u;
#pragma unroll
        for (unsigned j = 0; j < 16; ++j) { const unsigned c = xb_ld(&bar[XB_XCNT(j)]); sum += c; cnt += (c > 0u) ? 1u : 0u; mine = (j == x) ? c : mine; }
        if (sum == G) break;
        __builtin_amdgcn_s_sleep(1);
        if ((++sp & 255u) == 0u) { if (xb_ld(&bar[XB_TMO])) break; if (sp > XB_SPIN_CAP) { atomicAdd(&bar[XB_TMO], 1u); break; } }
    }
    nloc = mine > 0u ? mine : 1u; nx = cnt > 0u ? cnt : 1u;
}

__device__ __forceinline__ void xcd_barrier(const XcdBarrier& b) {
    asm volatile("s_waitcnt vmcnt(0)" ::: "memory");
    __syncthreads();
    if (threadIdx.x == 0) {
        unsigned* bar = b.bar;
        __builtin_amdgcn_s_waitcnt(0);
        unsigned nloc = b.st[0], nx = b.st[1];
        if (nloc == 0u) { xcd_barrier_complete(bar, b.x, nloc, nx); b.st[0] = nloc; b.st[1] = nx; }
        const unsigned old = xb_add(&bar[XB_XSUB(b.x)], 1u);
        const unsigned gen = old / nloc;
        if (old + 1u == (gen + 1u) * nloc) {
            __builtin_amdgcn_fence(__ATOMIC_RELEASE, "agent");
            asm volatile("s_waitcnt vmcnt(0)" ::: "memory");
            const unsigned og = xb_add(&bar[XB_TOP], 1u);
            const unsigned tg = og / nx;
            if (og + 1u == (tg + 1u) * nx) xb_add(&bar[XB_TOPGEN], 1u);
            else XB_SPIN(xb_ld(&bar[XB_TOPGEN]) == tg, bar);
            __builtin_amdgcn_fence(__ATOMIC_ACQUIRE, "agent");
            xb_add(&bar[XB_XGEN(b.x)], 1u);
            asm volatile("s_waitcnt vmcnt(0)" ::: "memory");
        } else {
            XB_SPIN(xb_ld(&bar[XB_XGEN(b.x)]) == gen, bar);
            __builtin_amdgcn_fence(__ATOMIC_ACQUIRE, "agent");
            asm volatile("s_waitcnt vmcnt(0)" ::: "memory");
        }
    }
    __syncthreads();
}

struct Args { const float* in[29]; float* out; unsigned char* ws; int ph_lo, ph_hi; };
struct Frame {
    LAS unsigned char* lds;
    volatile LAS unsigned* MISC;
    gu32* ctl;
    int tid, lane, wave, vcu, G;
    unsigned char* ws;
    float* out;
};
#define WSP(T, off) ((T*)(F.ws + (off)))

__device__ __forceinline__ int ropeperm(int i) { return (i < 16) ? (8 * (i >> 2) + (i & 3)) : (8 * ((i - 16) >> 2) + 4 + ((i - 16) & 3)); }
__device__ __forceinline__ int dst_row(int mode, int c) {
    if (mode == 1) { if (c < 256) return (c >> 7) * 256 + (c & 127); if (c < 512) return ((c - 256) >> 7) * 256 + 128 + (c & 127);
        if (c < C_KR) return c; if (c < C_KR + 32) return C_KR + ropeperm(c - C_KR); return C_DQ + (c - (C_KR + 32)); }
    if (mode == 2) { const int hh = c / 96, d = c - hh * 96; return hh * 128 + (d < 64 ? d : 64 + ropeperm(d - 64)); }
    if (mode == 3) return (c >> 7) * 256 + (c & 127);
    if (mode == 4) return (c >> 7) * 256 + 128 + (c & 127);
    return c;
}
struct TrDesc { const float* W; bf16* WT; const float* gain; int K, N, Kdst, mode, gmode, item; float gaux, rsc, qs; };
__device__ __forceinline__ void tr_load(const TrDesc& d, int lane, float (&v)[32]) {
    const int nblk = d.N / 32, kb = d.item / nblk, nb = d.item - kb * nblk, k0 = 64 * kb, n0 = 32 * nb;
    const float* p = d.W + (size_t)(k0 + (lane >> 5)) * d.N + n0 + (lane & 31);
#pragma unroll
    for (int i = 0; i < 32; ++i) v[i] = __builtin_nontemporal_load((const GAS float*)p + (size_t)(2 * i) * d.N);
}
__device__ __forceinline__ void tr_store(const TrDesc& d, int lane, const float (&v)[32], LAS float* scr) {
    const int nblk = d.N / 32, kb = d.item / nblk, nb = d.item - kb * nblk, k0 = 64 * kb, n0 = 32 * nb;
#pragma unroll
    for (int i = 0; i < 32; ++i) scr[(2 * i + (lane >> 5)) * 33 + (lane & 31)] = v[i];
    LDS_WAIT(); asm volatile("" ::: "memory");
    const int c = lane & 7; float g[8];
#pragma unroll
    for (int j = 0; j < 8; ++j) { const int k = k0 + 8 * c + j; g[j] = 1.0f;
        if (d.gmode == 1) g[j] = d.gain[k]; else if (d.gmode == 2) g[j] = (k >= 640) ? d.gain[(k - 640) & 63] * d.gaux : 1.0f; }
#pragma unroll
    for (int j = 0; j < 4; ++j) { const int n = (lane >> 3) + 8 * j; const LAS float* s = scr + (8 * c) * 33 + n; const int dr = dst_row(d.mode, n0 + n);
        float sc = 1.0f; if (d.mode == 2) sc = d.rsc; else if (d.mode == 1 && dr >= C_DQ && dr < C_DK) sc = d.rsc;
        if (d.qs > 0.f) { sc = d.qs; v2u o8; o8.x = pk4f8(s[0 * 33] * g[0] * sc, s[1 * 33] * g[1] * sc, s[2 * 33] * g[2] * sc, s[3 * 33] * g[3] * sc); o8.y = pk4f8(s[4 * 33] * g[4] * sc, s[5 * 33] * g[5] * sc, s[6 * 33] * g[6] * sc, s[7 * 33] * g[7] * sc);
            *(GAS v2u*)((unsigned char*)d.WT + (size_t)dr * d.Kdst + k0 + 8 * c) = o8; continue; }
        v4u o; o.x = pkbf(s[0 * 33] * g[0] * sc, s[1 * 33] * g[1] * sc); o.y = pkbf(s[2 * 33] * g[2] * sc, s[3 * 33] * g[3] * sc); o.z = pkbf(s[4 * 33] * g[4] * sc, s[5 * 33] * g[5] * sc); o.w = pkbf(s[6 * 33] * g[6] * sc, s[7 * 33] * g[7] * sc);
        *(GAS v4u*)(d.WT + (size_t)dr * d.Kdst + k0 + 8 * c) = o; }
    LDS_WAIT(); asm volatile("" ::: "memory");
}
__device__ __forceinline__ void zero_rect(bf16* WT, int ld, int r0, int nr, int c0, int nc, int gt, int ngt) {
    const int cpr = nc / 8, tot = nr * cpr;
    for (int i = gt; i < tot; i += ngt) { const int r = i / cpr, c = i - r * cpr; *(GAS v4u*)(WT + (size_t)(r0 + r) * ld + c0 + 8 * c) = (v4u){0u, 0u, 0u, 0u}; }
}
__device__ __forceinline__ void x_row_prep(const float* xrow, bf16* orow, int lane) {
    const GAS f32x4* xr = (const GAS f32x4*)xrow + lane; f32x4 v[4]; float s = 0.f;
#pragma unroll
    for (int j = 0; j < 4; ++j) { v[j] = __builtin_nontemporal_load(xr + 64 * j); s += (v[j].x * v[j].x + v[j].y * v[j].y) + (v[j].z * v[j].z + v[j].w * v[j].w); }
    s = wave_sum(s); const float rs = 1.0f / sqrtf(s * (1.0f / 1024.0f) + RMS_EPS);
    GAS unsigned long long* o8 = (GAS unsigned long long*)orow + lane;
#pragma unroll
    for (int j = 0; j < 4; ++j) o8[64 * j] = (unsigned long long)pkbf(v[j].x * rs, v[j].y * rs) | ((unsigned long long)pkbf(v[j].z * rs, v[j].w * rs) << 32);
}
__device__ __forceinline__ void p0_prologue(Frame& F, const Args& A) {
    { int t_ = F.wave * 64 + (int)__builtin_amdgcn_mbcnt_hi(~0u, __builtin_amdgcn_mbcnt_lo(~0u, 0u)); asm volatile("" : "+v"(t_)); F.tid = t_; F.lane = t_ & 63; unsigned long long w_ = (unsigned long long)F.ws; asm volatile("" : "+s"(w_)); F.ws = (unsigned char*)w_; }
    LAS float* scr = (LAS float*)(F.lds + RING_OFF + F.wave * 16384);
    const int gw = F.vcu * NWAVES + F.wave, NGW = F.G * NWAVES, gt = gw * 64 + F.lane, ngt = NGW * 64;
    constexpr int I_IN = 16 * 65, I_UQ = 4 * 18, I_UKV = 2 * 24, I_PW = 4 * 8, I_OUT = 16 * 32, I_G = 16 * 88, I_D = 44 * 32;
    constexpr int I_LAYER = I_IN + I_UQ + I_UKV + I_PW + I_OUT;
    constexpr int NITEMS = 2 * I_LAYER + 3 * I_G + 8 * 3 * I_G;
    static_assert(I_G == I_D, "item counts");
    const float qsc_mla = 0.10206207261596577f * LOG2E, qsc_diff = 0.17677669529663687f * LOG2E;
#define TR_DESC(d, it_) do { int r = (it_); \
        if (r < 2 * I_LAYER) { const int l = r / I_LAYER; r -= l * I_LAYER; \
            if (r < I_IN) { d = TrDesc{A.in[2] + (size_t)l * 1024 * 2080, WSP(bf16, WS_WIN) + (size_t)l * 2304 * 1024, A.in[1] + l * 1024, 1024, 2080, 1024, 1, 1, r, 0.f, qsc_diff, 0.f}; break; } r -= I_IN; \
            if (r < I_UQ) { d = TrDesc{A.in[11] + (size_t)l * 256 * 576, WSP(bf16, WS_WUQ) + (size_t)l * 768 * 256, A.in[10] + l * 256, 256, 576, 256, 2, 1, r, 0.f, qsc_mla, 0.f}; break; } r -= I_UQ; \
            if (r < I_UKV) { d = TrDesc{A.in[13] + (size_t)l * 128 * 768, WSP(bf16, WS_WUKV) + (size_t)l * 768 * 128, A.in[12] + l * 128, 128, 768, 128, 0, 1, r, 0.f, 1.f, 0.f}; break; } r -= I_UKV; \
            if (r < I_PW) { d = TrDesc{A.in[8] + (size_t)l * 256 * 256, WSP(bf16, WS_WPW) + (size_t)l * 256 * 256, nullptr, 256, 256, 256, 0, 0, r, 0.f, 1.f, 0.f}; break; } r -= I_PW; \
            d = TrDesc{A.in[19] + (size_t)l * 1024 * 1024, WSP(bf16, WS_WOUT) + (size_t)l * 1024 * 1024, A.in[18] + l * 64, 1024, 1024, 1024, 0, 2, r, 1.0f - (l == 0 ? LAM_INIT0 : LAM_INIT1), 1.f, 0.f}; break; } \
        r -= 2 * I_LAYER; \
        if (r < I_G) { d = TrDesc{A.in[21], WSP(bf16, WS_WGUD), A.in[20], 1024, 2816, 1024, 3, 1, r, 0.f, 1.f, 0.f}; break; } r -= I_G; \
        if (r < I_G) { d = TrDesc{A.in[22], WSP(bf16, WS_WGUD), A.in[20], 1024, 2816, 1024, 4, 1, r, 0.f, 1.f, 0.f}; break; } r -= I_G; \
        if (r < I_D) { d = TrDesc{A.in[23], WSP(bf16, WS_WDD), nullptr, 2816, 1024, 2816, 0, 0, r, 0.f, 1.f, QS_D}; break; } r -= I_D; \
        { const int e = r / (3 * I_G); r -= e * 3 * I_G; \
          if (r < I_G) { d = TrDesc{A.in[25] + (size_t)e * 1024 * 2816, WSP(bf16, WS_WGUE) + (size_t)e * 5632 * 512, A.in[20] + 1024, 1024, 2816, 1024, 3, 1, r, 0.f, 1.f, QS_GU}; break; } r -= I_G; \
          if (r < I_G) { d = TrDesc{A.in[26] + (size_t)e * 1024 * 2816, WSP(bf16, WS_WGUE) + (size_t)e * 5632 * 512, A.in[20] + 1024, 1024, 2816, 1024, 4, 1, r, 0.f, 1.f, QS_GU}; break; } r -= I_G; \
          d = TrDesc{A.in[27] + (size_t)e * 2816 * 1024, WSP(bf16, WS_WDE) + (size_t)e * 1024 * 1408, nullptr, 2816, 1024, 2816, 0, 0, r, 0.f, 1.f, QS_D}; } } while (0)
    if (gw < NITEMS) {
        TrDesc dc, dn; float vc[32], vn[32];
        TR_DESC(dc, gw); tr_load(dc, F.lane, vc);
        for (int it = gw; it < NITEMS; it += NGW) {
            const bool more = it + NGW < NITEMS;
            if (more) { TR_DESC(dn, it + NGW); tr_load(dn, F.lane, vn); }
            tr_store(dc, F.lane, vc, scr);
            if (more) { dc = dn;
#pragma unroll
                for (int i = 0; i < 32; ++i) vc[i] = vn[i]; }
        }
    }
#undef TR_DESC
    for (int l = 0; l < 2; ++l) {
        zero_rect(WSP(bf16, WS_WIN) + (size_t)l * 2304 * 1024, 1024, C_KR + 32, 96, 0, 1024, gt, ngt);
        zero_rect(WSP(bf16, WS_WIN) + (size_t)l * 2304 * 1024, 1024, 2176, 128, 0, 1024, gt, ngt);
        for (int hh = 0; hh < 6; ++hh) zero_rect(WSP(bf16, WS_WUQ) + (size_t)l * 768 * 256, 256, hh * 128 + 96, 32, 0, 256, gt, ngt);
    }
    for (int i = gt; i < 2048 * 16; i += ngt) { const int pos = i >> 4, fi = i & 15;
        const float freq = exp2f(-(float)fi * (13.287712379549449f / 16.0f)); const float ang = (float)pos * freq;
        const double rev = (double)ang * 0.15915494309189535; const float fr = (float)(rev - floor(rev));
        float* t = WSP(float, WS_ROPE) + (size_t)i * 2; t[0] = __builtin_amdgcn_cosf(fr); t[1] = __builtin_amdgcn_sinf(fr); }
    for (int i = gt; i < 2 * 512; i += ngt) WSP(float, WS_ROPE + BGLU_OFF)[i] = A.in[3][i];
    for (int i = gt; i < 8 * 1024; i += ngt) { const int e = i >> 10, k = i & 1023; WSP(float, WS_WR)[i] = A.in[20][1024 + k] * A.in[24][(size_t)k * 8 + e]; }
    if (gw == 0) {
        for (int l = 0; l < 2; ++l) { const int j = F.lane & 31;
            float a = A.in[14][l * 32 + j] * A.in[15][l * 32 + j], b = A.in[16][l * 32 + j] * A.in[17][l * 32 + j];
            if (F.lane >= 32) { a = 0.f; b = 0.f; }
            a = wave_sum(a); b = wave_sum(b);
            if (F.lane == 0) WSP(float, WS_LAM)[l] = expf(a) - expf(b) + (l == 0 ? LAM_INIT0 : LAM_INIT1); } }
    for (int m = gw * 2; m < M; m += NGW * 2) {
        x_row_prep(A.in[0] + (size_t)m * D, WSP(bf16, WS_XB) + (size_t)m * D, F.lane);
        x_row_prep(A.in[0] + (size_t)(m + 1) * D, WSP(bf16, WS_XB) + (size_t)(m + 1) * D, F.lane); }
}

__device__ __forceinline__ void conv_phase(Frame& F, const Args& A, int l) {
    { int t_ = F.wave * 64 + (int)__builtin_amdgcn_mbcnt_hi(~0u, __builtin_amdgcn_mbcnt_lo(~0u, 0u)); asm volatile("" : "+v"(t_)); F.tid = t_; F.lane = t_ & 63; unsigned long long w_ = (unsigned long long)F.ws; asm volatile("" : "+s"(w_)); F.ws = (unsigned char*)w_; }
    LAS float* U = (LAS float*)(F.lds + RING_OFF);
    const bf16* proj = WSP(bf16, WS_PROJ); bf16* cb = WSP(bf16, WS_CB);
    const float* b_glu = A.in[3] + l * 512; const float* w_dw = A.in[4] + l * 31 * 256; const float* b_dw = A.in[5] + l * 256;
    const float* lng = A.in[6] + l * 256; const float* lnb = A.in[7] + l * 256;
    const int c8 = F.tid & 31, r0 = F.tid >> 5, c = F.tid & 255, hf = F.tid >> 8;
    float w[31];
#pragma unroll
    for (int j = 0; j < 31; ++j) w[j] = w_dw[j * 256 + c];
    const float bd = b_dw[c];
    const f32x4 g4 = *(const f32x4*)(lng + 4 * F.lane), b4 = *(const f32x4*)(lnb + 4 * F.lane);
    v4u a8[6];
#define CONV_LOAD(unit_) do { const int b_ = (unit_) >> 5, t0_ = ((unit_) & 31) * 64; _Pragma("unroll") for (int k = 0; k < 6; ++k) { const int r = r0 + 16 * k, tok = t0_ - 30 + r; a8[k] = (v4u){0u, 0u, 0u, 0u}; \
        if (r < 94 && tok >= 0) { const bf16* rp = proj + (size_t)(b_ * SEQ + tok) * NPROJ + c8 * 8; a8[k] = __builtin_nontemporal_load((const GAS v4u*)rp); } } } while (0)
    if (F.vcu < NBATCH * 32) CONV_LOAD(F.vcu);
    for (int unit = F.vcu; unit < NBATCH * 32; unit += F.G) {
        const int b = unit >> 5, t0 = (unit & 31) * 64;
        {
#pragma unroll
          for (int k = 0; k < 6; ++k) { const int r = r0 + 16 * k, tok = t0 - 30 + r;
              if (r < 94) { f32x4 u0 = (f32x4){0.f, 0.f, 0.f, 0.f}, u1 = u0;
                  if (tok >= 0) { u0 = (f32x4){bf_lo(a8[k].x), bf_hi(a8[k].x), bf_lo(a8[k].y), bf_hi(a8[k].y)}; u1 = (f32x4){bf_lo(a8[k].z), bf_hi(a8[k].z), bf_lo(a8[k].w), bf_hi(a8[k].w)}; }
                  *(LAS f32x4*)(U + r * 256 + c8 * 8) = u0; *(LAS f32x4*)(U + r * 256 + c8 * 8 + 4) = u1; } } }
        __syncthreads();
        if (unit + F.G < NBATCH * 32) CONV_LOAD(unit + F.G);
        { float uw[62], o[32];
#pragma unroll
          for (int j = 0; j < 62; ++j) uw[j] = U[(hf * 32 + j) * 256 + c];
#pragma unroll
          for (int i = 0; i < 32; ++i) { float a = bd;
#pragma unroll
              for (int j = 0; j < 31; ++j) a = __builtin_fmaf(w[j], uw[i + j], a);
              o[i] = a; }
          __syncthreads();
#pragma unroll
          for (int i = 0; i < 32; ++i) U[(hf * 32 + i) * 256 + c] = o[i]; }
        __syncthreads();
        { f32x4 v[8]; float s[8];
#pragma unroll
          for (int k = 0; k < 8; ++k) { v[k] = *(LAS f32x4*)(U + (F.wave * 8 + k) * 256 + 4 * F.lane); s[k] = (v[k][0] + v[k][1]) + (v[k][2] + v[k][3]); }
#pragma unroll
          for (int o = 1; o < 64; o <<= 1)
#pragma unroll
              for (int k = 0; k < 8; ++k) s[k] += __shfl_xor(s[k], o);
#pragma unroll
          for (int k = 0; k < 8; ++k) { v[k] = v[k] - s[k] * (1.0f / 256.0f); s[k] = dot4_(v[k]); }
#pragma unroll
          for (int o = 1; o < 64; o <<= 1)
#pragma unroll
              for (int k = 0; k < 8; ++k) s[k] += __shfl_xor(s[k], o);
#pragma unroll
          for (int k = 0; k < 8; ++k) { const float rstd = __builtin_amdgcn_rsqf(s[k] * (1.0f / 256.0f) + LN_EPS); f32x4 y = v[k] * rstd * g4 + b4;
#pragma unroll
              for (int j = 0; j < 4; ++j) y[j] = y[j] * sigmoidf_(y[j]);
              v2u wv; wv.x = pkbf(y[0], y[1]); wv.y = pkbf(y[2], y[3]);
              *(GAS v2u*)(cb + (size_t)(b * SEQ + t0 + F.wave * 8 + k) * 256 + 4 * F.lane) = wv; } }
        __syncthreads();
    }
#undef CONV_LOAD
}

__device__ __forceinline__ void router_phase(Frame& F, const Args& A) {
    { int t_ = F.wave * 64 + (int)__builtin_amdgcn_mbcnt_hi(~0u, __builtin_amdgcn_mbcnt_lo(~0u, 0u)); asm volatile("" : "+v"(t_)); F.tid = t_; F.lane = t_ & 63; unsigned long long w_ = (unsigned long long)F.ws; asm volatile("" : "+s"(w_)); F.ws = (unsigned char*)w_; }
    LAS int* hist = (LAS int*)(F.lds + RING_OFF);
    LAS int* rec_g = hist + 32;
    LAS int* rec_r = rec_g + 512;
    LAS float* rec_w = (LAS float*)(rec_r + 512);
    const bf16* x = WSP(bf16, WS_XB); const float* wr = WSP(float, WS_WR); float* ssf1 = WSP(float, WS_SSF1);
    int* list = WSP(int, WS_LIST); float* wgt = WSP(float, WS_WGT); bf16* hb3 = WSP(bf16, WS_HB3);
    f32x4 wv[8][4];
#pragma unroll
    for (int e = 0; e < 8; ++e)
#pragma unroll
        for (int j = 0; j < 4; ++j) wv[e][j] = *(const f32x4*)(wr + e * 1024 + 256 * j + 4 * F.lane);
    for (int blk = F.vcu; blk < M / 256; blk += F.G) {
        if (F.tid < 8) hist[F.tid] = 0;
        __syncthreads();
        for (int i = 0; i < 32; i += 2) {
            f32x4 v[2][4];
#pragma unroll
            for (int rr = 0; rr < 2; ++rr) { const int m = blk * 256 + F.wave * 32 + i + rr;
#pragma unroll
                for (int j = 0; j < 4; ++j) { const v2u p = *((const GAS v2u*)(x + (size_t)m * D) + F.lane + 64 * j); v[rr][j] = (f32x4){bf_lo(p.x), bf_hi(p.x), bf_lo(p.y), bf_hi(p.y)}; } }
#pragma unroll
            for (int rr = 0; rr < 2; ++rr) { const int lr = F.wave * 32 + i + rr, m = blk * 256 + lr;
                float ss = 0.f, lg[8];
#pragma unroll
                for (int j = 0; j < 4; ++j) ss += dot4_(v[rr][j]);
                ss = wave_sum(ss);
#pragma unroll
                for (int e = 0; e < 8; ++e) { float a = 0.f;
#pragma unroll
                    for (int j = 0; j < 4; ++j) { const f32x4 p = v[rr][j] * wv[e][j]; a += (p[0] + p[1]) + (p[2] + p[3]); }
                    lg[e] = wave_sum(a); }
                const float rs = 1.0f / sqrtf(ss * (1.0f / 1024.0f) + RMS_EPS);
#pragma unroll
                for (int j = 0; j < 4; ++j) { const f32x4 hv = v[rr][j] * rs; *((GAS unsigned*)(hb3 + (size_t)m * (D / 2)) + F.lane + 64 * j) = pk4f8(hv[0], hv[1], hv[2], hv[3]); }
                int e1 = 0; float v1 = lg[0];
#pragma unroll
                for (int e = 1; e < 8; ++e) if (lg[e] > v1) { v1 = lg[e]; e1 = e; }
                int e2 = -1; float v2 = -INFINITY;
#pragma unroll
                for (int e = 0; e < 8; ++e) if (e != e1 && (e2 < 0 || lg[e] > v2)) { v2 = lg[e]; e2 = e; }
                const float ex = __expf((v2 - v1) * rs), w1 = 1.0f / (1.0f + ex), w2 = ex * w1;
                if (F.lane == 0) { ssf1[m] = ss;
                    rec_g[lr * 2] = e1; rec_g[lr * 2 + 1] = e2; rec_w[lr * 2] = w1; rec_w[lr * 2 + 1] = w2;
                    rec_r[lr * 2] = __hip_atomic_fetch_add(hist + e1, 1, __ATOMIC_RELAXED, __HIP_MEMORY_SCOPE_WORKGROUP);
                    rec_r[lr * 2 + 1] = __hip_atomic_fetch_add(hist + e2, 1, __ATOMIC_RELAXED, __HIP_MEMORY_SCOPE_WORKGROUP); } }
        }
        __syncthreads();
        if (F.tid < 8) hist[16 + F.tid] = (int)__hip_atomic_fetch_add((unsigned*)(F.ctl + CW_CNT + 64 * F.tid), (unsigned)hist[F.tid], RLX_AGENT);
        __syncthreads();
        if (F.tid < 256) {
#pragma unroll
            for (int s = 0; s < 2; ++s) { const int g = rec_g[F.tid * 2 + s], pos = hist[16 + g] + rec_r[F.tid * 2 + s];
                list[(size_t)g * M + pos] = (blk * 256 + F.tid) | (s << 16); wgt[(size_t)g * M + pos] = rec_w[F.tid * 2 + s]; } }
        __syncthreads();
    }
}
__device__ __forceinline__ void moe_prefix(Frame& F) {
    if (F.tid == 0) { int p = 0;
        for (int g = 0; g < 8; ++g) { F.MISC[16 + g] = (unsigned)p; const unsigned c = __hip_atomic_load(F.ctl + CW_CNT + 64 * g, RLX_AGENT); F.MISC[36 + g] = c; p += (int)((c + 255u) >> 8); }
        F.MISC[24] = (unsigned)p; F.MISC[32] = (unsigned)p; }
    __syncthreads();
}
__device__ __forceinline__ void final_phase(Frame& F, const Args& A) {
    { int t_ = F.wave * 64 + (int)__builtin_amdgcn_mbcnt_hi(~0u, __builtin_amdgcn_mbcnt_lo(~0u, 0u)); asm volatile("" : "+v"(t_)); F.tid = t_; F.lane = t_ & 63; unsigned long long w_ = (unsigned long long)F.ws; asm volatile("" : "+s"(w_)); F.ws = (unsigned char*)w_; }
    const int gw = F.vcu * NWAVES + F.wave, NGW = F.G * NWAVES; const float* g = A.in[28];
    f32x4 gv[4];
#pragma unroll
    for (int j = 0; j < 4; ++j) gv[j] = *(const f32x4*)(g + 256 * j + 4 * F.lane);
    const bf16* xb = WSP(bf16, WS_XB); const bf16* y1 = WSP(bf16, WS_Y1);
    for (int m0 = gw * 4; m0 < M; m0 += NGW * 4) {
        f32x4 v[4][4];
#pragma unroll
        for (int rr = 0; rr < 4; ++rr)
#pragma unroll
            for (int j = 0; j < 4; ++j) { const v2u p = __builtin_nontemporal_load((const GAS v2u*)(xb + (size_t)(m0 + rr) * D) + F.lane + 64 * j), q = __builtin_nontemporal_load((const GAS v2u*)(y1 + (size_t)(m0 + rr) * D) + F.lane + 64 * j);
                v[rr][j] = (f32x4){bf_lo(p.x), bf_hi(p.x), bf_lo(p.y), bf_hi(p.y)} + (f32x4){bf_lo(q.x), bf_hi(q.x), bf_lo(q.y), bf_hi(q.y)}; }
#pragma unroll
        for (int rr = 0; rr < 4; ++rr) { float ss = 0.f;
#pragma unroll
            for (int j = 0; j < 4; ++j) ss += dot4_(v[rr][j]);
            ss = wave_sum(ss); const float rs = 1.0f / sqrtf(ss * (1.0f / 1024.0f) + RMS_EPS);
#pragma unroll
            for (int j = 0; j < 4; ++j) __builtin_nontemporal_store(v[rr][j] * rs * gv[j], (GAS f32x4*)(F.out + (size_t)(m0 + rr) * D) + F.lane + 64 * j); }
    }
}

__device__ __forceinline__ void attn_coords(int i, bool contig, int per, int vcu, int G, int& b, int& h, int& qb) {
    const int p = contig ? vcu * per + (i >> 1) : vcu + (i >> 1) * G; const int bh = p >> 2, s = p & 3; b = bh / 6; h = bh - b * 6; qb = (i & 1) ? s : 7 - s;
}
template <int MODE, int PROBE = 0>
__device__ __forceinline__ void attn_phase(Frame& F, int l) {
    static_assert(att::ATT_LDS_BYTES <= RING_BYTES, "attention LDS");
    { unsigned long long w_ = (unsigned long long)F.ws; asm volatile("" : "+s"(w_)); F.ws = (unsigned char*)w_; }
    const att::bf16* proj = (const att::bf16*)WSP(bf16, WS_PROJ); const att::bf16* qb_ = (const att::bf16*)WSP(bf16, WS_Q); const att::bf16* kv = (const att::bf16*)WSP(bf16, WS_KV);
    const att::bf16* kr = (const att::bf16*)WSP(bf16, WS_KR); att::bf16* cat = (att::bf16*)WSP(bf16, WS_CAT);
    const float lam = WSP(float, WS_LAM)[l];
    int tid = F.wave * 64 + (int)__builtin_amdgcn_mbcnt_hi(~0u, __builtin_amdgcn_mbcnt_lo(~0u, 0u)); asm volatile("" : "+v"(tid));
    constexpr int NPAIR = NBATCH * 6 * 4;
    const bool contig = (NPAIR % F.G) == 0; const int per = NPAIR / F.G;
    const int npairs = contig ? per : (F.vcu < NPAIR ? (NPAIR - 1 - F.vcu) / F.G + 1 : 0), nun = 2 * npairs;
    if (F.wave >= 4) __builtin_amdgcn_s_setprio(1);
    att::UnitId U{0, 0, 0, 0}, UN{0, 0, 0, 0};
    if (MODE == 0) {
        if (nun > 0) attn_coords(0, contig, per, F.vcu, F.G, UN.b, UN.h, UN.qb);
        att::bf16x8 qr[6]; const att::MlaT T{qb_, kv, kr, cat};
        for (int i = 0; i < nun; ++i) { U = UN; if (i + 1 < nun) attn_coords(i + 1, contig, per, F.vcu, F.G, UN.b, UN.h, UN.qb);
            att::mla_unit<8, PROBE>(T, U, i == 0, i + 1 < nun, UN, qr, (att::lds_ptr)(F.lds + RING_OFF), tid); }
    } else {
        static constexpr unsigned char TAB[8][6] = {{47, 44, 15, 18, 2, 0}, {39, 36, 14, 10, 41, 9}, {31, 28, 13, 7, 33, 1}, {23, 20, 12, 6, 25, 40},
                                                    {46, 45, 43, 11, 17, 32}, {38, 37, 35, 42, 5, 24}, {30, 29, 27, 34, 4, 16}, {22, 21, 19, 26, 3, 8}};
        const bool tab = (F.G == 256); const int n2 = tab ? 6 : nun;
#define DIFF_ID(D, i) do { if (tab) { const int e_ = TAB[F.vcu & 7][i]; (D).b = F.vcu >> 3; (D).h = e_ >> 3; (D).qb = e_ & 7; } else attn_coords(i, contig, per, F.vcu, F.G, (D).b, (D).h, (D).qb); \
        { const float s2_ = exp2f(-8.0f * (float)((D).h + 1) / 6.0f) * LOG2E; const int z_ = (int)floorf(((float)((D).qb * 256 - 63) - 200.0f / s2_) * (1.0f / 64.0f)) + 1; (D).t0 = z_ > 0 ? (z_ & ~3) : 0; } } while (0)
        if (n2 > 0) DIFF_ID(UN, 0);
        att::bf16x8 qr[4]; const att::DiffT T{proj, cat};
        for (int i = 0; i < n2; ++i) { U = UN; if (i + 1 < n2) DIFF_ID(UN, i + 1);
            att::diff_unit<8>(T, U, i == 0, i + 1 < n2, UN, qr, lam, (att::lds_ptr)(F.lds + RING_OFF), tid); }
#undef DIFF_ID
    }
    __builtin_amdgcn_s_setprio(0);
    asm volatile("s_waitcnt vmcnt(0) lgkmcnt(0)" ::: "memory"); __syncthreads();
}

__global__ void __launch_bounds__(NWAVES * 64, 2) fwd_kernel(Args args) {
    extern __shared__ __attribute__((aligned(16))) unsigned char lds[];
    Frame F;
    F.lds = (LAS unsigned char*)lds;
    F.MISC = (volatile LAS unsigned*)(F.lds + MISC_OFF);
    F.tid = threadIdx.x; F.lane = F.tid & 63; F.wave = __builtin_amdgcn_readfirstlane(F.tid >> 6);
    F.G = gridDim.x; { const int bx = blockIdx.x; F.vcu = (F.G % 8 == 0) ? (bx % 8) * (F.G / 8) + bx / 8 : bx; }
    F.ws = args.ws; F.ctl = (gu32*)(args.ws + WS_CTL); F.out = args.out;
    for (int u = F.tid; u < (LDS_BYTES - LDSCTL_OFF) / 4; u += NWAVES * 64) ((LAS unsigned*)(F.lds + LDSCTL_OFF))[u] = 0u;
    __syncthreads();
    const int lo = args.ph_lo, hi = args.ph_hi;
    XcdBarrier bar = xcd_barrier_post((unsigned*)(F.ctl + CW_BAR), F.MISC + 8);
#ifndef SITE_MASK
#define SITE_MASK 0xffffffffu
#endif
#define EN(n) (((SITE_MASK) >> (n)) & 1u)
#ifndef DUP_MASK
#define DUP_MASK 0u
#endif
#define DUP(n) (((DUP_MASK) >> (n)) & 1u)
#define IN(k) (lo <= (k) && (k) < hi)
#define WS_OPQ() do { unsigned long long w_ = (unsigned long long)F.ws; asm volatile("" : "+s"(w_)); F.ws = (unsigned char*)w_; } while (0)
#ifndef DUP_BAR
#define DUP_BAR 0
#endif
#define SEAM(k) do { if (IN(k) && IN((k) + 1)) { xcd_barrier(bar); if (DUP_BAR) xcd_barrier(bar); } } while (0)
    const int bx = (int)blockIdx.x;

    if (IN(0) && EN(0)) p0_prologue(F, args);
    if (IN(0) && DUP(0)) p0_prologue(F, args);
    SEAM(0);

#define rope WSP(float, WS_ROPE)
#define ss_x (WSP(float, WS_SSX) + (size_t)l * M * 16)
#define ss_cq (WSP(float, WS_SSCQ) + (size_t)l * M * 4)
#define ss_ckv (WSP(float, WS_SSCKV) + (size_t)l * M * 4)
    { constexpr int l = 0;
        const int pb = l == 0 ? 1 : 7;
        for (int rep_ = 0; rep_ < 1 + (int)DUP(1); ++rep_) if (IN(pb) && EN(1)) {
            WS_OPQ(); pg8::Gemm g{WSP(bf16, WS_XB), WSP(bf16, WS_WIN) + (size_t)l * NPROJ * 1024, 1024, 1024}; pg8::StaticOrder S; S.init(M, NPROJ, F.G, bx);
            pg8::EpiProj E{WSP(bf16, WS_PROJ), l == 0 ? nullptr : ss_x, ss_cq, ss_ckv, WSP(bf16, WS_KR), rope, (const LAS float*)(F.lds + RING_OFF + RSBUF_OFF)};
            pg8::gemm_phase<pg8::EpiProj, pg8::StaticOrder, true, true>(F.lds + RING_OFF, g, S, E, F.wave);
        }
        SEAM(pb);
        if (IN(pb + 1)) {
            if (EN(2)) conv_phase(F, args, l);
            if (DUP(2)) conv_phase(F, args, l);
            for (int rep_ = 0; rep_ < 1 + (int)DUP(3); ++rep_) if (EN(3)) { WS_OPQ(); pg8::Gemm g{WSP(bf16, WS_PROJ) + C_CQ, WSP(bf16, WS_WUQ) + (size_t)l * 768 * 256, NPROJ, 256}; pg8::StaticOrder S; S.init(M, 768, F.G, bx);
              pg8::EpiQ E{WSP(bf16, WS_Q), ss_cq, rope, (const LAS float*)(F.lds + RING_OFF + RSBUF_OFF)};
              pg8::gemm_phase<pg8::EpiQ, pg8::StaticOrder, true, true>(F.lds + RING_OFF, g, S, E, F.wave); }
            for (int rep_ = 0; rep_ < 1 + (int)DUP(4); ++rep_) if (EN(4)) { WS_OPQ(); pg8::Gemm g{WSP(bf16, WS_PROJ) + C_CKV, WSP(bf16, WS_WUKV) + (size_t)l * 768 * 128, NPROJ, 128}; pg8::StaticOrder S; S.init(M, 768, F.G, bx);
              pg8::EpiStore E{WSP(bf16, WS_KV), KVW, nullptr, ss_ckv, 4, 1.0f / 128.0f, RMS_EPS, (const LAS float*)(F.lds + RING_OFF + RSBUF_OFF)};
              pg8::gemm_phase<pg8::EpiStore, pg8::StaticOrder, true, true>(F.lds + RING_OFF, g, S, E, F.wave); }
        }
        SEAM(pb + 1);
        if (IN(pb + 2)) {
            if (DUP(21)) attn_phase<0, 1>(F, l);
            if (DUP(22)) attn_phase<0, 4>(F, l);
            if (DUP(23)) attn_phase<0, 5>(F, l);
            if (DUP(24)) attn_phase<0, 6>(F, l);
            if (DUP(25)) attn_phase<0, 7>(F, l);
            if (DUP(5)) attn_phase<0>(F, l);
            if (EN(5)) attn_phase<0>(F, l);
            if (EN(6)) attn_phase<1>(F, l);
            if (DUP(6)) attn_phase<1>(F, l);
            for (int rep_ = 0; rep_ < 1 + (int)DUP(7); ++rep_) if (EN(7)) { WS_OPQ(); pg8::Gemm g{WSP(bf16, WS_CB), WSP(bf16, WS_WPW) + (size_t)l * 256 * 256, 256, 256}; pg8::StaticOrder S; S.init(M, 256, F.G, bx);
              pg8::EpiStore E{WSP(bf16, WS_CAT), D, args.in[9] + l * 256, nullptr, 1, 0.f, 0.f};
              pg8::gemm_phase<pg8::EpiStore, pg8::StaticOrder, true, true>(F.lds + RING_OFF, g, S, E, F.wave); }
        }
        SEAM(pb + 2);
        if (IN(pb + 3) && EN(8)) {
            WS_OPQ(); pg8::Gemm g{WSP(bf16, WS_CAT), WSP(bf16, WS_WOUT) + (size_t)l * 1024 * 1024, 1024, 1024}; pg8::StaticOrder S; S.init(M, D, F.G, bx);
            pg8::EpiResid E{l == 0 ? args.in[0] : nullptr, WSP(bf16, WS_XB), l == 0 ? WSP(float, WS_SSF) : nullptr};
            pg8::gemm_phase<pg8::EpiResid, pg8::StaticOrder, true, true>(F.lds + RING_OFF, g, S, E, F.wave);
            if (DUP(8)) { pg8::EpiResid E2{nullptr, WSP(bf16, WS_PROJ), nullptr};
                pg8::gemm_phase<pg8::EpiResid, pg8::StaticOrder, true, true>(F.lds + RING_OFF, g, S, E2, F.wave); }
        }
        SEAM(pb + 3);
        if (l == 0) {
            if (IN(5) && DUP(16)) { WS_OPQ(); pg8::Gemm g{WSP(bf16, WS_XB), WSP(bf16, WS_WGUD), 1024, 1024}; pg8::StaticOrder S; S.init(M, NGU, F.G, bx);
                pg8::EpiNull E; pg8::gemm_phase<pg8::EpiNull, pg8::StaticOrder, true, true>(F.lds + RING_OFF, g, S, E, F.wave); }
            if (IN(5) && DUP(20)) { WS_OPQ(); pg8::Gemm g{WSP(bf16, WS_XB), WSP(bf16, WS_WGUD), 1024, 1024}; pg8::FixedOrder S; S.init(M, NGU, F.G, bx);
                pg8::EpiNull E; pg8::gemm_phase<pg8::EpiNull, pg8::FixedOrder, true, true>(F.lds + RING_OFF, g, S, E, F.wave); }
            if (IN(5) && DUP(17)) { WS_OPQ(); pg8::Gemm g{WSP(bf16, WS_XB), WSP(bf16, WS_WGUD), 1024, 1024}; pg8::StaticOrder S; S.init(M, NGU, F.G, bx);
                pg8::EpiSwiGLU_<1> E{WSP(bf16, WS_ACT), WSP(float, WS_SSF), 16, 22}; pg8::gemm_phase<pg8::EpiSwiGLU_<1>, pg8::StaticOrder, true, true>(F.lds + RING_OFF, g, S, E, F.wave); }
            if (IN(5) && DUP(18)) { WS_OPQ(); pg8::Gemm g{WSP(bf16, WS_XB), WSP(bf16, WS_WGUD), 1024, 1024}; pg8::StaticOrder S; S.init(M, NGU, F.G, bx);
                pg8::EpiSwiGLU_<2> E{WSP(bf16, WS_ACT), WSP(float, WS_SSF), 16, 22}; pg8::gemm_phase<pg8::EpiSwiGLU_<2>, pg8::StaticOrder, true, true>(F.lds + RING_OFF, g, S, E, F.wave); }
            if (IN(5) && EN(9) && !DUP(19)) {
                WS_OPQ(); pg8::Gemm g{WSP(bf16, WS_XB), WSP(bf16, WS_WGUD), 1024, 1024}; pg8::StaticOrder S; S.init(M, NGU, F.G, bx);
                pg8::EpiSwiGLUd8 E{WSP(bf16, WS_ACT), WSP(float, WS_SSF), 16, 22, (const LAS float*)(F.lds + RING_OFF + RSBUF_OFF)};
                pg8::gemm_phase<pg8::EpiSwiGLUd8, pg8::StaticOrder, true, true>(F.lds + RING_OFF, g, S, E, F.wave);
            }
            if (IN(5) && EN(9) && DUP(19)) {
                WS_OPQ(); pg8::Gemm g{WSP(bf16, WS_XB), WSP(bf16, WS_WGUD), 1024, 1024}; pg8::RangeOrder S; S.init(M, NGU, F.G, bx); S.i0 = 0; S.i1 = 11;
                pg8::EpiSwiGLU E{WSP(bf16, WS_ACT), WSP(float, WS_SSF), 16, 22};
                pg8::gemm_phase<pg8::EpiSwiGLU, pg8::RangeOrder, true, true>(F.lds + RING_OFF, g, S, E, F.wave);
                xcd_barrier(bar);
                S.i0 = 11; S.i1 = 22;
                pg8::gemm_phase<pg8::EpiSwiGLU, pg8::RangeOrder, true, true>(F.lds + RING_OFF, g, S, E, F.wave);
            }
            SEAM(5);
            if (IN(6) && EN(10)) {
                WS_OPQ(); pg8::Gemm g{WSP(bf16, WS_ACT), WSP(bf16, WS_WDD), FF / 2, FF / 2}; pg8::StaticOrder S; S.init(M, D, F.G, bx);
                pg8::EpiResid E{nullptr, WSP(bf16, WS_XB), WSP(float, WS_SSX) + (size_t)M * 16, 1.0f / (QS_ACT * QS_D)};
                pg8::gemm_phase<pg8::EpiResid, pg8::StaticOrder, true, true, false, true>(F.lds + RING_OFF, g, S, E, F.wave);
                if (DUP(10)) { pg8::EpiResid E2{nullptr, WSP(bf16, WS_KV), nullptr};
                    pg8::gemm_phase<pg8::EpiResid, pg8::StaticOrder, true, true>(F.lds + RING_OFF, g, S, E2, F.wave); }
            }
            SEAM(6);
        }
    }
    { constexpr int l = 1;
        const int pb = l == 0 ? 1 : 7;
        for (int rep_ = 0; rep_ < 1 + (int)DUP(1); ++rep_) if (IN(pb) && EN(1)) {
            WS_OPQ(); pg8::Gemm g{WSP(bf16, WS_XB), WSP(bf16, WS_WIN) + (size_t)l * NPROJ * 1024, 1024, 1024}; pg8::StaticOrder S; S.init(M, NPROJ, F.G, bx);
            pg8::EpiProj E{WSP(bf16, WS_PROJ), l == 0 ? nullptr : ss_x, ss_cq, ss_ckv, WSP(bf16, WS_KR), rope, (const LAS float*)(F.lds + RING_OFF + RSBUF_OFF)};
            pg8::gemm_phase<pg8::EpiProj, pg8::StaticOrder, true, true>(F.lds + RING_OFF, g, S, E, F.wave);
        }
        SEAM(pb);
        if (IN(pb + 1)) {
            if (EN(2)) conv_phase(F, args, l);
            if (DUP(2)) conv_phase(F, args, l);
            for (int rep_ = 0; rep_ < 1 + (int)DUP(3); ++rep_) if (EN(3)) { WS_OPQ(); pg8::Gemm g{WSP(bf16, WS_PROJ) + C_CQ, WSP(bf16, WS_WUQ) + (size_t)l * 768 * 256, NPROJ, 256}; pg8::StaticOrder S; S.init(M, 768, F.G, bx);
              pg8::EpiQ E{WSP(bf16, WS_Q), ss_cq, rope, (const LAS float*)(F.lds + RING_OFF + RSBUF_OFF)};
              pg8::gemm_phase<pg8::EpiQ, pg8::StaticOrder, true, true>(F.lds + RING_OFF, g, S, E, F.wave); }
            for (int rep_ = 0; rep_ < 1 + (int)DUP(4); ++rep_) if (EN(4)) { WS_OPQ(); pg8::Gemm g{WSP(bf16, WS_PROJ) + C_CKV, WSP(bf16, WS_WUKV) + (size_t)l * 768 * 128, NPROJ, 128}; pg8::StaticOrder S; S.init(M, 768, F.G, bx);
              pg8::EpiStore E{WSP(bf16, WS_KV), KVW, nullptr, ss_ckv, 4, 1.0f / 128.0f, RMS_EPS, (const LAS float*)(F.lds + RING_OFF + RSBUF_OFF)};
              pg8::gemm_phase<pg8::EpiStore, pg8::StaticOrder, true, true>(F.lds + RING_OFF, g, S, E, F.wave); }
        }
        SEAM(pb + 1);
        if (IN(pb + 2)) {
            if (DUP(21)) attn_phase<0, 1>(F, l);
            if (DUP(22)) attn_phase<0, 4>(F, l);
            if (DUP(23)) attn_phase<0, 5>(F, l);
            if (DUP(24)) attn_phase<0, 6>(F, l);
            if (DUP(25)) attn_phase<0, 7>(F, l);
            if (DUP(5)) attn_phase<0>(F, l);
            if (EN(5)) attn_phase<0>(F, l);
            if (EN(6)) attn_phase<1>(F, l);
            if (DUP(6)) attn_phase<1>(F, l);
            for (int rep_ = 0; rep_ < 1 + (int)DUP(7); ++rep_) if (EN(7)) { WS_OPQ(); pg8::Gemm g{WSP(bf16, WS_CB), WSP(bf16, WS_WPW) + (size_t)l * 256 * 256, 256, 256}; pg8::StaticOrder S; S.init(M, 256, F.G, bx);
              pg8::EpiStore E{WSP(bf16, WS_CAT), D, args.in[9] + l * 256, nullptr, 1, 0.f, 0.f};
              pg8::gemm_phase<pg8::EpiStore, pg8::StaticOrder, true, true>(F.lds + RING_OFF, g, S, E, F.wave); }
        }
        SEAM(pb + 2);
        if (IN(pb + 3) && EN(8)) {
            WS_OPQ(); pg8::Gemm g{WSP(bf16, WS_CAT), WSP(bf16, WS_WOUT) + (size_t)l * 1024 * 1024, 1024, 1024}; pg8::StaticOrder S; S.init(M, D, F.G, bx);
            pg8::EpiResid E{l == 0 ? args.in[0] : nullptr, WSP(bf16, WS_XB), l == 0 ? WSP(float, WS_SSF) : nullptr};
            pg8::gemm_phase<pg8::EpiResid, pg8::StaticOrder, true, true>(F.lds + RING_OFF, g, S, E, F.wave);
            if (DUP(8)) { pg8::EpiResid E2{nullptr, WSP(bf16, WS_PROJ), nullptr};
                pg8::gemm_phase<pg8::EpiResid, pg8::StaticOrder, true, true>(F.lds + RING_OFF, g, S, E2, F.wave); }
        }
        SEAM(pb + 3);
        if (l == 0) {
            if (IN(5) && DUP(16)) { WS_OPQ(); pg8::Gemm g{WSP(bf16, WS_XB), WSP(bf16, WS_WGUD), 1024, 1024}; pg8::StaticOrder S; S.init(M, NGU, F.G, bx);
                pg8::EpiNull E; pg8::gemm_phase<pg8::EpiNull, pg8::StaticOrder, true, true>(F.lds + RING_OFF, g, S, E, F.wave); }
            if (IN(5) && DUP(20)) { WS_OPQ(); pg8::Gemm g{WSP(bf16, WS_XB), WSP(bf16, WS_WGUD), 1024, 1024}; pg8::FixedOrder S; S.init(M, NGU, F.G, bx);
                pg8::EpiNull E; pg8::gemm_phase<pg8::EpiNull, pg8::FixedOrder, true, true>(F.lds + RING_OFF, g, S, E, F.wave); }
            if (IN(5) && DUP(17)) { WS_OPQ(); pg8::Gemm g{WSP(bf16, WS_XB), WSP(bf16, WS_WGUD), 1024, 1024}; pg8::StaticOrder S; S.init(M, NGU, F.G, bx);
                pg8::EpiSwiGLU_<1> E{WSP(bf16, WS_ACT), WSP(float, WS_SSF), 16, 22}; pg8::gemm_phase<pg8::EpiSwiGLU_<1>, pg8::StaticOrder, true, true>(F.lds + RING_OFF, g, S, E, F.wave); }
            if (IN(5) && DUP(18)) { WS_OPQ(); pg8::Gemm g{WSP(bf16, WS_XB), WSP(bf16, WS_WGUD), 1024, 1024}; pg8::StaticOrder S; S.init(M, NGU, F.G, bx);
                pg8::EpiSwiGLU_<2> E{WSP(bf16, WS_ACT), WSP(float, WS_SSF), 16, 22}; pg8::gemm_phase<pg8::EpiSwiGLU_<2>, pg8::StaticOrder, true, true>(F.lds + RING_OFF, g, S, E, F.wave); }
            if (IN(5) && EN(9) && !DUP(19)) {
                WS_OPQ(); pg8::Gemm g{WSP(bf16, WS_XB), WSP(bf16, WS_WGUD), 1024, 1024}; pg8::StaticOrder S; S.init(M, NGU, F.G, bx);
                pg8::EpiSwiGLUd8 E{WSP(bf16, WS_ACT), WSP(float, WS_SSF), 16, 22, (const LAS float*)(F.lds + RING_OFF + RSBUF_OFF)};
                pg8::gemm_phase<pg8::EpiSwiGLUd8, pg8::StaticOrder, true, true>(F.lds + RING_OFF, g, S, E, F.wave);
            }
            if (IN(5) && EN(9) && DUP(19)) {
                WS_OPQ(); pg8::Gemm g{WSP(bf16, WS_XB), WSP(bf16, WS_WGUD), 1024, 1024}; pg8::RangeOrder S; S.init(M, NGU, F.G, bx); S.i0 = 0; S.i1 = 11;
                pg8::EpiSwiGLU E{WSP(bf16, WS_ACT), WSP(float, WS_SSF), 16, 22};
                pg8::gemm_phase<pg8::EpiSwiGLU, pg8::RangeOrder, true, true>(F.lds + RING_OFF, g, S, E, F.wave);
                xcd_barrier(bar);
                S.i0 = 11; S.i1 = 22;
                pg8::gemm_phase<pg8::EpiSwiGLU, pg8::RangeOrder, true, true>(F.lds + RING_OFF, g, S, E, F.wave);
            }
            SEAM(5);
            if (IN(6) && EN(10)) {
                WS_OPQ(); pg8::Gemm g{WSP(bf16, WS_ACT), WSP(bf16, WS_WDD), FF / 2, FF / 2}; pg8::StaticOrder S; S.init(M, D, F.G, bx);
                pg8::EpiResid E{nullptr, WSP(bf16, WS_XB), WSP(float, WS_SSX) + (size_t)M * 16, 1.0f / (QS_ACT * QS_D)};
                pg8::gemm_phase<pg8::EpiResid, pg8::StaticOrder, true, true, false, true>(F.lds + RING_OFF, g, S, E, F.wave);
                if (DUP(10)) { pg8::EpiResid E2{nullptr, WSP(bf16, WS_KV), nullptr};
                    pg8::gemm_phase<pg8::EpiResid, pg8::StaticOrder, true, true>(F.lds + RING_OFF, g, S, E2, F.wave); }
            }
            SEAM(6);
        }
    }
    if (IN(11) && EN(11)) router_phase(F, args);
    SEAM(11);
    for (int k = 0; k < 6; ++k) {
        const int ph = 12 + k;
        if (IN(ph)) {
            moe_prefix(F);
            const int TT = (int)F.MISC[32];
            if (k >= 1 && EN(14)) { const int c = k - 1, ta = c * 128 < TT ? c * 128 : TT, tb = (c + 1) * 128 < TT ? (c + 1) * 128 : TT;
                WS_OPQ(); pg8::Gemm g{WSP(bf16, (c & 1) ? WS_ACT1 : WS_ACT0), WSP(bf16, WS_WDE), FF / 2, FF / 2};
                pg8::MoeOrder S{tb - ta, 4, ta, F.G, bx, (const PG8_LAS int*)(F.lds + MISC_OFF + 64), WSP(int, WS_LIST)};
                pg8::EpiScatter E{WSP(bf16, WS_XB), WSP(bf16, WS_Y1), WSP(int, WS_LIST), WSP(float, WS_WGT), 1.0f / (QS_ACT * QS_D)};
                pg8::gemm_phase<pg8::EpiScatter, pg8::MoeOrder, true, true, false, true>(F.lds + RING_OFF, g, S, E, F.wave); }
            if (k <= 4 && EN(13)) { const int c = k, ta = c * 128 < TT ? c * 128 : TT, tb = (c + 1) * 128 < TT ? (c + 1) * 128 : TT;
                WS_OPQ(); pg8::Gemm g{WSP(bf16, WS_HB3), WSP(bf16, WS_WGUE), 512, 512};
                pg8::MoeOrder S{tb - ta, 22, ta, F.G, bx, (const PG8_LAS int*)(F.lds + MISC_OFF + 64), WSP(int, WS_LIST)};
                pg8::EpiSwiGLU8 E{WSP(bf16, (c & 1) ? WS_ACT1 : WS_ACT0), nullptr, 1, 22};
                pg8::gemm_phase<pg8::EpiSwiGLU8, pg8::MoeOrder, true, true, true, true>(F.lds + RING_OFF, g, S, E, F.wave);
                if (DUP(13)) pg8::gemm_phase<pg8::EpiSwiGLU8, pg8::MoeOrder, true, true, true, true>(F.lds + RING_OFF, g, S, E, F.wave);
                if (DUP(19)) { pg8::EpiNull E0; pg8::gemm_phase<pg8::EpiNull, pg8::MoeOrder, true, true, true, true>(F.lds + RING_OFF, g, S, E0, F.wave); } }
        }
        SEAM(ph);
    }
    if (IN(18) && EN(15)) final_phase(F, args);
#undef rope
#undef ss_x
#undef ss_cq
#undef ss_ckv
#undef IN
#undef SEAM
}

#ifndef MK_N_LAUNCHES
#define MK_N_LAUNCHES 1
#endif
extern "C" void kernel_launch(void* const* d_in, const int* in_sizes, int n_in, void* d_out, int out_size, void* d_ws, size_t ws_size, hipStream_t stream) {
    static int grid = 0;
    if (grid == 0) {
        if (n_in != 29 || in_sizes[0] != M * D || out_size != M * D || ws_size < WS_END) { fprintf(stderr, "kernel_launch: unexpected sizes: n_in %d in0 %d out %d ws %zu (need %zu)\n", n_in, n_in > 0 ? in_sizes[0] : -1, out_size, ws_size, (size_t)WS_END); grid = -1; return; }
        int dev = 0, cus = 0, per_cu = 0;
        if (hipGetDevice(&dev) != hipSuccess || hipDeviceGetAttribute(&cus, hipDeviceAttributeMultiprocessorCount, dev) != hipSuccess) { grid = -1; return; }
        if (hipFuncSetAttribute((const void*)fwd_kernel, hipFuncAttributeMaxDynamicSharedMemorySize, LDS_BYTES) != hipSuccess) { fprintf(stderr, "kernel_launch: hipFuncSetAttribute failed\n"); grid = -1; return; }
        if (hipOccupancyMaxActiveBlocksPerMultiprocessor(&per_cu, (const void*)fwd_kernel, NWAVES * 64, LDS_BYTES) != hipSuccess || per_cu < 1)
            fprintf(stderr, "kernel_launch: note: occupancy query reports %d workgroups per CU\n", per_cu);
        (void)hipGetLastError();
        grid = cus;
    }
    if (grid < 0) return;
    if (hipMemsetAsync((char*)d_ws + WS_CTL, 0, CTL_ZERO_BYTES, stream) != hipSuccess) return;
    Args a{};
    for (int i = 0; i < 29; ++i) a.in[i] = (const float*)d_in[i];
    a.out = (float*)d_out; a.ws = (unsigned char*)d_ws;
#if MK_N_LAUNCHES == 1
    a.ph_lo = 0; a.ph_hi = NPHASE;
    hipLaunchKernelGGL(fwd_kernel, dim3(grid), dim3(NWAVES * 64), LDS_BYTES, stream, a);
#else
    for (int p = 0; p < NPHASE; ++p) { a.ph_lo = p; a.ph_hi = p + 1; hipLaunchKernelGGL(fwd_kernel, dim3(grid), dim3(NWAVES * 64), LDS_BYTES, stream, a); }
#endif
}
```

```cpp
#include <hip/hip_runtime.h>
#include <cstdio>
#include <cstdint>
namespace pg8 {
#define PG8_LAS __attribute__((address_space(3)))
typedef unsigned short bf16_t;
typedef short bf16x8 __attribute__((ext_vector_type(8)));
typedef float f32x4 __attribute__((ext_vector_type(4)));
typedef unsigned u32x4 __attribute__((ext_vector_type(4)));
constexpr int BM = 256, BK = 64, HALF = 128, HTB = HALF * BK * 2  , STAGE_BYTES = 8 * HTB, NXCD = 8, WGM = 8;

__host__ __device__ __forceinline__ int lds_byte(int r, int c) { const int st = (r >> 4) * 2 + (c >> 5), rr = r & 15, cc = c & 31, ob = rr * 64 + cc * 2; return st * 1024 + (ob ^ (((ob >> 9) & 1) << 5)); }
__host__ __device__ __forceinline__ void stage_rc(int b, int& R, int& C) { const int st = b / 1024, sb = b % 1024, swz = sb ^ (((sb >> 9) & 1) << 5); R = (st >> 1) * 16 + swz / 64; C = (st & 1) * 32 + (swz % 64) / 2; }
__host__ __device__ __forceinline__ int perm32(int rho) { const int n = rho >> 4, i = rho & 15; return 8 * (i >> 2) + 4 * n + (i & 3); }

struct Unit { int pm, pn, aux, aux2, aux3; };
struct Gemm { const bf16_t* A; const bf16_t* Bt; int lda, K; };

struct StaticOrder {
    int nM, nN, nwg, G, c;
    __host__ __device__ void init(int M, int N, int G_, int c_) { nM = M / BM; nN = N / BM; nwg = nM * nN; G = G_; c = c_; }
    __host__ __device__ bool next(int i, Unit& u) const {
        const long L = (long)i * G + c; if (L >= nwg) return false;
        int wgid = (int)L; { const int q = nwg / NXCD, r = nwg % NXCD, xcd = wgid % NXCD, off = wgid / NXCD; wgid = (xcd < r ? xcd * (q + 1) : r * (q + 1) + (xcd - r) * q) + off; }
        const int nig = WGM * nN, gid = wgid / nig, fm = gid * WGM, gsz = (nM - fm) < WGM ? (nM - fm) : WGM;
        u.pm = fm + ((wgid % nig) % gsz); u.pn = (wgid % nig) / gsz; return true;
    }
    __device__ __forceinline__ void a_ready(const Unit&) const {}
    __device__ __forceinline__ void done(const Unit&) const {}
};

__device__ __forceinline__ unsigned cvt_pk_bf16(float lo, float hi) { unsigned r; asm volatile("v_cvt_pk_bf16_f32 %0, %1, %2" : "=v"(r) : "v"(lo), "v"(hi)); return r; }
typedef float f32x2 __attribute__((ext_vector_type(2)));
typedef int i32x4 __attribute__((ext_vector_type(4)));
typedef int i32x8 __attribute__((ext_vector_type(8)));
#define PG8_RSBUF 147456
#define PG8_TOKBUF (131072 + 4096)
#ifndef FP8_SCALE1
#define FP8_SCALE1 0
#endif
__device__ __forceinline__ i32x8 cat8(bf16x8 a, bf16x8 b) { return __builtin_shufflevector(__builtin_bit_cast(i32x4, a), __builtin_bit_cast(i32x4, b), 0, 1, 2, 3, 4, 5, 6, 7); }
typedef float f32x8 __attribute__((ext_vector_type(8)));
typedef float f32x16 __attribute__((ext_vector_type(16)));
typedef float f32x32 __attribute__((ext_vector_type(32)));
__device__ __forceinline__ f32x32 cat32(f32x4 a, f32x4 b, f32x4 c, f32x4 d, f32x4 e, f32x4 f, f32x4 g, f32x4 h) {
    const f32x8 p = __builtin_shufflevector(a, b, 0, 1, 2, 3, 4, 5, 6, 7), q = __builtin_shufflevector(c, d, 0, 1, 2, 3, 4, 5, 6, 7), r = __builtin_shufflevector(e, f, 0, 1, 2, 3, 4, 5, 6, 7), s = __builtin_shufflevector(g, h, 0, 1, 2, 3, 4, 5, 6, 7);
    const f32x16 u = __builtin_shufflevector(p, q, 0, 1, 2, 3, 4, 5, 6, 7, 8, 9, 10, 11, 12, 13, 14, 15), v = __builtin_shufflevector(r, s, 0, 1, 2, 3, 4, 5, 6, 7, 8, 9, 10, 11, 12, 13, 14, 15);
    return __builtin_shufflevector(u, v, 0, 1, 2, 3, 4, 5, 6, 7, 8, 9, 10, 11, 12, 13, 14, 15, 16, 17, 18, 19, 20, 21, 22, 23, 24, 25, 26, 27, 28, 29, 30, 31); }
template <class Epi, class Sched, bool ALIGN_EPI = false, bool SP2 = false, bool GATHER = false, bool FP8 = false>
__device__ __forceinline__ void gemm_phase(PG8_LAS unsigned char* lds, const Gemm g, const Sched& S, const Epi& E, int wave_idx) {
    int tid_ = wave_idx * 64 + (int)__builtin_amdgcn_mbcnt_hi(~0u, __builtin_amdgcn_mbcnt_lo(~0u, 0u)); asm volatile("" : "+v"(tid_));
    const int tid = tid_, wid = __builtin_amdgcn_readfirstlane(tid >> 6), lane = tid & 63, wr = wid >> 2, wc = wid & 3, fr = lane & 15, fq = lane >> 4;
    const int K = g.K, lda = g.lda; int nt_ = K / BK; asm volatile("" : "+s"(nt_)); const int nt = nt_;
    unsigned voffA[2], voffB[2]; int rA_[2]; unsigned cA_[2]; unsigned gcur[2][2], gnxt[2][2];
#pragma unroll
    for (int i = 0; i < 2; ++i) { int R, C; stage_rc(tid * 16 + i * 8192, R, C); const int Rb = Epi::PERM ? ((R & ~31) + perm32(R & 31)) : R;
        voffA[i] = (unsigned)(R * lda + C) * 2u; rA_[i] = R; cA_[i] = (unsigned)C * 2u; voffB[i] = (unsigned)(Rb * K + C) * 2u; }
    const size_t kstep = (size_t)(BK * 2);
    const size_t hstepA = (size_t)HALF * lda * 2, hstepB = (size_t)HALF * K * 2;
    const size_t tstepA = GATHER ? 0 : 2 * hstepA, tstepB = 2 * hstepB;
    const unsigned ldsw = (unsigned)wid * 1024u;
    const int aoff = lds_byte(wr * 64 + fr, fq * 8), boff = lds_byte(wc * 32 + fr, fq * 8);
#define PG8_SA(b, h) (((b) * 2 + (h)) * HTB)
#define PG8_SB(b, h) ((4 + (b) * 2 + (h)) * HTB)
#define PG8_STAGE(bufoff, gbase, voff) do { _Pragma("unroll") for (int _i = 0; _i < 2; ++_i) \
        __builtin_amdgcn_global_load_lds((const unsigned*)((const char*)(gbase) + (voff)[_i]), (PG8_LAS unsigned*)(lds + (bufoff) + ldsw + _i * 8192), 16, 0, 0); } while (0)
#define PG8_STAGE_A(bufoff, gbase, h, NX) do { if constexpr (GATHER) { _Pragma("unroll") for (int _i = 0; _i < 2; ++_i) { const unsigned o_ = (NX) ? gnxt[h][_i] : gcur[h][_i]; \
        __builtin_amdgcn_global_load_lds((const unsigned*)((const char*)(gbase) + o_), (PG8_LAS unsigned*)(lds + (bufoff) + ldsw + _i * 8192), 16, 0, 0); } } \
    else { PG8_STAGE(bufoff, (const char*)(gbase) + (h) * hstepA, voffA); } } while (0)
#define PG8_LDA(dst, b, h) do { _Pragma("unroll") for (int m = 0; m < 4; ++m) _Pragma("unroll") for (int k = 0; k < 2; ++k) dst[m][k] = *(const PG8_LAS bf16x8*)(lds + PG8_SA(b, h) + aoff + m * 2048 + k * 1024); } while (0)
#define PG8_LDB(dst, b, h) do { _Pragma("unroll") for (int n = 0; n < 2; ++n) _Pragma("unroll") for (int k = 0; k < 2; ++k) dst[n][k] = *(const PG8_LAS bf16x8*)(lds + PG8_SB(b, h) + boff + n * 2048 + k * 1024); } while (0)
#define PG8_MMA(ai, bj, At, Bt) do { if constexpr (FP8 && bj == 0) { PG8_FRAG_ANCHOR("v[160:191]", At[0][0], At[0][1], At[1][0], At[1][1], At[2][0], At[2][1], At[3][0], At[3][1]); PG8_FRAG_ANCHOR("v[128:159]", B0[0][0], B0[0][1], B0[1][0], B0[1][1], B1[0][0], B1[0][1], B1[1][0], B1[1][1]); } \
        __builtin_amdgcn_s_setprio(1); _Pragma("unroll") for (int m = 0; m < 4; ++m) _Pragma("unroll") for (int n = 0; n < 2; ++n) { \
        if constexpr (FP8) acc[ai][bj][m][n] = __builtin_amdgcn_mfma_scale_f32_16x16x128_f8f6f4(cat8(Bt[n][0], Bt[n][1]), cat8(At[m][0], At[m][1]), acc[ai][bj][m][n], 0, 0, 0, FP8_SCALE1, 0, FP8_SCALE1); \
        else { _Pragma("unroll") for (int k = 0; k < 2; ++k) acc[ai][bj][m][n] = __builtin_amdgcn_mfma_f32_16x16x32_bf16(Bt[n][k], At[m][k], acc[ai][bj][m][n], 0, 0, 0); } } __builtin_amdgcn_s_setprio(0); } while (0)
#define PG8_FRAG_ANCHOR(REG, f0, f1, f2, f3, f4, f5, f6, f7) do { f32x32 big_ = cat32(__builtin_bit_cast(f32x4, f0), __builtin_bit_cast(f32x4, f1), __builtin_bit_cast(f32x4, f2), __builtin_bit_cast(f32x4, f3), __builtin_bit_cast(f32x4, f4), __builtin_bit_cast(f32x4, f5), __builtin_bit_cast(f32x4, f6), __builtin_bit_cast(f32x4, f7)); asm volatile("" : "+{" REG "}"(big_)); \
        f0 = __builtin_bit_cast(bf16x8, (f32x4)__builtin_shufflevector(big_, big_, 0, 1, 2, 3)); f1 = __builtin_bit_cast(bf16x8, (f32x4)__builtin_shufflevector(big_, big_, 4, 5, 6, 7)); f2 = __builtin_bit_cast(bf16x8, (f32x4)__builtin_shufflevector(big_, big_, 8, 9, 10, 11)); f3 = __builtin_bit_cast(bf16x8, (f32x4)__builtin_shufflevector(big_, big_, 12, 13, 14, 15)); \
        f4 = __builtin_bit_cast(bf16x8, (f32x4)__builtin_shufflevector(big_, big_, 16, 17, 18, 19)); f5 = __builtin_bit_cast(bf16x8, (f32x4)__builtin_shufflevector(big_, big_, 20, 21, 22, 23)); f6 = __builtin_bit_cast(bf16x8, (f32x4)__builtin_shufflevector(big_, big_, 24, 25, 26, 27)); f7 = __builtin_bit_cast(bf16x8, (f32x4)__builtin_shufflevector(big_, big_, 28, 29, 30, 31)); } while (0)
#define PG8_WAIT_V(n) asm volatile("s_waitcnt vmcnt(" #n ")" ::: "memory")
#define PG8_WAIT_L(n) asm volatile("s_waitcnt lgkmcnt(" #n ")" ::: "memory")
#define PG8_BAR __builtin_amdgcn_s_barrier()
#define PG8_SCHED __builtin_amdgcn_sched_barrier(0)
    Unit cur, nxt; int ui = 0;
    if (!S.next(0, cur)) return;
    if constexpr (GATHER) {
#pragma unroll
        for (int h_ = 0; h_ < 2; ++h_)
#pragma unroll
            for (int i_ = 0; i_ < 2; ++i_) { gcur[h_][i_] = (unsigned)S.row_tok(cur, h_ * HALF + rA_[i_]) * (unsigned)(lda * 2) + cA_[i_]; gnxt[h_][i_] = gcur[h_][i_]; } }
#define PG8_ANCHOR() do { if constexpr (FP8) { _Pragma("unroll") for (int a_ = 0; a_ < 2; ++a_) _Pragma("unroll") for (int b_ = 0; b_ < 2; ++b_) { \
        f32x32 big_ = cat32(acc[a_][b_][0][0], acc[a_][b_][0][1], acc[a_][b_][1][0], acc[a_][b_][1][1], acc[a_][b_][2][0], acc[a_][b_][2][1], acc[a_][b_][3][0], acc[a_][b_][3][1]); if (a_ == 0 && b_ == 0) asm volatile("" : "+{v[0:31]}"(big_)); else if (a_ == 0) asm volatile("" : "+{v[32:63]}"(big_)); else if (b_ == 0) asm volatile("" : "+{v[64:95]}"(big_)); else asm volatile("" : "+{v[96:127]}"(big_)); \
        acc[a_][b_][0][0] = __builtin_shufflevector(big_, big_, 0, 1, 2, 3); acc[a_][b_][0][1] = __builtin_shufflevector(big_, big_, 4, 5, 6, 7); acc[a_][b_][1][0] = __builtin_shufflevector(big_, big_, 8, 9, 10, 11); acc[a_][b_][1][1] = __builtin_shufflevector(big_, big_, 12, 13, 14, 15); \
        acc[a_][b_][2][0] = __builtin_shufflevector(big_, big_, 16, 17, 18, 19); acc[a_][b_][2][1] = __builtin_shufflevector(big_, big_, 20, 21, 22, 23); acc[a_][b_][3][0] = __builtin_shufflevector(big_, big_, 24, 25, 26, 27); acc[a_][b_][3][1] = __builtin_shufflevector(big_, big_, 28, 29, 30, 31); } } } while (0)
    f32x4 acc[2][2][4][2];
#pragma unroll
    for (int a = 0; a < 2; ++a)
#pragma unroll
        for (int b = 0; b < 2; ++b)
#pragma unroll
            for (int m = 0; m < 4; ++m)
#pragma unroll
                for (int n = 0; n < 2; ++n) acc[a][b][m][n] = (f32x4){0.f, 0.f, 0.f, 0.f};
    PG8_ANCHOR();
    bf16x8 At[4][2], B0[2][2], B1[2][2];
    const char* cA = (const char*)g.A + (size_t)cur.pm * tstepA; const char* cB = (const char*)g.Bt + (size_t)cur.pn * tstepB;
    S.a_ready(cur);
    if constexpr (SP2) {
        PG8_STAGE(PG8_SB(0, 0), cB, voffB); PG8_STAGE(PG8_SB(0, 1), cB + hstepB, voffB); PG8_STAGE_A(PG8_SA(0, 0), cA, 0, false); PG8_STAGE_A(PG8_SA(0, 1), cA, 1, false);
        if (wr == 1) PG8_BAR;
        PG8_WAIT_V(2); PG8_BAR;
        PG8_STAGE(PG8_SB(1, 0), cB + kstep, voffB); PG8_STAGE_A(PG8_SA(1, 0), cA + kstep, 0, false); PG8_STAGE(PG8_SB(1, 1), cB + hstepB + kstep, voffB);
        PG8_WAIT_V(6); PG8_BAR;
    } else {
        PG8_STAGE(PG8_SB(0, 0), cB, voffB); PG8_STAGE_A(PG8_SA(0, 0), cA, 0, false); PG8_STAGE(PG8_SB(0, 1), cB + hstepB, voffB); PG8_STAGE_A(PG8_SA(0, 1), cA, 1, false);
        if (wr == 1) PG8_BAR;
        PG8_WAIT_V(4); PG8_BAR;
        PG8_STAGE(PG8_SB(1, 0), cB + kstep, voffB); PG8_STAGE_A(PG8_SA(1, 0), cA + kstep, 0, false); PG8_STAGE(PG8_SB(1, 1), cB + hstepB + kstep, voffB);
        PG8_WAIT_V(6); PG8_BAR;
    }
    for (;;) {
        bool has_next = false; const char* nA = cA; const char* nB = cB;
        _Pragma("nounroll") for (int t = 0; t < nt; t += 2) {
            const bool last = (t == nt - 2);
            const char* a1 = cA + (size_t)(t + 1) * kstep;
            if constexpr (SP2) {
            PG8_LDB(B0, 0, 0); PG8_LDB(B1, 0, 1); PG8_SCHED; PG8_LDA(At, 0, 0); PG8_STAGE_A(PG8_SA(1, 1), a1, 1, false);
            PG8_WAIT_V(8); PG8_WAIT_L(0); PG8_BAR; PG8_MMA(0, 0, At, B0); PG8_MMA(0, 1, At, B1); PG8_BAR; PG8_SCHED;
            if (t == 0) {
        if constexpr (Epi::RSNP == 16) { const char* rp_ = (const char*)E.rs_src(cur);
            if (rp_) { _Pragma("unroll") for (int i_ = 0; i_ < 2; ++i_) __builtin_amdgcn_global_load_lds((const unsigned*)(rp_ + tid * 16 + i_ * 8192), (PG8_LAS unsigned*)(lds + PG8_RSBUF + wid * 1024 + i_ * 8192), 16, 0, 0); } }
        if constexpr (Epi::RSNP == 4) { const char* rp_ = (const char*)E.rs_src(cur);
            if (rp_ && wid < 4) __builtin_amdgcn_global_load_lds((const unsigned*)(rp_ + tid * 16), (PG8_LAS unsigned*)(lds + PG8_RSBUF + wid * 1024), 16, 0, 0); }
has_next = S.next(ui + 1, nxt);
        if constexpr (GATHER) { if (has_next && wid < 4) {
            __builtin_amdgcn_global_load_lds((const unsigned*)(S.row_ptr(nxt) + tid), (PG8_LAS unsigned*)(lds + PG8_TOKBUF + wid * 256), 4, 0, 0); } }
        nA = has_next ? (const char*)g.A + (size_t)nxt.pm * tstepA : cA; nB = has_next ? (const char*)g.Bt + (size_t)nxt.pn * tstepB : cB;
            }
            const char* a2 = last ? nA : cA + (size_t)(t + 2) * kstep; const char* b2 = last ? nB : cB + (size_t)(t + 2) * kstep;
            const char* a3 = a2 + kstep; const char* b3 = b2 + kstep;
            if (last && has_next) S.a_ready(nxt);
            if constexpr (GATHER) { if (last && has_next) { asm volatile("" ::: "memory");
#pragma unroll
                for (int h_ = 0; h_ < 2; ++h_)
#pragma unroll
                    for (int i_ = 0; i_ < 2; ++i_) { const int tk_ = *(const PG8_LAS int*)(lds + PG8_TOKBUF + (h_ * HALF + rA_[i_]) * 4); gnxt[h_][i_] = (unsigned)(tk_ & 0xffff) * (unsigned)(lda * 2) + cA_[i_]; } } }
            PG8_LDA(At, 0, 1); PG8_STAGE(PG8_SB(0, 0), b2, voffB); PG8_STAGE(PG8_SB(0, 1), b2 + hstepB, voffB); PG8_STAGE_A(PG8_SA(0, 0), a2, 0, last);
            PG8_WAIT_V(8); PG8_WAIT_L(0); PG8_BAR; PG8_MMA(1, 0, At, B0); PG8_MMA(1, 1, At, B1); PG8_BAR; PG8_SCHED;
            PG8_LDB(B0, 1, 0); PG8_LDB(B1, 1, 1); PG8_SCHED; PG8_LDA(At, 1, 0); PG8_STAGE_A(PG8_SA(0, 1), a2, 1, last);
            PG8_WAIT_V(8); PG8_WAIT_L(0); PG8_BAR; PG8_MMA(0, 0, At, B0); PG8_MMA(0, 1, At, B1); PG8_BAR; PG8_SCHED;
            PG8_LDA(At, 1, 1); PG8_STAGE(PG8_SB(1, 0), b3, voffB); PG8_STAGE(PG8_SB(1, 1), b3 + hstepB, voffB); PG8_STAGE_A(PG8_SA(1, 0), a3, 0, last);
            PG8_WAIT_V(8); PG8_WAIT_L(0); PG8_BAR; PG8_MMA(1, 0, At, B0); PG8_MMA(1, 1, At, B1); PG8_BAR; PG8_SCHED;
            } else {
            if (t == 0) {
        if constexpr (Epi::RSNP == 16) { const char* rp_ = (const char*)E.rs_src(cur);
            if (rp_) { _Pragma("unroll") for (int i_ = 0; i_ < 2; ++i_) __builtin_amdgcn_global_load_lds((const unsigned*)(rp_ + tid * 16 + i_ * 8192), (PG8_LAS unsigned*)(lds + PG8_RSBUF + wid * 1024 + i_ * 8192), 16, 0, 0); } }
        if constexpr (Epi::RSNP == 4) { const char* rp_ = (const char*)E.rs_src(cur);
            if (rp_ && wid < 4) __builtin_amdgcn_global_load_lds((const unsigned*)(rp_ + tid * 16), (PG8_LAS unsigned*)(lds + PG8_RSBUF + wid * 1024), 16, 0, 0); }
has_next = S.next(ui + 1, nxt);
        if constexpr (GATHER) { if (has_next && wid < 4) {
            __builtin_amdgcn_global_load_lds((const unsigned*)(S.row_ptr(nxt) + tid), (PG8_LAS unsigned*)(lds + PG8_TOKBUF + wid * 256), 4, 0, 0); } }
        nA = has_next ? (const char*)g.A + (size_t)nxt.pm * tstepA : cA; nB = has_next ? (const char*)g.Bt + (size_t)nxt.pn * tstepB : cB;
            }
            const char* a2 = last ? nA : cA + (size_t)(t + 2) * kstep; const char* b2 = last ? nB : cB + (size_t)(t + 2) * kstep;
            const char* a3 = a2 + kstep; const char* b3 = b2 + kstep;
            if (last && has_next) S.a_ready(nxt);
            if constexpr (GATHER) { if (last && has_next) { asm volatile("" ::: "memory");
#pragma unroll
                for (int h_ = 0; h_ < 2; ++h_)
#pragma unroll
                    for (int i_ = 0; i_ < 2; ++i_) { const int tk_ = *(const PG8_LAS int*)(lds + PG8_TOKBUF + (h_ * HALF + rA_[i_]) * 4); gnxt[h_][i_] = (unsigned)(tk_ & 0xffff) * (unsigned)(lda * 2) + cA_[i_]; } } }
            PG8_LDB(B0, 0, 0); PG8_SCHED; PG8_LDA(At, 0, 0); PG8_STAGE_A(PG8_SA(1, 1), a1, 1, false);
            PG8_WAIT_L(8); PG8_BAR; PG8_WAIT_L(0); PG8_MMA(0, 0, At, B0); PG8_BAR; PG8_SCHED;
            PG8_LDB(B1, 0, 1); PG8_STAGE(PG8_SB(0, 0), b2, voffB);
            PG8_BAR; PG8_WAIT_L(0); PG8_MMA(0, 1, At, B1); PG8_BAR;
            PG8_LDA(At, 0, 1); PG8_STAGE_A(PG8_SA(0, 0), a2, 0, last);
            PG8_BAR; PG8_WAIT_L(0); PG8_MMA(1, 0, At, B0); PG8_BAR; PG8_SCHED;
            PG8_STAGE(PG8_SB(0, 1), b2 + hstepB, voffB);
            PG8_WAIT_V(6); PG8_BAR; PG8_MMA(1, 1, At, B1); PG8_BAR;
            PG8_LDB(B0, 1, 0); PG8_SCHED; PG8_LDA(At, 1, 0); PG8_STAGE_A(PG8_SA(0, 1), a2, 1, last);
            PG8_WAIT_L(8); PG8_BAR; PG8_WAIT_L(0); PG8_MMA(0, 0, At, B0); PG8_BAR; PG8_SCHED;
            PG8_LDB(B1, 1, 1); PG8_STAGE(PG8_SB(1, 0), b3, voffB);
            PG8_BAR; PG8_WAIT_L(0); PG8_MMA(0, 1, At, B1); PG8_BAR;
            PG8_LDA(At, 1, 1); PG8_STAGE_A(PG8_SA(1, 0), a3, 0, last);
            PG8_BAR; PG8_WAIT_L(0); PG8_MMA(1, 0, At, B0); PG8_BAR; PG8_SCHED;
            PG8_STAGE(PG8_SB(1, 1), b3 + hstepB, voffB);
            PG8_WAIT_V(6); PG8_BAR; PG8_MMA(1, 1, At, B1); PG8_BAR;
            }
        }
        if constexpr (ALIGN_EPI) { if (wr == 0) PG8_BAR; }
        if constexpr (!Epi::AFTER_DRAIN) { E(acc, cur, wr, wc, fr, fq); S.done(cur); }
        if (!has_next) break;
#pragma unroll
        for (int a = 0; a < 2; ++a)
#pragma unroll
            for (int b = 0; b < 2; ++b)
#pragma unroll
                for (int m = 0; m < 4; ++m)
#pragma unroll
                    for (int n = 0; n < 2; ++n) acc[a][b][m][n] = (f32x4){0.f, 0.f, 0.f, 0.f};
    PG8_ANCHOR();
        cur = nxt; cA = nA; cB = nB; ++ui;
        if constexpr (GATHER) {
#pragma unroll
            for (int h_ = 0; h_ < 2; ++h_)
#pragma unroll
                for (int i_ = 0; i_ < 2; ++i_) gcur[h_][i_] = gnxt[h_][i_]; }
        if constexpr (ALIGN_EPI) { if (wr == 1) PG8_BAR; }
    }
    PG8_WAIT_V(0);
    if constexpr (!ALIGN_EPI) { if (wr == 0) PG8_BAR; }
    PG8_BAR;
    if constexpr (Epi::AFTER_DRAIN) { E.fused(acc, cur, wr, wc, fr, fq, lds, wid, lane); S.done(cur); }
#undef PG8_SA
#undef PG8_SB
#undef PG8_STAGE
#undef PG8_STAGE_A
#undef PG8_LDA
#undef PG8_LDB
#undef PG8_MMA
#undef PG8_WAIT_V
#undef PG8_WAIT_L
#undef PG8_BAR
#undef PG8_SCHED
}
}

constexpr int NWAVES = 8;
constexpr int M = 65536, SEQ = 2048, NBATCH = 32, D = 1024;
constexpr int NPROJ = 2304, FF = 2816, NGU = 2 * FF, NEXP = 8;
constexpr int C_CQ = 512, C_CKV = 768, C_KR = 896, C_DQ = 1024, C_DK = 1408, C_DV = 1792;
constexpr int QW = 576, KVW = 768;
constexpr float LOG2E = 1.4426950408889634f;
constexpr float RMS_EPS = 1e-6f, LN_EPS = 1e-5f;
constexpr float LAM_INIT0 = 0.2f, LAM_INIT1 = 0.35550906759096926f;
constexpr int NPHASE = 19;
constexpr int MOE_CHUNK_TILES = 128, MOE_MAX_TILES = 528;

constexpr size_t MiB = 1u << 20;
constexpr size_t WS_CTL = 0, CTL_ZERO_BYTES = 40960;
constexpr size_t WS_SSX = 4 * MiB;
constexpr size_t WS_SSF = 12 * MiB;
constexpr size_t WS_SSCQ = 16 * MiB;
constexpr size_t WS_SSCKV = 18 * MiB;
constexpr size_t WS_SSF1 = 20 * MiB;
constexpr size_t WS_ROPE = 21 * MiB;
constexpr size_t BGLU_OFF = 320 * 1024;
constexpr size_t WS_WR = 21 * MiB + 512 * 1024;
constexpr size_t WS_LAM = 21 * MiB + 768 * 1024;
constexpr size_t WS_WIN = 22 * MiB;
constexpr size_t WS_WUQ = 31 * MiB;
constexpr size_t WS_WUKV = WS_WUQ + 768 * 1024;
constexpr size_t WS_WPW = WS_WUKV + 768 * 1024;
constexpr size_t WS_WOUT = 33 * MiB;
constexpr size_t WS_WGUD = 37 * MiB;
constexpr size_t WS_WDD = 48 * MiB;
constexpr size_t WS_WGUE = 54 * MiB;
constexpr size_t WS_WDE = 142 * MiB;
constexpr size_t WS_XB = 186 * MiB;
constexpr size_t WS_PROJ = 314 * MiB;
constexpr size_t WS_Q = 602 * MiB;
constexpr size_t WS_KV = 674 * MiB;
constexpr size_t WS_KR = 770 * MiB;
constexpr size_t WS_CB = 774 * MiB;
constexpr size_t WS_CAT = 806 * MiB;
constexpr size_t WS_ACT = 314 * MiB;
constexpr size_t WS_HB3 = 314 * MiB;
constexpr size_t WS_Y1 = 442 * MiB;
constexpr size_t WS_ACT0 = 570 * MiB;
constexpr size_t WS_ACT1 = 746 * MiB;
constexpr size_t WS_LIST = 922 * MiB;
constexpr size_t WS_WGT = 926 * MiB;
constexpr size_t WS_END = 934 * MiB;
static_assert(WS_WPW + 2 * 256 * 256 * 2 <= WS_WOUT && WS_WDD + (size_t)1024 * 2816 * 2 <= WS_WGUE && WS_WGUE + (size_t)8 * 5632 * 1024 * 2 <= WS_WDE && WS_WDE + (size_t)8 * 1024 * 2816 * 2 <= WS_XB, "weights map");
static_assert(WS_ACT + (size_t)M * FF * 2 <= WS_KV && WS_ACT0 + (size_t)MOE_CHUNK_TILES * 256 * FF * 2 <= WS_ACT1 && WS_ACT1 + (size_t)MOE_CHUNK_TILES * 256 * FF * 2 <= WS_LIST && WS_WGT + 4 * MiB <= WS_END, "overlay map");
constexpr int CW_TMO = 0, CW_CODE = 1;
constexpr int CW_BAR = 4096;
constexpr int CW_CNT = 8192;
static_assert((CW_CNT + 8 * 64) * 4 <= (int)CTL_ZERO_BYTES && (CW_BAR + 3456) * 4 <= CW_CNT * 4, "control words inside the memset region");

constexpr int RING_OFF = 0, RING_BYTES = 131072;
constexpr int LDSCTL_OFF = RING_BYTES, MISC_OFF = LDSCTL_OFF + 320;
constexpr int RSBUF_OFF = 147456;
constexpr int LDS_BYTES = 163840;
static_assert(MISC_OFF + 64 * 4 <= LDS_BYTES, "LDS map");

#define GAS __attribute__((address_space(1)))
#define LAS __attribute__((address_space(3)))
typedef unsigned short bf16;
typedef unsigned v4u __attribute__((ext_vector_type(4)));
typedef unsigned v2u __attribute__((ext_vector_type(2)));
typedef float f32x4 __attribute__((ext_vector_type(4)));
typedef short bf16x8 __attribute__((ext_vector_type(8)));
typedef GAS unsigned gu32;
#define RLX_AGENT __ATOMIC_RELAXED, __HIP_MEMORY_SCOPE_AGENT
#define LDS_WAIT() asm volatile("s_waitcnt lgkmcnt(0)" ::: "memory")
#define VM_WAIT() asm volatile("s_waitcnt vmcnt(0)" ::: "memory")
__device__ __forceinline__ unsigned pkbf(float lo, float hi) { return pg8::cvt_pk_bf16(lo, hi); }
__device__ __forceinline__ float bf_lo(unsigned w) { return __uint_as_float(w << 16); }
__device__ __forceinline__ float bf_hi(unsigned w) { return __uint_as_float(w & 0xffff0000u); }
__device__ __forceinline__ float sigmoidf_(float x) { return __builtin_amdgcn_rcpf(1.0f + __builtin_amdgcn_exp2f(-x * LOG2E)); }
__device__ __forceinline__ float wave_sum(float v) {
#pragma unroll
    for (int o = 1; o < 64; o <<= 1) v += __shfl_xor(v, o);
    return v;
}
constexpr float QS_GU = 32.f, QS_D = 64.f, QS_ACT = 4.f;
__device__ __forceinline__ float clamp8(float x) { return __builtin_fminf(__builtin_fmaxf(x, -448.f), 448.f); }
__device__ __forceinline__ unsigned pk4f8(float a, float b, float c, float d) {
    int p = 0; p = __builtin_amdgcn_cvt_pk_fp8_f32(clamp8(a), clamp8(b), p, false); p = __builtin_amdgcn_cvt_pk_fp8_f32(clamp8(c), clamp8(d), p, true); return (unsigned)p; }
__device__ __forceinline__ float dot4_(f32x4 v) { return (v[0] * v[0] + v[1] * v[1]) + (v[2] * v[2] + v[3] * v[3]); }

namespace pg8 {
typedef unsigned u32x2 __attribute__((ext_vector_type(2)));
__device__ __forceinline__ float red_fq(float s) {
    const auto a = __builtin_amdgcn_permlane16_swap(__float_as_uint(s), __float_as_uint(s), false, false); s = __uint_as_float(a[0]) + __uint_as_float(a[1]);
    const auto b = __builtin_amdgcn_permlane32_swap(__float_as_uint(s), __float_as_uint(s), false, false); return __uint_as_float(b[0]) + __uint_as_float(b[1]);
}
__device__ __forceinline__ void load_rs8(const float* ssp_, int np, int row0, int fq, float inv_n, float eps, float (&rs)[2][4]) {
    const GAS float* ssp = (const GAS float*)ssp_;
    if (np == 16) { f32x4 t[2][4];
#pragma unroll
        for (int ai = 0; ai < 2; ++ai)
#pragma unroll
            for (int m = 0; m < 4; ++m) t[ai][m] = *(const GAS f32x4*)((const GAS char*)ssp + ((unsigned)(row0 + ai * HALF + m * 16) * 64u + 16u * fq));
#pragma unroll
        for (int ai = 0; ai < 2; ++ai)
#pragma unroll
            for (int m = 0; m < 4; ++m) rs[ai][m] = (t[ai][m][0] + t[ai][m][1]) + (t[ai][m][2] + t[ai][m][3]);
    } else if (np == 4) {
#pragma unroll
        for (int ai = 0; ai < 2; ++ai)
#pragma unroll
            for (int m = 0; m < 4; ++m) rs[ai][m] = *(const GAS float*)((const GAS char*)ssp + ((unsigned)(row0 + ai * HALF + m * 16) * 16u + 4u * fq));
    } else {
#pragma unroll
        for (int ai = 0; ai < 2; ++ai)
#pragma unroll
            for (int m = 0; m < 4; ++m) rs[ai][m] = (fq == 0) ? ssp[row0 + ai * HALF + m * 16] : 0.f;
    }
#pragma unroll
    for (int ai = 0; ai < 2; ++ai)
#pragma unroll
        for (int m = 0; m < 4; ++m) rs[ai][m] = __builtin_amdgcn_rsqf(red_fq(rs[ai][m]) * inv_n + eps);
}
__device__ __forceinline__ void load_rs8_lds(const PG8_LAS float* rsl, int trow0, int fq, float inv_n, float eps, float (&rs)[2][4]) {
    f32x4 t[2][4];
#pragma unroll
    for (int ai = 0; ai < 2; ++ai)
#pragma unroll
        for (int m = 0; m < 4; ++m) t[ai][m] = *(const PG8_LAS f32x4*)(rsl + (trow0 + ai * HALF + m * 16) * 16 + 4 * fq);
#pragma unroll
    for (int ai = 0; ai < 2; ++ai)
#pragma unroll
        for (int m = 0; m < 4; ++m) rs[ai][m] = __builtin_amdgcn_rsqf(red_fq((t[ai][m][0] + t[ai][m][1]) + (t[ai][m][2] + t[ai][m][3])) * inv_n + eps);
}
__device__ __forceinline__ void load_rs8_lds4(const PG8_LAS float* rsl, int trow0, int fq, float inv_n, float eps, float (&rs)[2][4]) {
#pragma unroll
    for (int ai = 0; ai < 2; ++ai)
#pragma unroll
        for (int m = 0; m < 4; ++m) rs[ai][m] = rsl[(trow0 + ai * HALF + m * 16) * 4 + fq];
#pragma unroll
    for (int ai = 0; ai < 2; ++ai)
#pragma unroll
        for (int m = 0; m < 4; ++m) rs[ai][m] = __builtin_amdgcn_rsqf(red_fq(rs[ai][m]) * inv_n + eps);
}
__device__ __forceinline__ float dot4(f32x4 v) { return (v[0] * v[0] + v[1] * v[1]) + (v[2] * v[2] + v[3] * v[3]); }

__device__ __forceinline__ void rope4(f32x4& x1, f32x4& x2, const float* rope, int pos, int g) {
    const GAS f32x4* t = (const GAS f32x4*)(rope + ((size_t)pos * 16 + 4 * g) * 2); const f32x4 t0 = t[0], t1 = t[1];
    const f32x4 c = (f32x4){t0[0], t0[2], t1[0], t1[2]}, s = (f32x4){t0[1], t0[3], t1[1], t1[3]};
    const f32x4 a = x1 * c - x2 * s, b = x1 * s + x2 * c; x1 = a; x2 = b;
}
__device__ __forceinline__ void rope4v(f32x4& x1, f32x4& x2, f32x4 t0, f32x4 t1) {
    const f32x4 c = (f32x4){t0[0], t0[2], t1[0], t1[2]}, s = (f32x4){t0[1], t0[3], t1[1], t1[3]};
    const f32x4 a = x1 * c - x2 * s, b = x1 * s + x2 * c; x1 = a; x2 = b;
}
__device__ __forceinline__ u32x4 pack8(f32x4 v0, f32x4 v1) { u32x4 w; w.x = cvt_pk_bf16(v0[0], v0[1]); w.y = cvt_pk_bf16(v0[2], v0[3]); w.z = cvt_pk_bf16(v1[0], v1[1]); w.w = cvt_pk_bf16(v1[2], v1[3]); return w; }

struct EpiStore {
    static constexpr bool PERM = true, AFTER_DRAIN = false;
    static constexpr int RSNP = 4;
    bf16_t* O; int ldc; const float* bias; const float* ss; int np; float inv_n, eps; const PG8_LAS float* rsl = nullptr;
    __device__ __forceinline__ const float* rs_src(const Unit& u) const { return (ss && rsl && np == 4) ? ss + (size_t)u.pm * BM * 4 : nullptr; }
    __device__ __forceinline__ void operator()(const f32x4 (&acc)[2][2][4][2], const Unit& u, int wr, int wc, int fr, int fq) const {
        const int row0 = u.pm * BM + wr * 64 + fr, col0 = u.pn * BM + wc * 32 + 8 * fq;
        f32x4 bv[2][2];
#pragma unroll
        for (int bj = 0; bj < 2; ++bj)
#pragma unroll
            for (int n = 0; n < 2; ++n) bv[bj][n] = bias ? *(const GAS f32x4*)(bias + col0 + bj * HALF + 4 * n) : (f32x4){0.f, 0.f, 0.f, 0.f};
        float rsv[2][4];
        if (ss) { if (rsl && np == 4) load_rs8_lds4(rsl, wr * 64 + fr, fq, inv_n, eps, rsv); else load_rs8(ss, np, row0, fq, inv_n, eps, rsv); }
        else {
#pragma unroll
            for (int ai = 0; ai < 2; ++ai)
#pragma unroll
                for (int m = 0; m < 4; ++m) rsv[ai][m] = 1.0f; }
#pragma unroll
        for (int ai = 0; ai < 2; ++ai)
#pragma unroll
            for (int m = 0; m < 4; ++m) { const int row = row0 + ai * HALF + m * 16; const float rs = rsv[ai][m];
                const unsigned ob = ((unsigned)row * (unsigned)ldc + (unsigned)col0) * 2u;
#pragma unroll
                for (int bj = 0; bj < 2; ++bj) *(GAS u32x4*)((GAS char*)O + (ob + bj * HALF * 2)) = pack8(acc[ai][bj][m][0] * rs + bv[bj][0], acc[ai][bj][m][1] * rs + bv[bj][1]); }
    }
};
struct EpiProj {
    static constexpr bool PERM = true, AFTER_DRAIN = false;
    static constexpr int RSNP = 16;
    bf16_t* proj; const float* ss_x; float* ss_cq; float* ss_ckv; bf16_t* krope; const float* rope; const PG8_LAS float* rsl = nullptr;
    __device__ __forceinline__ const float* rs_src(const Unit& u) const { return (ss_x && rsl) ? ss_x + (size_t)u.pm * BM * 16 : nullptr; }
    __device__ __forceinline__ void operator()(const f32x4 (&acc)[2][2][4][2], const Unit& u, int wr, int wc, int fr, int fq) const {
        const int row0 = u.pm * BM + wr * 64 + fr, col0 = u.pn * BM + wc * 32 + 8 * fq;
        float rsv[2][4];
        if (ss_x) { if (rsl) load_rs8_lds(rsl, wr * 64 + fr, fq, 1.0f / 1024.0f, 1e-6f, rsv); else load_rs8(ss_x, 16, row0, fq, 1.0f / 1024.0f, 1e-6f, rsv); }
        else {
#pragma unroll
            for (int ai = 0; ai < 2; ++ai)
#pragma unroll
                for (int m = 0; m < 4; ++m) rsv[ai][m] = 1.0f; }
        const bool glu_ = u.pn < 2;
        f32x4 gb[2][2];
        { const int c0 = (glu_ ? u.pn : 0) * 128 + wc * 32 + 8 * fq; const float* bglu = (const float*)((const char*)rope + BGLU_OFF) + (ss_x ? 512 : 0);
#pragma unroll
          for (int n = 0; n < 2; ++n) { gb[0][n] = *(const GAS f32x4*)(bglu + c0 + 4 * n); gb[1][n] = *(const GAS f32x4*)(bglu + 256 + c0 + 4 * n); } }
#pragma unroll
        for (int ai = 0; ai < 2; ++ai)
#pragma unroll
            for (int m = 0; m < 4; ++m) { const int row = row0 + ai * HALF + m * 16; const float rs = rsv[ai][m];
                const unsigned ob = ((unsigned)row * 2304u + (unsigned)col0) * 2u; float sq0 = 0.f, sq1 = 0.f;
                if (glu_) { f32x4 o_[2];
#pragma unroll
                    for (int n = 0; n < 2; ++n) { f32x4 t_ = (acc[ai][1][m][n] * rs + gb[1][n]) * -1.4426950408889634f;
#pragma unroll
                        for (int j = 0; j < 4; ++j) t_[j] = __builtin_amdgcn_rcpf(1.0f + __builtin_amdgcn_exp2f(t_[j]));
                        o_[n] = (acc[ai][0][m][n] * rs + gb[0][n]) * t_; }
                    *(GAS u32x4*)((GAS char*)proj + ((unsigned)row * 2304u + (unsigned)(u.pn * 128 + wc * 32 + 8 * fq)) * 2u) = pack8(o_[0], o_[1]); continue; }
#pragma unroll
                for (int bj = 0; bj < 2; ++bj) { f32x4 v0 = acc[ai][bj][m][0] * rs, v1 = acc[ai][bj][m][1] * rs;
                    if (u.pn == 2 || u.pn == 3) { if (bj == 0) sq0 = dot4(v0) + dot4(v1); else sq1 = dot4(v0) + dot4(v1); }
                    if (!(bj == 1 && ((u.pn == 3 && wc >= 1) || u.pn == 8))) *(GAS u32x4*)((GAS char*)proj + (ob + bj * HALF * 2)) = pack8(v0, v1);
 }
                if (u.pn == 2) { const float s = red_fq(sq0 + sq1); if (fq == 0) *(GAS float*)((GAS char*)ss_cq + ((unsigned)row * 16u + 4u * wc)) = s; }
                else if (u.pn == 3) { const float s = red_fq(sq0); if (fq == 0) *(GAS float*)((GAS char*)ss_ckv + ((unsigned)row * 16u + 4u * wc)) = s; } }
        if (u.pn == 3 && wc == 0) {
            f32x4 tr[2][4][2];
#pragma unroll
            for (int ai = 0; ai < 2; ++ai)
#pragma unroll
                for (int m = 0; m < 4; ++m) { const GAS f32x4* t = (const GAS f32x4*)(rope + ((size_t)((row0 + ai * HALF + m * 16) & 2047) * 16 + 4 * fq) * 2); tr[ai][m][0] = t[0]; tr[ai][m][1] = t[1]; }
#pragma unroll
            for (int ai = 0; ai < 2; ++ai)
#pragma unroll
                for (int m = 0; m < 4; ++m) { const int row = row0 + ai * HALF + m * 16; const float rs = rsv[ai][m];
                    f32x4 v0 = acc[ai][1][m][0] * rs, v1 = acc[ai][1][m][1] * rs; rope4v(v0, v1, tr[ai][m][0], tr[ai][m][1]); *(GAS u32x4*)((GAS char*)krope + ((unsigned)row * 64u + 16u * fq)) = pack8(v0, v1); } }
    }
};
struct EpiQ {
    static constexpr bool PERM = true, AFTER_DRAIN = false;
    static constexpr int RSNP = 4;
    bf16_t* q; const float* ss_cq; const float* rope; const PG8_LAS float* rsl = nullptr;
    __device__ __forceinline__ const float* rs_src(const Unit& u) const { return rsl ? ss_cq + (size_t)u.pm * BM * 4 : nullptr; }
    __device__ __forceinline__ void operator()(const f32x4 (&acc)[2][2][4][2], const Unit& u, int wr, int wc, int fr, int fq) const {
        if (wc == 3) return;
        const int row0 = u.pm * BM + wr * 64 + fr;
        f32x4 tr[2][4][2];
        if (wc == 2) {
#pragma unroll
            for (int ai = 0; ai < 2; ++ai)
#pragma unroll
                for (int m = 0; m < 4; ++m) { const GAS f32x4* t = (const GAS f32x4*)(rope + ((size_t)((row0 + ai * HALF + m * 16) & 2047) * 16 + 4 * fq) * 2); tr[ai][m][0] = t[0]; tr[ai][m][1] = t[1]; } }
        float rsv[2][4]; if (rsl) load_rs8_lds4(rsl, wr * 64 + fr, fq, 1.0f / 256.0f, 1e-6f, rsv); else load_rs8(ss_cq, 4, row0, fq, 1.0f / 256.0f, 1e-6f, rsv);
#pragma unroll
        for (int ai = 0; ai < 2; ++ai)
#pragma unroll
            for (int m = 0; m < 4; ++m) { const int row = row0 + ai * HALF + m * 16; const float rs = rsv[ai][m];
#pragma unroll
                for (int bj = 0; bj < 2; ++bj) { f32x4 v0 = acc[ai][bj][m][0] * rs, v1 = acc[ai][bj][m][1] * rs;
                    if (wc == 2) rope4v(v0, v1, tr[ai][m][0], tr[ai][m][1]);
                    *(GAS u32x4*)((GAS char*)q + ((unsigned)row * 1152u + (unsigned)((2 * u.pn + bj) * 96 + wc * 32 + 8 * fq) * 2u)) = pack8(v0, v1); } }
    }
};
__device__ __forceinline__ f32x4 gram_acc(u32x4 w, f32x4 d) { const bf16x8 f = __builtin_bit_cast(bf16x8, w); return __builtin_amdgcn_mfma_f32_16x16x32_bf16(f, f, d, 0, 0, 0); }
__device__ __forceinline__ float gram_diag(f32x4 d, int fr) { const int r = fr & 3; return r == 0 ? d[0] : r == 1 ? d[1] : r == 2 ? d[2] : d[3]; }
__device__ __forceinline__ f32x4 unpk_lo(u32x4 p) { return (f32x4){__uint_as_float(p.x << 16), __uint_as_float(p.x & 0xffff0000u), __uint_as_float(p.y << 16), __uint_as_float(p.y & 0xffff0000u)}; }
__device__ __forceinline__ f32x4 unpk_hi(u32x4 p) { return (f32x4){__uint_as_float(p.z << 16), __uint_as_float(p.z & 0xffff0000u), __uint_as_float(p.w << 16), __uint_as_float(p.w & 0xffff0000u)}; }
struct EpiResid {
    static constexpr bool PERM = true, AFTER_DRAIN = false;
    static constexpr int RSNP = 0;
    const float* xin; bf16_t* xb; float* ss; float asc = 1.0f;
    __device__ __forceinline__ void operator()(const f32x4 (&acc)[2][2][4][2], const Unit& u, int wr, int wc, int fr, int fq) const {
        const int row0 = u.pm * BM + wr * 64 + fr, col0 = u.pn * BM + wc * 32 + 8 * fq;
        if (xin) {
            f32x4 pre[4][2][2];
#pragma unroll
            for (int m = 0; m < 4; ++m) { const unsigned oe = (unsigned)(row0 + m * 16) * 1024u + (unsigned)col0;
#pragma unroll
                for (int bj = 0; bj < 2; ++bj)
#pragma unroll
                    for (int n = 0; n < 2; ++n) pre[m][bj][n] = __builtin_nontemporal_load((const GAS f32x4*)((const GAS char*)xin + (oe + bj * HALF + n * 4) * 4u)); }
#pragma unroll
            for (int ai = 0; ai < 2; ++ai)
#pragma unroll
                for (int m = 0; m < 4; ++m) { const int row = row0 + ai * HALF + m * 16; const unsigned oe = (unsigned)row * 1024u + (unsigned)col0; f32x4 dg = (f32x4){0.f, 0.f, 0.f, 0.f};
                    f32x4 v[2][2];
#pragma unroll
                    for (int bj = 0; bj < 2; ++bj)
#pragma unroll
                        for (int n = 0; n < 2; ++n) v[bj][n] = pre[m][bj][n] + acc[ai][bj][m][n];
                    if (ai == 0) { const unsigned oe2 = oe + (unsigned)HALF * 1024u;
#pragma unroll
                        for (int bj = 0; bj < 2; ++bj)
#pragma unroll
                            for (int n = 0; n < 2; ++n) pre[m][bj][n] = __builtin_nontemporal_load((const GAS f32x4*)((const GAS char*)xin + (oe2 + bj * HALF + n * 4) * 4u)); }
#pragma unroll
                    for (int bj = 0; bj < 2; ++bj) { const u32x4 w_ = pack8(v[bj][0], v[bj][1]); *(GAS u32x4*)((GAS char*)xb + (oe + bj * HALF) * 2u) = w_; if (ss) dg = gram_acc(w_, dg); }
                    if (ss) { const float s = gram_diag(dg, fr); if (fq == (fr >> 2)) *(GAS float*)((GAS char*)ss + ((unsigned)row * 64u + (unsigned)(4 * u.pn + wc) * 4u)) = s; } }
        } else {
            u32x4 pre[2][4][2];
#pragma unroll
            for (int ai = 0; ai < 2; ++ai)
#pragma unroll
                for (int m = 0; m < 4; ++m) { const unsigned ob = ((unsigned)(row0 + ai * HALF + m * 16) * 1024u + (unsigned)col0) * 2u;
#pragma unroll
                    for (int bj = 0; bj < 2; ++bj) pre[ai][m][bj] = __builtin_nontemporal_load((const GAS u32x4*)((const GAS char*)xb + (ob + bj * HALF * 2))); }
#pragma unroll
            for (int ai = 0; ai < 2; ++ai)
#pragma unroll
                for (int m = 0; m < 4; ++m) { const int row = row0 + ai * HALF + m * 16; const unsigned ob = ((unsigned)row * 1024u + (unsigned)col0) * 2u; f32x4 dg = (f32x4){0.f, 0.f, 0.f, 0.f};
#pragma unroll
                    for (int bj = 0; bj < 2; ++bj) { const u32x4 p = pre[ai][m][bj]; const f32x4 v0 = unpk_lo(p) + acc[ai][bj][m][0] * asc, v1 = unpk_hi(p) + acc[ai][bj][m][1] * asc;
                        const u32x4 w_ = pack8(v0, v1); *(GAS u32x4*)((GAS char*)xb + (ob + bj * HALF * 2)) = w_; if (ss) dg = gram_acc(w_, dg); }
                    if (ss) { const float s = gram_diag(dg, fr); if (fq == (fr >> 2)) *(GAS float*)((GAS char*)ss + ((unsigned)row * 64u + (unsigned)(4 * u.pn + wc) * 4u)) = s; } }
        }
    }
};
template <int PROBE = 0  , bool NORS = false  , int F8 = 0  > struct EpiSwiGLU_ {
    static constexpr bool PERM = true, AFTER_DRAIN = false;
    static constexpr int RSNP = NORS ? 0 : 16;
    bf16_t* act; const float* ss; int np; int nct; const PG8_LAS float* rsl = nullptr;
    __device__ __forceinline__ const float* rs_src(const Unit& u) const { return (ss && rsl) ? ss + (size_t)u.pm * BM * 16 : nullptr; }
    __device__ __forceinline__ void operator()(const f32x4 (&acc)[2][2][4][2], const Unit& u, int wr, int wc, int fr, int fq) const {
        const int row0 = u.pm * BM + wr * 64 + fr, col0 = (u.pn % nct) * 128 + wc * 32 + 8 * fq;
        float rsv[2][4];
        if (PROBE == 2 || !ss) {
#pragma unroll
            for (int ai = 0; ai < 2; ++ai)
#pragma unroll
                for (int m = 0; m < 4; ++m) rsv[ai][m] = PROBE == 2 ? 0.03f : 1.0f; }
        else if (rsl) load_rs8_lds(rsl, wr * 64 + fr, fq, 1.0f / 1024.0f, 1e-6f, rsv);
        else load_rs8(ss, np, row0, fq, 1.0f / 1024.0f, 1e-6f, rsv);
#pragma unroll
        for (int ai = 0; ai < 2; ++ai)
#pragma unroll
            for (int m = 0; m < 4; ++m) { const int row = row0 + ai * HALF + m * 16; const float rs = rsv[ai][m];
                f32x4 a[2];
#pragma unroll
                for (int n = 0; n < 2; ++n) {
                    if constexpr (F8 != 0) {
                        const float sg = F8 == 1 ? 1.0f / QS_GU : rs, ce = -1.4426950408889634f * sg, ci = F8 == 1 ? QS_GU * QS_GU / QS_ACT : __builtin_amdgcn_rcpf(sg * sg * QS_ACT), lci = F8 == 1 ? 8.0f : __builtin_amdgcn_logf(ci);
                        static_assert(F8 != 1 || QS_GU * QS_GU / QS_ACT == 256.0f, "log2 of the MoE scale constant");
                        const f32x4 G = acc[ai][0][m][n], U = acc[ai][1][m][n]; f32x4 t;
#pragma unroll
                        for (int j = 0; j < 4; ++j) t[j] = __builtin_amdgcn_exp2f(__builtin_fmaf(G[j], ce, lci));
                        t = t + ci;
#pragma unroll
                        for (int j = 0; j < 4; ++j) t[j] = __builtin_amdgcn_rcpf(t[j]);
                        a[n] = (G * U) * t; }
                    else { const f32x4 g = NORS ? acc[ai][0][m][n] : acc[ai][0][m][n] * rs, up = NORS ? acc[ai][1][m][n] : acc[ai][1][m][n] * rs;
#pragma unroll
                        for (int j = 0; j < 4; ++j) a[n][j] = g[j] * __builtin_amdgcn_rcpf(1.0f + __builtin_amdgcn_exp2f(-g[j] * 1.4426950408889634f)) * up[j]; } }
                if constexpr (F8 != 0) { v2u w8; w8.x = pk4f8(a[0][0], a[0][1], a[0][2], a[0][3]); w8.y = pk4f8(a[1][0], a[1][1], a[1][2], a[1][3]);
                    *(GAS v2u*)((GAS char*)act + ((unsigned)row * 2816u + (unsigned)col0)) = w8; }
                else { const u32x4 w = pack8(a[0], a[1]);
                    if (PROBE == 1) asm volatile("" :: "v"(w)); else *(GAS u32x4*)(act + (size_t)row * 2816 + col0) = w; } }
    }
};
typedef EpiSwiGLU_<0> EpiSwiGLU;
typedef EpiSwiGLU_<0, true> EpiSwiGLUn;
typedef EpiSwiGLU_<0, true, 1> EpiSwiGLU8;
typedef EpiSwiGLU_<0, false, 2> EpiSwiGLUd8;
struct EpiScatter {
    static constexpr bool PERM = true, AFTER_DRAIN = false;
    static constexpr int RSNP = 0;
    bf16_t* xb; bf16_t* y1; const int* list; const float* wgt; float wsc;
    __device__ __forceinline__ void operator()(const f32x4 (&acc)[2][2][4][2], const Unit& u, int wr, int wc, int fr, int fq) const {
        const int tr0 = wr * 64 + fr, col0 = (u.pn & 3) * BM + wc * 32 + 8 * fq; const unsigned y1off = (unsigned)((const char*)y1 - (const char*)xb);
        int tok[2][4]; float wg[2][4];
#pragma unroll
        for (int ai = 0; ai < 2; ++ai)
#pragma unroll
            for (int m = 0; m < 4; ++m) { const int tr = tr0 + ai * HALF + m * 16; const bool ok = tr < u.aux3; tok[ai][m] = ok ? ((const GAS int*)list)[u.aux2 + tr] : -1; wg[ai][m] = ok ? ((const GAS float*)wgt)[u.aux2 + tr] * wsc : 0.f; }
        u32x4 pre[2][4][2];
#pragma unroll
        for (int ai = 0; ai < 2; ++ai)
#pragma unroll
            for (int m = 0; m < 4; ++m) { const int tv = tok[ai][m]; const unsigned ob = ((unsigned)(tv < 0 ? 0 : (tv & 0xffff)) * 1024u + (unsigned)col0) * 2u;
#pragma unroll
                for (int bj = 0; bj < 2; ++bj) pre[ai][m][bj] = (tv >= 0 && (tv >> 16) == 0) ? *(const GAS u32x4*)((const GAS char*)xb + (ob + bj * HALF * 2)) : (u32x4){0u, 0u, 0u, 0u}; }
#pragma unroll
        for (int ai = 0; ai < 2; ++ai)
#pragma unroll
            for (int m = 0; m < 4; ++m) { const int tv = tok[ai][m]; const float w = wg[ai][m];
                if (tv >= 0) { const unsigned ob = ((unsigned)(tv & 0xffff) * 1024u + (unsigned)col0) * 2u + ((tv >> 16) == 0 ? 0u : y1off);
#pragma unroll
                    for (int bj = 0; bj < 2; ++bj) { const u32x4 p = pre[ai][m][bj];
                        *(GAS u32x4*)((GAS char*)xb + (ob + bj * HALF * 2)) = pack8(unpk_lo(p) + acc[ai][bj][m][0] * w, unpk_hi(p) + acc[ai][bj][m][1] * w); } } }
    }
};
struct RangeOrder : StaticOrder {
    int i0, i1;
    __device__ __forceinline__ bool next(int i, Unit& u) const { return (i0 + i < i1) && StaticOrder::next(i0 + i, u); }
};
struct FixedOrder : StaticOrder {
    __device__ __forceinline__ bool next(int i, Unit& u) const { const bool ok = StaticOrder::next(i, u); u.pm = 0; u.pn = 0; return ok; }
};
struct EpiNull {
    static constexpr bool PERM = true, AFTER_DRAIN = false;
    static constexpr int RSNP = 0;
    __device__ __forceinline__ void operator()(const f32x4 (&acc)[2][2][4][2], const Unit& u, int wr, int wc, int fr, int fq) const {
#pragma unroll
        for (int ai = 0; ai < 2; ++ai)
#pragma unroll
            for (int bj = 0; bj < 2; ++bj)
#pragma unroll
                for (int m = 0; m < 4; ++m)
#pragma unroll
                    for (int n = 0; n < 2; ++n) { f32x4 v = acc[ai][bj][m][n]; asm volatile("" :: "v"(v)); }
    }
};
struct MoeOrder {
    int nrt, nct, ta, G, c; const PG8_LAS int* P; const int* list;
    __device__ __forceinline__ bool next(int i, Unit& u) const {
        const long L = (long)i * G + c; const int nwg = nrt * nct; if (L >= nwg) return false;
        int wgid = (int)L; { const int q = nwg / NXCD, r = nwg % NXCD, xcd = wgid % NXCD, off = wgid / NXCD; wgid = (xcd < r ? xcd * (q + 1) : r * (q + 1) + (xcd - r) * q) + off; }
        const int nig = WGM * nct, gid = wgid / nig, fm = gid * WGM, gsz = (nrt - fm) < WGM ? (nrt - fm) : WGM;
        const int pm = fm + ((wgid % nig) % gsz), pn = (wgid % nig) / gsz;
        const int rt = ta + pm; int g = 0;
#pragma unroll
        for (int k = 1; k < 8; ++k) g += (P[k] <= rt) ? 1 : 0;
        const int j = rt - P[g], left = P[20 + g] - j * BM;
        u.pm = pm; u.pn = g * nct + pn; u.aux = 0; u.aux2 = g * 65536 + j * BM; u.aux3 = left < BM ? left : BM; return true;
    }
    __device__ __forceinline__ const int* row_ptr(const Unit& u) const { return list + u.aux2; }
    __device__ __forceinline__ int row_tok(const Unit& u, int r) const { return r < u.aux3 ? (((const GAS int*)list)[u.aux2 + r] & 0xffff) : 0; }
    __device__ __forceinline__ void a_ready(const Unit&) const {}
    __device__ __forceinline__ void done(const Unit&) const {}
};
}

namespace att {
using bf16x8 = __attribute__((ext_vector_type(8))) short;
using s16x4 = __attribute__((ext_vector_type(4))) short;
using f32x16 = __attribute__((ext_vector_type(16))) float;
using u32x4 = __attribute__((ext_vector_type(4))) unsigned;
typedef __attribute__((address_space(3))) const char* lds_cptr;
typedef __attribute__((address_space(3))) char* lds_ptr;
typedef short v4i16_t __attribute__((ext_vector_type(4)));
typedef unsigned short bf16;
#define LAS3 __attribute__((address_space(3)))
__device__ __forceinline__ int crow(int r, int hi) { return (r & 3) + 8 * (r >> 2) + 4 * hi; }
__device__ __forceinline__ void glds16(const void* sbase, unsigned voff, unsigned lds_dst) { unsigned keep;
    asm volatile("s_mov_b32 %0, m0\n\ts_mov_b32 m0, %3\n\ts_nop 0\n\tglobal_load_lds_dwordx4 %1, %2\n\ts_mov_b32 m0, %0" : "=&s"(keep) : "v"(voff), "s"(sbase), "s"(lds_dst) : "memory"); }
__device__ __forceinline__ s16x4 vtr(lds_cptr p) { return __builtin_bit_cast(s16x4, __builtin_amdgcn_ds_read_tr16_b64_v4i16((LAS3 v4i16_t*)p)); }
typedef float f32x2_t __attribute__((ext_vector_type(2))); typedef __bf16 bf16x2_t __attribute__((ext_vector_type(2)));
__device__ __forceinline__ unsigned cvtpk(float lo, float hi) { f32x2_t v = {lo, hi}; bf16x2_t b = __builtin_convertvector(v, bf16x2_t); return __builtin_bit_cast(unsigned, b); }
#define MFMA(a, b, c) __builtin_amdgcn_mfma_f32_32x32x16_bf16(a, b, c, 0, 0, 0)
#define SBAR() __builtin_amdgcn_sched_barrier(0)
#define PIN(x) asm volatile("" : "+v"(x))
#define EX(v) __builtin_amdgcn_exp2f(v)
#define WAIT_BAR0() asm volatile("s_waitcnt vmcnt(0) lgkmcnt(0)\n\ts_barrier" ::: "memory")
#define WAIT_BARN(N) asm volatile("s_waitcnt vmcnt(" #N ") lgkmcnt(0)\n\ts_barrier" ::: "memory")
#define MX3(a, b, c) __builtin_fmaxf(__builtin_fmaxf((a), (b)), (c))
#define PAF(k) __builtin_bit_cast(bf16x8, pw##k)
#define VFR(i) (bf16x8){vlo[i][0], vlo[i][1], vlo[i][2], vlo[i][3], vhi[i][0], vhi[i][1], vhi[i][2], vhi[i][3]}
__device__ __forceinline__ float rowmax(const f32x16& p0, const f32x16& p1) {
    float a = MX3(p0[0], p0[1], p1[0]), b = MX3(p0[2], p0[3], p1[1]); a = MX3(a, p1[2], p1[3]);
#pragma unroll
    for (int r = 4; r < 16; r += 4) { a = MX3(a, p0[r], p0[r + 1]); b = MX3(b, p0[r + 2], p0[r + 3]); a = MX3(a, p1[r], p1[r + 1]); b = MX3(b, p1[r + 2], p1[r + 3]); }
    float m = __builtin_fmaxf(a, b); auto rr = __builtin_amdgcn_permlane32_swap(__float_as_uint(m), __float_as_uint(m), false, false);
    return __builtin_fmaxf(__uint_as_float(rr[0]), __uint_as_float(rr[1])); }
__device__ __forceinline__ float big_shift(float sacc) {
    auto rr = __builtin_amdgcn_permlane32_swap(__float_as_uint(sacc), __float_as_uint(sacc), false, false);
    const float m = __builtin_fmaxf(__uint_as_float(rr[0]), __uint_as_float(rr[1]));
    return m > 1073741824.0f ? (float)((int)(__float_as_uint(m) >> 23) - 127) : 0.f;
}
__device__ __forceinline__ float halfsum(float v) { auto rr = __builtin_amdgcn_permlane32_swap(__float_as_uint(v), __float_as_uint(v), false, false); return __uint_as_float(rr[0]) + __uint_as_float(rr[1]); }
__device__ __forceinline__ void cmask(f32x16& p0, f32x16& p1, int jb, int qrel, int hi) {
    const int kb = 64 * jb + 4 * hi;
#pragma unroll
    for (int r = 0; r < 16; ++r) { const int kv = kb + (r & 3) + 8 * (r >> 2); if (kv > qrel) p0[r] = -INFINITY; if (kv + 32 > qrel) p1[r] = -INFINITY; } }
__device__ __forceinline__ void store_o(const f32x16& v0, const f32x16& v1, LAS3 bf16* stg, bf16* Ow, int op, int lane, int r32, int hi) {
#pragma unroll
    for (int r = 0; r < 16; ++r) { const int orow = crow(r, hi);
        stg[orow * 64 + r32] = (bf16)(cvtpk(v0[r], 0.f) & 0xffffu); stg[orow * 64 + 32 + r32] = (bf16)(cvtpk(v1[r], 0.f) & 0xffffu); }
    asm volatile("s_waitcnt lgkmcnt(0)" ::: "memory");
#pragma unroll
    for (int i = 0; i < 4; ++i) { const int row = i * 8 + (lane >> 3), ch = lane & 7; const u32x4 v = *(const LAS3 u32x4*)(stg + row * 64 + ch * 8); *(GAS u32x4*)(Ow + (size_t)row * op + ch * 8) = v; }
    asm volatile("s_waitcnt lgkmcnt(0)" ::: "memory");
}
#define MLA_STEP(C0, C1, P0, P1, t) do { SBAR(); \
    const int sl_knext = (((t) + 1) & 3) * KS; const lds_cptr vp_ = vp0 + (((t) - 1) & 3) * VS; const lds_cptr kr_ = kp0 + ((t) & 3) * KS + 8192; \
    float sacc = (P0[0] + P0[1]); \
    C0 = MFMA(kf[0], qr[0], negm); sacc += P0[2]; sacc += P0[3]; sacc += P0[4]; PIN(sacc); pw0[0] = cvtpk(P0[0], P0[1]); pw0[1] = cvtpk(P0[2], P0[3]); PIN(pw0); SBAR(); \
    C1 = MFMA(kf[1], qr[0], negm); sacc += P0[5]; sacc += P0[6]; sacc += P0[7]; PIN(sacc); pw0[2] = cvtpk(P0[4], P0[5]); pw0[3] = cvtpk(P0[6], P0[7]); PIN(pw0); SBAR(); \
    C0 = MFMA(kf[2], qr[1], C0); sacc += P0[8]; sacc += P0[9]; sacc += P0[10]; PIN(sacc); pw1[0] = cvtpk(P0[8], P0[9]); PIN(pw1); SBAR(); \
    C1 = MFMA(kf[3], qr[1], C1); sacc += P0[11]; sacc += P0[12]; sacc += P0[13]; PIN(sacc); pw1[1] = cvtpk(P0[10], P0[11]); PIN(pw1); SBAR(); \
    kf[0] = *(const LAS3 bf16x8*)(kr_ + 0); SBAR(); C0 = MFMA(kf[4], qr[2], C0); sacc += P0[14]; sacc += P0[15]; sacc += P1[0]; PIN(sacc); pw1[2] = cvtpk(P0[12], P0[13]); PIN(pw1); SBAR(); \
    kf[1] = *(const LAS3 bf16x8*)(kr_ + 512); SBAR(); C1 = MFMA(kf[5], qr[2], C1); sacc += P1[1]; sacc += P1[2]; sacc += P1[3]; PIN(sacc); pw1[3] = cvtpk(P0[14], P0[15]); PIN(pw1); SBAR(); \
    kf[2] = *(const LAS3 bf16x8*)(kr_ + 2048); SBAR(); C0 = MFMA(kf[6], qr[3], C0); sacc += P1[4]; sacc += P1[5]; PIN(sacc); pw2[0] = cvtpk(P1[0], P1[1]); pw2[1] = cvtpk(P1[2], P1[3]); PIN(pw2); SBAR(); \
    kf[3] = *(const LAS3 bf16x8*)(kr_ + 2560); SBAR(); C1 = MFMA(kf[7], qr[3], C1); sacc += P1[6]; sacc += P1[7]; PIN(sacc); pw2[2] = cvtpk(P1[4], P1[5]); pw2[3] = cvtpk(P1[6], P1[7]); PIN(pw2); SBAR(); \
    C0 = MFMA(kf[0], qr[4], C0); sacc += P1[8]; sacc += P1[9]; PIN(sacc); pw3[0] = cvtpk(P1[8], P1[9]); PIN(pw3); SBAR(); \
    C1 = MFMA(kf[1], qr[4], C1); sacc += P1[10]; sacc += P1[11]; PIN(sacc); pw3[1] = cvtpk(P1[10], P1[11]); PIN(pw3); SBAR(); \
    if (PROBE != 4) { vlo[0] = vtr(vp_ + 0); vhi[0] = vtr(vp_ + 512); } SBAR(); C0 = MFMA(kf[2], qr[5], C0); sacc += P1[12]; sacc += P1[13]; PIN(sacc); pw3[2] = cvtpk(P1[12], P1[13]); PIN(pw3); SBAR(); \
    if (PROBE != 4) { vlo[4] = vtr(vp_ + 4096); vhi[4] = vtr(vp_ + 4608); } SBAR(); C1 = MFMA(kf[3], qr[5], C1); sacc += P1[14]; sacc += P1[15]; PIN(sacc); pw3[3] = cvtpk(P1[14], P1[15]); PIN(pw3); SBAR(); \
    l_reg += sacc; \
    if ((t) - (NT - 4) >= (wid >> 1)) cmask(C0, C1, (t) - (NT - 4), qrel, hi); \
    MLA_DECIDE(C0, C1); SBAR(); MLA_MIDBAR(); SBAR(); \
    if (PROBE != 4) { vlo[1] = vtr(vp_ + 1024); vhi[1] = vtr(vp_ + 1536); } SBAR(); if (PROBE != 6) o[0] = MFMA(PAF(0), VFR(0), o[0]); C0[0] = MEX(C0[0]); C0[1] = MEX(C0[1]); C0[2] = MEX(C0[2]); C0[3] = MEX(C0[3]); PIN(C0); SBAR(); \
    if (PROBE != 4) { vlo[5] = vtr(vp_ + 5120); vhi[5] = vtr(vp_ + 5632); } SBAR(); if (PROBE != 5) { kf[0] = *(const LAS3 bf16x8*)(kp0 + sl_knext + 0); kf[1] = *(const LAS3 bf16x8*)(kp0 + sl_knext + 512); } SBAR(); if (PROBE != 6) o[1] = MFMA(PAF(0), VFR(4), o[1]); C0[4] = MEX(C0[4]); C0[5] = MEX(C0[5]); C0[6] = MEX(C0[6]); C0[7] = MEX(C0[7]); PIN(C0); SBAR(); \
    if (PROBE != 4) { vlo[2] = vtr(vp_ + 2048); vhi[2] = vtr(vp_ + 2560); } SBAR(); if (PROBE != 5) { kf[2] = *(const LAS3 bf16x8*)(kp0 + sl_knext + 2048); kf[3] = *(const LAS3 bf16x8*)(kp0 + sl_knext + 2560); } SBAR(); if (PROBE != 6) o[0] = MFMA(PAF(1), VFR(1), o[0]); C0[8] = MEX(C0[8]); C0[9] = MEX(C0[9]); C0[10] = MEX(C0[10]); C0[11] = MEX(C0[11]); PIN(C0); SBAR(); \
    if (PROBE != 4) { vlo[6] = vtr(vp_ + 6144); vhi[6] = vtr(vp_ + 6656); } SBAR(); if (PROBE != 5) { kf[4] = *(const LAS3 bf16x8*)(kp0 + sl_knext + 4096); kf[5] = *(const LAS3 bf16x8*)(kp0 + sl_knext + 4608); } SBAR(); if (PROBE != 6) o[1] = MFMA(PAF(1), VFR(5), o[1]); C0[12] = MEX(C0[12]); C0[13] = MEX(C0[13]); C0[14] = MEX(C0[14]); C0[15] = MEX(C0[15]); PIN(C0); SBAR(); \
    if (PROBE != 4) { vlo[3] = vtr(vp_ + 3072); vhi[3] = vtr(vp_ + 3584); } SBAR(); if (PROBE != 5) { kf[6] = *(const LAS3 bf16x8*)(kp0 + sl_knext + 6144); kf[7] = *(const LAS3 bf16x8*)(kp0 + sl_knext + 6656); } SBAR(); if (PROBE != 6) o[0] = MFMA(PAF(2), VFR(2), o[0]); C1[0] = MEX(C1[0]); C1[1] = MEX(C1[1]); C1[2] = MEX(C1[2]); C1[3] = MEX(C1[3]); PIN(C1); SBAR(); \
    if (PROBE != 4) { vlo[7] = vtr(vp_ + 7168); vhi[7] = vtr(vp_ + 7680); } SBAR(); if (PROBE != 6) o[1] = MFMA(PAF(2), VFR(6), o[1]); C1[4] = MEX(C1[4]); C1[5] = MEX(C1[5]); C1[6] = MEX(C1[6]); C1[7] = MEX(C1[7]); PIN(C1); SBAR(); \
    if (PROBE != 6) o[0] = MFMA(PAF(3), VFR(3), o[0]); C1[8] = MEX(C1[8]); C1[9] = MEX(C1[9]); C1[10] = MEX(C1[10]); C1[11] = MEX(C1[11]); PIN(C1); SBAR(); \
    if (PROBE != 6) o[1] = MFMA(PAF(3), VFR(7), o[1]); C1[12] = MEX(C1[12]); C1[13] = MEX(C1[13]); C1[14] = MEX(C1[14]); C1[15] = MEX(C1[15]); PIN(C1); SBAR(); \
    } while (0)

#define DIFF_STEP(C0, C1, P0, P1, OP, MP, t, VSL, KNEXT, KND0, NMH, TBN, HASPREV, FIRST) do { SBAR(); \
    const lds_cptr vp_ = vp0 + (VSL); float sacc = 0.f; \
    C0 = MFMA(kx0, QXF(), (f32x16){}); if (HASPREV) { sacc += P0[0]; sacc += P0[1]; sacc += P0[2]; sacc += P0[3]; sacc += P0[4]; sacc += P0[5]; PIN(sacc); pw0[0] = cvtpk(P0[0], P0[1]); pw0[1] = cvtpk(P0[2], P0[3]); pw0[2] = cvtpk(P0[4], P0[5]); PIN(pw0); } SBAR(); \
    C1 = MFMA(kx1, QXF(), (f32x16){}); if (HASPREV) { sacc += P0[6]; sacc += P0[7]; sacc += P0[8]; sacc += P0[9]; sacc += P0[10]; sacc += P0[11]; PIN(sacc); pw0[3] = cvtpk(P0[6], P0[7]); pw1[0] = cvtpk(P0[8], P0[9]); pw1[1] = cvtpk(P0[10], P0[11]); PIN(pw0); PIN(pw1); } SBAR(); \
    C0 = MFMA(kf[0], qr[2 * (MP)], C0); if (HASPREV) { sacc += P0[12]; sacc += P0[13]; sacc += P0[14]; sacc += P0[15]; sacc += P1[0]; PIN(sacc); pw1[2] = cvtpk(P0[12], P0[13]); pw1[3] = cvtpk(P0[14], P0[15]); pw2[0] = cvtpk(P1[0], P1[1]); PIN(pw1); PIN(pw2); } SBAR(); \
    C1 = MFMA(kf[1], qr[2 * (MP)], C1); if (HASPREV) { sacc += P1[1]; sacc += P1[2]; sacc += P1[3]; sacc += P1[4]; sacc += P1[5]; PIN(sacc); pw2[1] = cvtpk(P1[2], P1[3]); pw2[2] = cvtpk(P1[4], P1[5]); pw2[3] = cvtpk(P1[6], P1[7]); PIN(pw2); } SBAR(); \
    if (HASPREV) { vlo[0] = vtr(vp_ + 0); vhi[0] = vtr(vp_ + 512); } SBAR(); C0 = MFMA(kf[2], qr[2 * (MP) + 1], C0); if (HASPREV) { sacc += P1[6]; sacc += P1[7]; sacc += P1[8]; sacc += P1[9]; sacc += P1[10]; PIN(sacc); pw3[0] = cvtpk(P1[8], P1[9]); pw3[1] = cvtpk(P1[10], P1[11]); PIN(pw3); } SBAR(); \
    if (HASPREV) { vlo[4] = vtr(vp_ + 4096); vhi[4] = vtr(vp_ + 4608); } SBAR(); C1 = MFMA(kf[3], qr[2 * (MP) + 1], C1); if (HASPREV) { sacc += P1[11]; sacc += P1[12]; sacc += P1[13]; sacc += P1[14]; sacc += P1[15]; PIN(sacc); pw3[2] = cvtpk(P1[12], P1[13]); pw3[3] = cvtpk(P1[14], P1[15]); PIN(pw3); } SBAR(); \
    if (HASPREV) { if ((MP) == 0) l2 += sacc; else l1 += sacc; } \
    if ((t) - (NT - 4) >= (wid >> 1)) cmask(C0, C1, (t) - (NT - 4), qrel, hi); \
    DIFF_DECIDE(C0, C1, MP, FIRST, HASPREV); SBAR(); \
    if (HASPREV) { vlo[1] = vtr(vp_ + 1024); vhi[1] = vtr(vp_ + 1536); } SBAR(); if (HASPREV) OP[0] = MFMA(PAF(0), VFR(0), OP[0]); C0[0] = EX(C0[0]); C0[1] = EX(C0[1]); C0[2] = EX(C0[2]); C0[3] = EX(C0[3]); PIN(C0); QX_SET((TBN) - (NMH)); SBAR(); \
    if (HASPREV) { vlo[5] = vtr(vp_ + 5120); vhi[5] = vtr(vp_ + 5632); } SBAR(); kf[0] = *(const LAS3 bf16x8*)(kp0 + (KNEXT) + ((KND0) + 0) * 2048 + 0); SBAR(); if (HASPREV) OP[1] = MFMA(PAF(0), VFR(4), OP[1]); C0[4] = EX(C0[4]); C0[5] = EX(C0[5]); C0[6] = EX(C0[6]); C0[7] = EX(C0[7]); PIN(C0); SBAR(); \
    if (HASPREV) { vlo[2] = vtr(vp_ + 2048); vhi[2] = vtr(vp_ + 2560); } SBAR(); kf[1] = *(const LAS3 bf16x8*)(kp0 + (KNEXT) + ((KND0) + 0) * 2048 + 512); SBAR(); if (HASPREV) OP[0] = MFMA(PAF(1), VFR(1), OP[0]); C0[8] = EX(C0[8]); C0[9] = EX(C0[9]); C0[10] = EX(C0[10]); C0[11] = EX(C0[11]); PIN(C0); SBAR(); \
    if (HASPREV) { vlo[6] = vtr(vp_ + 6144); vhi[6] = vtr(vp_ + 6656); } SBAR(); kf[2] = *(const LAS3 bf16x8*)(kp0 + (KNEXT) + ((KND0) + 1) * 2048 + 0); SBAR(); if (HASPREV) OP[1] = MFMA(PAF(1), VFR(5), OP[1]); C0[12] = EX(C0[12]); C0[13] = EX(C0[13]); C0[14] = EX(C0[14]); C0[15] = EX(C0[15]); PIN(C0); SBAR(); \
    if (HASPREV) { vlo[3] = vtr(vp_ + 3072); vhi[3] = vtr(vp_ + 3584); } SBAR(); kf[3] = *(const LAS3 bf16x8*)(kp0 + (KNEXT) + ((KND0) + 1) * 2048 + 512); SBAR(); if (HASPREV) OP[0] = MFMA(PAF(2), VFR(2), OP[0]); C1[0] = EX(C1[0]); C1[1] = EX(C1[1]); C1[2] = EX(C1[2]); C1[3] = EX(C1[3]); PIN(C1); SBAR(); \
    if (HASPREV) { vlo[7] = vtr(vp_ + 7168); vhi[7] = vtr(vp_ + 7680); } SBAR(); if (HASPREV) OP[1] = MFMA(PAF(2), VFR(6), OP[1]); C1[4] = EX(C1[4]); C1[5] = EX(C1[5]); C1[6] = EX(C1[6]); C1[7] = EX(C1[7]); PIN(C1); SBAR(); \
    if (HASPREV) OP[0] = MFMA(PAF(3), VFR(3), OP[0]); C1[8] = EX(C1[8]); C1[9] = EX(C1[9]); C1[10] = EX(C1[10]); C1[11] = EX(C1[11]); PIN(C1); SBAR(); \
    if (HASPREV) OP[1] = MFMA(PAF(3), VFR(7), OP[1]); C1[12] = EX(C1[12]); C1[13] = EX(C1[13]); C1[14] = EX(C1[14]); C1[15] = EX(C1[15]); PIN(C1); SBAR(); \
    if (rescd) { asm volatile("s_waitcnt lgkmcnt(0)" ::: "memory"); _Pragma("unroll") for (int r = 0; r < 16; ++r) { const float g_ = wsf[crow(r, hi)]; OP[0][r] *= g_; OP[1][r] *= g_; } asm volatile("s_waitcnt lgkmcnt(0)" ::: "memory"); } \
    } while (0)


constexpr int MLA_KS = 12288, MLA_VS = 8192, MLA_LV = 4 * MLA_KS, MLA_WS = MLA_LV + 4 * MLA_VS, MLA_OST = MLA_WS + 8 * 256, MLA_LDS = MLA_OST + 8 * 4096;
constexpr int DIF_KS = 8192, DIF_VS = 8192, DIF_LV = 4 * DIF_KS, DIF_WS = DIF_LV + 4 * DIF_VS, DIF_OST = DIF_WS + 8 * 256, DIF_LDS = DIF_OST + 8 * 4096;
constexpr int ATT_LDS_BYTES = MLA_LDS > DIF_LDS ? MLA_LDS : DIF_LDS;

struct UnitId { int qb, b, h, t0; };
struct MlaT { const bf16* q; const bf16* kv; const bf16* kr; bf16* cat; };
struct DiffT { const bf16* proj; bf16* cat; };
#define MLA_QH(T, D) ((T).q + (size_t)(D).b * 2048 * 576 + (D).h * 96)
#define MLA_KH(T, D) ((T).kv + (size_t)(D).b * 2048 * 768 + (D).h * 128)
#define MLA_KRH(T, D) ((T).kr + (size_t)(D).b * 2048 * 32)
#define MLA_VH(T, D) ((T).kv + (size_t)(D).b * 2048 * 768 + (D).h * 128 + 64)
#define MLA_OH(T, D) ((T).cat + (size_t)(D).b * 2048 * 1024 + 256 + (D).h * 64)
#define DIF_QH(T, D) ((T).proj + (size_t)(D).b * 2048 * 2304 + 1024 + (D).h * 64)
#define DIF_KH(T, D) ((T).proj + ((size_t)(D).b * 2048 + (size_t)(D).t0 * 64) * 2304 + 1408 + (D).h * 64)
#define DIF_VH(T, D) ((T).proj + ((size_t)(D).b * 2048 + (size_t)(D).t0 * 64) * 2304 + 1792 + (D).h * 64)
#define DIF_OH(T, D) ((T).cat + (size_t)(D).b * 2048 * 1024 + 640 + (D).h * 64)

template <int THRL, int PROBE = 0  >
__device__ __forceinline__ void mla_unit(const MlaT& T, const UnitId& U, bool first, bool has_next, const UnitId& UN, bf16x8 (&qr)[6], lds_ptr shm, int tid_in) {
    int tid = tid_in; asm volatile("" : "+v"(tid));
    constexpr int QP = 576, KP = 768, VP = 768, OP = 1024, KS = MLA_KS, VS = MLA_VS;
    const int lane = tid & 63, r32 = lane & 31, hi = lane >> 5; const int wid = __builtin_amdgcn_readfirstlane(tid >> 6);
    const int q0 = U.qb * 256, NT = (q0 + 256) / 64;
    const int tl = NT - 1;
    const bool h2 = wid >= 4;
    const unsigned lds0 = (unsigned)(uintptr_t)shm;
    LAS3 float* wsf = (LAS3 float*)(shm + MLA_WS) + wid * 64;
    const unsigned koff = PROBE == 7 ? (unsigned)((wid * 8 + (lane >> 3)) * KP + (lane & 7) * 8) * 2u : (unsigned)(lane * KP + wid * 8) * 2u;
    const unsigned kroff = (unsigned)(lane * 32 + (wid & 3) * 8) * 2u;
    const unsigned voff = (unsigned)((16 * (wid & 3) + (lane >> 2)) * VP + (wid >> 2) * 32 + (lane & 3) * 8) * 2u;
    const unsigned kdst = lds0 + wid * 1024, krdst = lds0 + (8 + (wid & 3)) * 1024, vdst = lds0 + MLA_LV + wid * 1024;
#define DMA_K_(D, t, off) do { glds16(MLA_KH(T, D) + (size_t)(t) * 64 * KP, koff, (unsigned)__builtin_amdgcn_readfirstlane(kdst + (off))); glds16(MLA_KRH(T, D) + (size_t)(t) * 64 * 32, kroff, (unsigned)__builtin_amdgcn_readfirstlane(krdst + (off))); } while (0)
#define DMA_V_(D, t, off) glds16(MLA_VH(T, D) + (size_t)(t) * 64 * VP, voff, (unsigned)__builtin_amdgcn_readfirstlane(vdst + (off)))
#define DMA_K(t, off) DMA_K_(U, t, off)
#define DMA_V(t, off) DMA_V_(U, t, off)
#define LOAD_Q(D) do { const bf16* Qw_ = MLA_QH(T, D) + (size_t)((D).qb * 256 + wid * 32) * QP; _Pragma("unroll") for (int d0 = 0; d0 < 6; ++d0) qr[d0] = *(const GAS bf16x8*)(Qw_ + (size_t)r32 * QP + d0 * 16 + hi * 8); } while (0)
    const lds_cptr vp0 = (lds_cptr)shm + MLA_LV + ((lane >> 4) & 1) * 32 + (lane & 3) * 8 + (4 * hi + ((lane & 15) >> 2)) * 64;
    const lds_cptr kp0 = (lds_cptr)shm + hi * 1024 + r32 * 16;
    if (first) { DMA_K(0, 0); DMA_V(0, 0); DMA_K(1, KS); DMA_V(1, VS); DMA_K(2, 2 * KS); LOAD_Q(U); }
    float mhat = 0.f, l_reg = 0.f; f32x16 o[2]; o[0] = f32x16{}; o[1] = f32x16{}; f32x16 negm = f32x16{}; PIN(negm);
    const int qrel = wid * 32 + r32; bool resc = false;
    f32x16 pA0, pA1, pB0, pB1; bf16x8 kf[8]; s16x4 vlo[8], vhi[8]; u32x4 pw0, pw1, pw2, pw3;
    if (PROBE >= 4) { _Pragma("unroll") for (int i = 0; i < 8; ++i) { vlo[i] = s16x4{}; vhi[i] = s16x4{}; } }
    WAIT_BAR0();
    DMA_K(3, 3 * KS); DMA_V(2, 2 * VS);
    { pA0 = negm; pA1 = negm;
#pragma unroll
      for (int d0 = 0; d0 < 6; ++d0) { const bf16x8 k0 = *(const LAS3 bf16x8*)(kp0 + d0 * 2048), k1 = *(const LAS3 bf16x8*)(kp0 + d0 * 2048 + 512); pA0 = MFMA(k0, qr[d0], pA0); pA1 = MFMA(k1, qr[d0], pA1); }
      if (NT == 4) cmask(pA0, pA1, 0, qrel, hi);
      const float rm = rowmax(pA0, pA1); mhat = rm;
#pragma unroll
      for (int r = 0; r < 16; ++r) { pA0[r] = EX(pA0[r] - rm); pA1[r] = EX(pA1[r] - rm); negm[r] = -mhat; }
      PIN(negm); }
#pragma unroll
    for (int d0 = 0; d0 < 4; ++d0) { kf[2 * d0] = *(const LAS3 bf16x8*)(kp0 + KS + d0 * 2048); kf[2 * d0 + 1] = *(const LAS3 bf16x8*)(kp0 + KS + d0 * 2048 + 512); }
    WAIT_BAR0();
    if (NT > 4) DMA_K(4, 0);
    if (h2) DMA_V(3, 3 * VS);
#define MEX(v) (PROBE == 1 ? (v) : EX(v))
#define MLA_MIDBAR() asm volatile("s_barrier" ::: "memory")
#define MLA_DECIDE(C0, C1) do { const float dl = big_shift(sacc); resc = false; \
        if (__builtin_expect(__any(dl > 0.f), 0)) { mhat += dl; \
            _Pragma("unroll") for (int r = 0; r < 16; ++r) { C0[r] -= dl; C1[r] -= dl; } \
            _Pragma("unroll") for (int r = 0; r < 16; ++r) negm[r] = -mhat; PIN(negm); \
            const float f = EX(-dl); l_reg *= f; if (hi == 0) wsf[r32] = f; resc = true; } } while (0)
#define MLA_RESC() do { if (resc) { asm volatile("s_waitcnt lgkmcnt(0)" ::: "memory"); _Pragma("unroll") for (int r = 0; r < 16; ++r) { const float f = wsf[crow(r, hi)]; o[0][r] *= f; o[1][r] *= f; } resc = false; } } while (0)
#define MLA_END(t) do { WAIT_BAR0(); MLA_RESC(); \
        if ((t) + 4 < NT) DMA_K((t) + 4, (((t) + 4) & 3) * KS); \
        if (h2) { if ((t) + 3 < NT) DMA_V((t) + 3, (((t) + 3) & 3) * VS); } else { if ((t) + 2 < NT && (t) >= 1) DMA_V((t) + 2, (((t) + 2) & 3) * VS); } } while (0)
#define MLA_DRAIN(P0, P1) do { float sacc = 0.f; \
      _Pragma("unroll") for (int r = 0; r < 16; ++r) sacc += P0[r] + P1[r]; \
      l_reg += sacc; \
      pw0 = (u32x4){cvtpk(P0[0], P0[1]), cvtpk(P0[2], P0[3]), cvtpk(P0[4], P0[5]), cvtpk(P0[6], P0[7])}; pw1 = (u32x4){cvtpk(P0[8], P0[9]), cvtpk(P0[10], P0[11]), cvtpk(P0[12], P0[13]), cvtpk(P0[14], P0[15])}; \
      pw2 = (u32x4){cvtpk(P1[0], P1[1]), cvtpk(P1[2], P1[3]), cvtpk(P1[4], P1[5]), cvtpk(P1[6], P1[7])}; pw3 = (u32x4){cvtpk(P1[8], P1[9]), cvtpk(P1[10], P1[11]), cvtpk(P1[12], P1[13]), cvtpk(P1[14], P1[15])}; \
      const lds_cptr vp_ = vp0 + (tl & 3) * VS; \
      _Pragma("unroll") for (int i = 0; i < 8; ++i) { vlo[i] = vtr(vp_ + (i >> 2) * 4096 + (i & 3) * 1024); vhi[i] = vtr(vp_ + (i >> 2) * 4096 + (i & 3) * 1024 + 512); } \
      o[0] = MFMA(PAF(0), VFR(0), o[0]); o[1] = MFMA(PAF(0), VFR(4), o[1]); o[0] = MFMA(PAF(1), VFR(1), o[0]); o[1] = MFMA(PAF(1), VFR(5), o[1]); \
      o[0] = MFMA(PAF(2), VFR(2), o[0]); o[1] = MFMA(PAF(2), VFR(6), o[1]); o[0] = MFMA(PAF(3), VFR(3), o[0]); o[1] = MFMA(PAF(3), VFR(7), o[1]); } while (0)
#define MLA_EPI() do { l_reg = halfsum(l_reg); \
      int le = lane; asm volatile("" : "+v"(le)); const int r32e = le & 31, hie = le >> 5; \
      if (hie == 0) wsf[32 + r32e] = 1.0f / l_reg; \
      asm volatile("s_waitcnt lgkmcnt(0)" ::: "memory"); \
      f32x16 v0, v1; \
      _Pragma("unroll") for (int r = 0; r < 16; ++r) { const float f = wsf[32 + crow(r, hie)]; v0[r] = o[0][r] * f; v1[r] = o[1][r] * f; } \
      store_o(v0, v1, (LAS3 bf16*)(shm + MLA_OST) + wid * 2048, MLA_OH(T, U) + (size_t)(q0 + wid * 32) * OP, OP, le, r32e, hie); } while (0)
    if (h2) MLA_MIDBAR();
    int t = 1;
    for (; t + 1 <= tl; t += 2) {
        MLA_STEP(pB0, pB1, pA0, pA1, t); MLA_END(t);
        MLA_STEP(pA0, pA1, pB0, pB1, t + 1); MLA_END(t + 1);
    }
    MLA_STEP(pB0, pB1, pA0, pA1, tl);
    if (!h2) MLA_MIDBAR();
    WAIT_BAR0();
    if (has_next) { DMA_K_(UN, 0, 0); DMA_V_(UN, 0, 0); DMA_K_(UN, 1, KS); DMA_V_(UN, 1, VS); DMA_K_(UN, 2, 2 * KS); LOAD_Q(UN); }
    MLA_RESC();
    MLA_DRAIN(pB0, pB1);
    MLA_EPI();
#undef DMA_K_
#undef DMA_V_
#undef DMA_K
#undef DMA_V
#undef LOAD_Q
#undef MEX
#undef MLA_MIDBAR
#undef MLA_DECIDE
#undef MLA_RESC
#undef MLA_END
#undef MLA_DRAIN
#undef MLA_EPI
}

template <int THRL>
__device__ __forceinline__ void diff_unit(const DiffT& T, const UnitId& U, bool first, bool has_next, const UnitId& UN, bf16x8 (&qr)[4], float lam, lds_ptr shm, int tid_in) {
    int tid = tid_in; asm volatile("" : "+v"(tid));
    constexpr int PP = 2304, OP = 1024, KS = DIF_KS, VS = DIF_VS;
    const int lane = tid & 63, r32 = lane & 31, hi = lane >> 5; const int wid = __builtin_amdgcn_readfirstlane(tid >> 6);
    const int q0 = U.qb * 256, NT = (q0 + 256) / 64 - U.t0, kz = 64 * U.t0;
    const int tl = NT - 4 + (wid >> 1);
    const float slope2 = exp2f(-8.0f * (float)(U.h + 1) / 6.0f) * 1.4426950408889634f;
    const unsigned lds0 = (unsigned)(uintptr_t)shm;
    LAS3 float* wsf = (LAS3 float*)(shm + DIF_WS) + wid * 64;
    const unsigned koff = (unsigned)(lane * PP + wid * 8) * 2u;
    const unsigned voff = (unsigned)((16 * (wid & 3) + (lane >> 2)) * PP + (wid >> 2) * 32 + (lane & 3) * 8) * 2u;
    const unsigned kdst = lds0 + wid * 1024, vdst = lds0 + DIF_LV + wid * 1024;
#define DMA_K_(D, t, off) glds16(DIF_KH(T, D) + (size_t)(t) * 64 * PP, koff, (unsigned)__builtin_amdgcn_readfirstlane(kdst + (off)))
#define DMA_V_(D, t, off) glds16(DIF_VH(T, D) + (size_t)(t) * 64 * PP, voff, (unsigned)__builtin_amdgcn_readfirstlane(vdst + (off)))
#define DMA_K(t, off) DMA_K_(U, t, off)
#define DMA_V(t, off) DMA_V_(U, t, off)
#define LOAD_Q(D) do { const bf16* Qw_ = DIF_QH(T, D) + (size_t)((D).qb * 256 + wid * 32) * PP; _Pragma("unroll") for (int d0 = 0; d0 < 4; ++d0) qr[d0] = *(const GAS bf16x8*)(Qw_ + (size_t)r32 * PP + d0 * 16 + hi * 8); } while (0)
    const lds_cptr vp0 = (lds_cptr)shm + DIF_LV + ((lane >> 4) & 1) * 32 + (lane & 3) * 8 + (4 * hi + ((lane & 15) >> 2)) * 64;
    const lds_cptr kp0 = (lds_cptr)shm + hi * 1024 + r32 * 16;
    if (first) { DMA_K(0, 0); DMA_V(0, 0); DMA_K(1, KS); DMA_V(1, VS); DMA_K(2, 2 * KS); LOAD_Q(U); }
    float mh1 = 0.f, mh2 = 0.f, l1 = 0.f, l2 = 0.f; f32x16 o1[2], o2[2]; o1[0] = f32x16{}; o1[1] = f32x16{}; o2[0] = f32x16{}; o2[1] = f32x16{};
    const int qrel = wid * 32 + r32;
    const float tb0 = slope2 * (float)(kz - (q0 + qrel)), tbs = 64.0f * slope2;
    const unsigned sb0 = __float_as_uint(slope2) & 0xffff0000u; const float sr1 = slope2 - __uint_as_float(sb0); const unsigned sb1 = __float_as_uint(sr1) & 0xffff0000u; const float sr2 = sr1 - __uint_as_float(sb1);
    const unsigned s2w = __float_as_uint(sr2);
    u32x4 qxw; qxw.x = __builtin_amdgcn_perm(sb1, sb0, 0x07060302u); qxw.y = 0u; qxw.z = 0u; qxw.w = 0u;
    bf16x8 kx0, kx1; { const unsigned i0 = __float_as_uint((float)r32) >> 16, i1 = __float_as_uint((float)(r32 + 32)) >> 16, one = 0x3f80u; const bool lo = (hi == 0);
        const u32x4 a0 = lo ? (u32x4){i0 | (i0 << 16), i0 | (one << 16), one | (one << 16), 0u} : (u32x4){0u, 0u, 0u, 0u}, a1 = lo ? (u32x4){i1 | (i1 << 16), i1 | (one << 16), one | (one << 16), 0u} : (u32x4){0u, 0u, 0u, 0u};
        kx0 = __builtin_bit_cast(bf16x8, a0); kx1 = __builtin_bit_cast(bf16x8, a1); }
#define QXF() __builtin_bit_cast(bf16x8, qxw)
#define QX_SET(uexpr) do { const float u_ = (uexpr); const unsigned ub_ = __float_as_uint(u_); const float r1_ = u_ - __uint_as_float(ub_ & 0xffff0000u); const unsigned r1b_ = __float_as_uint(r1_); \
        const float r2_ = r1_ - __uint_as_float(r1b_ & 0xffff0000u); qxw.y = __builtin_amdgcn_perm(ub_, s2w, 0x07060302u); qxw.z = __builtin_amdgcn_perm(__float_as_uint(r2_), r1b_, 0x07060302u); PIN(qxw); } while (0)
    const float bmax0 = slope2 * __builtin_fminf((float)(63 + kz - (q0 + qrel)), 0.f);
    f32x16 pA0, pA1, pB0, pB1; bf16x8 kf[4]; s16x4 vlo[8], vhi[8]; u32x4 pw0, pw1, pw2, pw3; bool rescd = false;
    WAIT_BAR0();
    DMA_K(3, 3 * KS); DMA_V(2, 2 * VS);
#pragma unroll
    for (int q = 0; q < 4; ++q) kf[q] = *(const LAS3 bf16x8*)(kp0 + (q >> 1) * 2048 + (q & 1) * 512);
    QX_SET(tb0);
#define DIFF_DECIDE(C0, C1, MP, FIRST, HASPREV) do { rescd = false; \
        if (FIRST) { const float dl = rowmax(C0, C1) - bmax0; if ((MP) == 0) mh1 += dl; else mh2 += dl; \
            _Pragma("unroll") for (int r = 0; r < 16; ++r) { C0[r] -= dl; C1[r] -= dl; } } \
        if (HASPREV) { const float dl = big_shift(sacc); \
            if (__builtin_expect(__any(dl > 0.f), 0)) { const float f = EX(-dl); if ((MP) == 0) { mh2 += dl; l2 *= f; } else { mh1 += dl; l1 *= f; } if (hi == 0) wsf[r32] = f; rescd = true; } } } while (0)
    DIFF_STEP(pA0, pA1, pB0, pB1, o2, 0, 0, 0, 0, 2, mh2, tb0, 0, 1);
    DIFF_STEP(pB0, pB1, pA0, pA1, o1, 1, 0, 0, KS, 0, mh1, tb0 + tbs, 1, 1);
    if (NT > 4) { WAIT_BARN(2); DMA_K(4, 0); DMA_V(3, 3 * VS); } else { WAIT_BAR0(); DMA_V(3, 3 * VS); }
    float tbt = tb0 + tbs;
    for (int t = 1; t <= tl; ++t) {
        DIFF_STEP(pA0, pA1, pB0, pB1, o2, 0, t, ((t - 1) & 3) * VS, (t & 3) * KS, 2, mh2, tbt, 1, 0);
        DIFF_STEP(pB0, pB1, pA0, pA1, o1, 1, t, (t & 3) * VS, ((t + 1) & 3) * KS, 0, mh1, tbt + tbs, 1, 0);
        tbt += tbs;
        if (t + 1 < NT) { if (t + 4 < NT) { WAIT_BARN(2); } else { WAIT_BAR0(); }
            if (t + 4 < NT) DMA_K(t + 4, ((t + 4) & 3) * KS); if (t + 3 < NT) DMA_V(t + 3, ((t + 3) & 3) * VS); }
    }
#define DIFF_DRAIN() do { float sacc = 0.f; \
      _Pragma("unroll") for (int r = 0; r < 16; ++r) sacc += pB0[r] + pB1[r]; \
      l2 += sacc; \
      pw0 = (u32x4){cvtpk(pB0[0], pB0[1]), cvtpk(pB0[2], pB0[3]), cvtpk(pB0[4], pB0[5]), cvtpk(pB0[6], pB0[7])}; pw1 = (u32x4){cvtpk(pB0[8], pB0[9]), cvtpk(pB0[10], pB0[11]), cvtpk(pB0[12], pB0[13]), cvtpk(pB0[14], pB0[15])}; \
      pw2 = (u32x4){cvtpk(pB1[0], pB1[1]), cvtpk(pB1[2], pB1[3]), cvtpk(pB1[4], pB1[5]), cvtpk(pB1[6], pB1[7])}; pw3 = (u32x4){cvtpk(pB1[8], pB1[9]), cvtpk(pB1[10], pB1[11]), cvtpk(pB1[12], pB1[13]), cvtpk(pB1[14], pB1[15])}; \
      const lds_cptr vp_ = vp0 + (tl & 3) * VS; \
      _Pragma("unroll") for (int i = 0; i < 8; ++i) { vlo[i] = vtr(vp_ + (i >> 2) * 4096 + (i & 3) * 1024); vhi[i] = vtr(vp_ + (i >> 2) * 4096 + (i & 3) * 1024 + 512); } \
      o2[0] = MFMA(PAF(0), VFR(0), o2[0]); o2[1] = MFMA(PAF(0), VFR(4), o2[1]); o2[0] = MFMA(PAF(1), VFR(1), o2[0]); o2[1] = MFMA(PAF(1), VFR(5), o2[1]); \
      o2[0] = MFMA(PAF(2), VFR(2), o2[0]); o2[1] = MFMA(PAF(2), VFR(6), o2[1]); o2[0] = MFMA(PAF(3), VFR(3), o2[0]); o2[1] = MFMA(PAF(3), VFR(7), o2[1]); } while (0)
#define DIFF_EPI() do { l1 = halfsum(l1); l2 = halfsum(l2); \
      int le = lane; asm volatile("" : "+v"(le)); const int r32e = le & 31, hie = le >> 5; \
      if (hie == 0) { wsf[r32e] = 1.0f / l1; wsf[32 + r32e] = lam / l2; } \
      asm volatile("s_waitcnt lgkmcnt(0)" ::: "memory"); \
      f32x16 v0, v1; \
      _Pragma("unroll") for (int r = 0; r < 16; ++r) { const float f1 = wsf[crow(r, hie)], f2 = wsf[32 + crow(r, hie)]; v0[r] = o1[0][r] * f1 - o2[0][r] * f2; v1[r] = o1[1][r] * f1 - o2[1][r] * f2; } \
      _Pragma("unroll") for (int r = 0; r < 16; ++r) { float s_ = v0[r] * v0[r] + v1[r] * v1[r]; \
          s_ += __shfl_xor(s_, 1); s_ += __shfl_xor(s_, 2); s_ += __shfl_xor(s_, 4); s_ += __shfl_xor(s_, 8); s_ += __shfl_xor(s_, 16); \
          const float rn = __builtin_amdgcn_rsqf(s_ * (1.0f / 64.0f) + 1e-5f); v0[r] *= rn; v1[r] *= rn; } \
      store_o(v0, v1, (LAS3 bf16*)(shm + DIF_OST) + wid * 2048, DIF_OH(T, U) + (size_t)(q0 + wid * 32) * OP, OP, le, r32e, hie); } while (0)
    const bool early = tl < NT - 1;
    if (!early) { WAIT_BAR0();
        if (has_next) { DMA_K_(UN, 0, 0); DMA_V_(UN, 0, 0); DMA_K_(UN, 1, KS); DMA_V_(UN, 1, VS); DMA_K_(UN, 2, 2 * KS); LOAD_Q(UN); } }
    DIFF_DRAIN(); DIFF_EPI();
    if (early) {
        for (int t2 = tl + 1; t2 <= NT - 2; ++t2) WAIT_BAR0();
        WAIT_BAR0();
        if (has_next) { DMA_K_(UN, 0, 0); DMA_V_(UN, 0, 0); DMA_K_(UN, 1, KS); DMA_V_(UN, 1, VS); DMA_K_(UN, 2, 2 * KS); LOAD_Q(UN); }
    }
#undef DMA_K_
#undef DMA_V_
#undef DMA_K
#undef DMA_V
#undef LOAD_Q
#undef DIFF_DECIDE
#undef DIFF_DRAIN
#undef DIFF_EPI
#undef QXF
#undef QX_SET
}
}
#define XB_TMO      128
#define XB_XCNT(j)  (256  + 64 * (j))
#define XB_XSUB(j)  (1280 + 64 * (j))
#define XB_XGEN(j)  (2304 + 64 * (j))
#define XB_TOP      3328
#define XB_TOPGEN   3392
#define XCD_BAR_WORDS 3456
#define XB_SPIN_CAP (1u << 18)

__device__ __forceinline__ unsigned xb_ld(unsigned* p)              { return __hip_atomic_load(p, __ATOMIC_RELAXED, __HIP_MEMORY_SCOPE_AGENT); }
__device__ __forceinline__ unsigned xb_add(unsigned* p, unsigned v) { return __hip_atomic_fetch_add(p, v, __ATOMIC_RELAXED, __HIP_MEMORY_SCOPE_AGENT); }
__device__ __forceinline__ unsigned xb_xcc_id() { return (unsigned)__builtin_amdgcn_s_getreg((3 << 11) | 20) & 0xFu; }
#define XB_SPIN(cond, bar) do { unsigned _sp = 0; while (cond) { __builtin_amdgcn_s_sleep(1); \
    if ((++_sp & 255u) == 0u) { if (xb_ld(&(bar)[XB_TMO])) break; if (_sp > XB_SPIN_CAP) { atomicAdd(&(bar)[XB_TMO], 1u); break; } } } } while (0)

struct XcdBarrier {
    unsigned* bar; unsigned x;
    volatile LAS unsigned* st;
};

__device__ __forceinline__ XcdBarrier xcd_barrier_post(unsigned* bar, volatile LAS unsigned* st) {
    XcdBarrier b; b.bar = bar; b.x = xb_xcc_id(); b.st = st;
    if (threadIdx.x == 0) (void)xb_add(&bar[XB_XCNT(b.x)], 1u);
    return b;
}
__device__ __forceinline__ void xcd_barrier_complete(unsigned* bar, unsigned x, unsigned& nloc, unsigned& nx) {
    const unsigned G = gridDim.x * gridDim.y * gridDim.z;
    unsigned sum, cnt, mine, sp = 0u;
    for (;;) {
        sum = 0u; cnt = 0u; mine = 0u;
#pragma unroll
        for (unsigned j = 0; j < 16; ++j) { const unsigned c = xb_ld(&bar[XB_XCNT(j)]); sum += c; cnt += (c > 0u) ? 1u : 0u; mine = (j == x) ? c : mine; }
        if (sum == G) break;
        __builtin_amdgcn_s_sleep(1);
        if ((++sp & 255u) == 0u) { if (xb_ld(&bar[XB_TMO])) break; if (sp > XB_SPIN_CAP) { atomicAdd(&bar[XB_TMO], 1u); break; } }
    }
    nloc = mine > 0u ? mine : 1u; nx = cnt > 0u ? cnt : 1u;
}

__device__ __forceinline__ void xcd_barrier(const XcdBarrier& b) {
    asm volatile("s_waitcnt vmcnt(0)" ::: "memory");
    __syncthreads();
    if (threadIdx.x == 0) {
        unsigned* bar = b.bar;
        __builtin_amdgcn_s_waitcnt(0);
        unsigned nloc = b.st[0], nx = b.st[1];
        if (nloc == 0u) { xcd_barrier_complete(bar, b.x, nloc, nx); b.st[0] = nloc; b.st[1] = nx; }
        const unsigned old = xb_add(&bar[XB_XSUB(b.x)], 1u);
        const unsigned gen = old / nloc;
        if (old + 1u == (gen + 1u) * nloc) {
            __builtin_amdgcn_fence(__ATOMIC_RELEASE, "agent");
            asm volatile("s_waitcnt vmcnt(0)" ::: "memory");
            const unsigned og = xb_add(&bar[XB_TOP], 1u);
            const unsigned tg = og / nx;
            if (og + 1u == (tg + 1u) * nx) xb_add(&bar[XB_TOPGEN], 1u);
            else XB_SPIN(xb_ld(&bar[XB_TOPGEN]) == tg, bar);
            __builtin_amdgcn_fence(__ATOMIC_ACQUIRE, "agent");
            xb_add(&bar[XB_XGEN(b.x)], 1u);
            asm volatile("s_waitcnt vmcnt(0)" ::: "memory");
        } else {
            XB_SPIN(xb_ld(&bar[XB_XGEN(b.x)]) == gen, bar);
            __builtin_amdgcn_fence(__ATOMIC_ACQUIRE, "agent");
            asm volatile("s_waitcnt vmcnt(0)" ::: "memory");
        }
    }
    __syncthreads();
}

struct Args { const float* in[29]; float* out; unsigned char* ws; int ph_lo, ph_hi; };
struct Frame {
    LAS unsigned char* lds;
    volatile LAS unsigned* MISC;
    gu32* ctl;
    int tid, lane, wave, vcu, G;
    unsigned char* ws;
    float* out;
};
#define WSP(T, off) ((T*)(F.ws + (off)))

__device__ __forceinline__ int ropeperm(int i) { return (i < 16) ? (8 * (i >> 2) + (i & 3)) : (8 * ((i - 16) >> 2) + 4 + ((i - 16) & 3)); }
__device__ __forceinline__ int dst_row(int mode, int c) {
    if (mode == 1) { if (c < 256) return (c >> 7) * 256 + (c & 127); if (c < 512) return ((c - 256) >> 7) * 256 + 128 + (c & 127);
        if (c < C_KR) return c; if (c < C_KR + 32) return C_KR + ropeperm(c - C_KR); return C_DQ + (c - (C_KR + 32)); }
    if (mode == 2) { const int hh = c / 96, d = c - hh * 96; return hh * 128 + (d < 64 ? d : 64 + ropeperm(d - 64)); }
    if (mode == 3) return (c >> 7) * 256 + (c & 127);
    if (mode == 4) return (c >> 7) * 256 + 128 + (c & 127);
    return c;
}
struct TrDesc { const float* W; bf16* WT; const float* gain; int K, N, Kdst, mode, gmode, item; float gaux, rsc, qs; };
__device__ __forceinline__ void tr_load(const TrDesc& d, int lane, float (&v)[32]) {
    const int nblk = d.N / 32, kb = d.item / nblk, nb = d.item - kb * nblk, k0 = 64 * kb, n0 = 32 * nb;
    const float* p = d.W + (size_t)(k0 + (lane >> 5)) * d.N + n0 + (lane & 31);
#pragma unroll
    for (int i = 0; i < 32; ++i) v[i] = __builtin_nontemporal_load((const GAS float*)p + (size_t)(2 * i) * d.N);
}
__device__ __forceinline__ void tr_store(const TrDesc& d, int lane, const float (&v)[32], LAS float* scr) {
    const int nblk = d.N / 32, kb = d.item / nblk, nb = d.item - kb * nblk, k0 = 64 * kb, n0 = 32 * nb;
#pragma unroll
    for (int i = 0; i < 32; ++i) scr[(2 * i + (lane >> 5)) * 33 + (lane & 31)] = v[i];
    LDS_WAIT(); asm volatile("" ::: "memory");
    const int c = lane & 7; float g[8];
#pragma unroll
    for (int j = 0; j < 8; ++j) { const int k = k0 + 8 * c + j; g[j] = 1.0f;
        if (d.gmode == 1) g[j] = d.gain[k]; else if (d.gmode == 2) g[j] = (k >= 640) ? d.gain[(k - 640) & 63] * d.gaux : 1.0f; }
#pragma unroll
    for (int j = 0; j < 4; ++j) { const int n = (lane >> 3) + 8 * j; const LAS float* s = scr + (8 * c) * 33 + n; const int dr = dst_row(d.mode, n0 + n);
        float sc = 1.0f; if (d.mode == 2) sc = d.rsc; else if (d.mode == 1 && dr >= C_DQ && dr < C_DK) sc = d.rsc;
        if (d.qs > 0.f) { sc = d.qs; v2u o8; o8.x = pk4f8(s[0 * 33] * g[0] * sc, s[1 * 33] * g[1] * sc, s[2 * 33] * g[2] * sc, s[3 * 33] * g[3] * sc); o8.y = pk4f8(s[4 * 33] * g[4] * sc, s[5 * 33] * g[5] * sc, s[6 * 33] * g[6] * sc, s[7 * 33] * g[7] * sc);
            *(GAS v2u*)((unsigned char*)d.WT + (size_t)dr * d.Kdst + k0 + 8 * c) = o8; continue; }
        v4u o; o.x = pkbf(s[0 * 33] * g[0] * sc, s[1 * 33] * g[1] * sc); o.y = pkbf(s[2 * 33] * g[2] * sc, s[3 * 33] * g[3] * sc); o.z = pkbf(s[4 * 33] * g[4] * sc, s[5 * 33] * g[5] * sc); o.w = pkbf(s[6 * 33] * g[6] * sc, s[7 * 33] * g[7] * sc);
        *(GAS v4u*)(d.WT + (size_t)dr * d.Kdst + k0 + 8 * c) = o; }
    LDS_WAIT(); asm volatile("" ::: "memory");
}
__device__ __forceinline__ void zero_rect(bf16* WT, int ld, int r0, int nr, int c0, int nc, int gt, int ngt) {
    const int cpr = nc / 8, tot = nr * cpr;
    for (int i = gt; i < tot; i += ngt) { const int r = i / cpr, c = i - r * cpr; *(GAS v4u*)(WT + (size_t)(r0 + r) * ld + c0 + 8 * c) = (v4u){0u, 0u, 0u, 0u}; }
}
__device__ __forceinline__ void x_row_prep(const float* xrow, bf16* orow, int lane) {
    const GAS f32x4* xr = (const GAS f32x4*)xrow + lane; f32x4 v[4]; float s = 0.f;
#pragma unroll
    for (int j = 0; j < 4; ++j) { v[j] = __builtin_nontemporal_load(xr + 64 * j); s += (v[j].x * v[j].x + v[j].y * v[j].y) + (v[j].z * v[j].z + v[j].w * v[j].w); }
    s = wave_sum(s); const float rs = 1.0f / sqrtf(s * (1.0f / 1024.0f) + RMS_EPS);
    GAS unsigned long long* o8 = (GAS unsigned long long*)orow + lane;
#pragma unroll
    for (int j = 0; j < 4; ++j) o8[64 * j] = (unsigned long long)pkbf(v[j].x * rs, v[j].y * rs) | ((unsigned long long)pkbf(v[j].z * rs, v[j].w * rs) << 32);
}
__device__ __forceinline__ void p0_prologue(Frame& F, const Args& A) {
    { int t_ = F.wave * 64 + (int)__builtin_amdgcn_mbcnt_hi(~0u, __builtin_amdgcn_mbcnt_lo(~0u, 0u)); asm volatile("" : "+v"(t_)); F.tid = t_; F.lane = t_ & 63; unsigned long long w_ = (unsigned long long)F.ws; asm volatile("" : "+s"(w_)); F.ws = (unsigned char*)w_; }
    LAS float* scr = (LAS float*)(F.lds + RING_OFF + F.wave * 16384);
    const int gw = F.vcu * NWAVES + F.wave, NGW = F.G * NWAVES, gt = gw * 64 + F.lane, ngt = NGW * 64;
    constexpr int I_IN = 16 * 65, I_UQ = 4 * 18, I_UKV = 2 * 24, I_PW = 4 * 8, I_OUT = 16 * 32, I_G = 16 * 88, I_D = 44 * 32;
    constexpr int I_LAYER = I_IN + I_UQ + I_UKV + I_PW + I_OUT;
    constexpr int NITEMS = 2 * I_LAYER + 3 * I_G + 8 * 3 * I_G;
    static_assert(I_G == I_D, "item counts");
    const float qsc_mla = 0.10206207261596577f * LOG2E, qsc_diff = 0.17677669529663687f * LOG2E;
#define TR_DESC(d, it_) do { int r = (it_); \
        if (r < 2 * I_LAYER) { const int l = r / I_LAYER; r -= l * I_LAYER; \
            if (r < I_IN) { d = TrDesc{A.in[2] + (size_t)l * 1024 * 2080, WSP(bf16, WS_WIN) + (size_t)l * 2304 * 1024, A.in[1] + l * 1024, 1024, 2080, 1024, 1, 1, r, 0.f, qsc_diff, 0.f}; break; } r -= I_IN; \
            if (r < I_UQ) { d = TrDesc{A.in[11] + (size_t)l * 256 * 576, WSP(bf16, WS_WUQ) + (size_t)l * 768 * 256, A.in[10] + l * 256, 256, 576, 256, 2, 1, r, 0.f, qsc_mla, 0.f}; break; } r -= I_UQ; \
            if (r < I_UKV) { d = TrDesc{A.in[13] + (size_t)l * 128 * 768, WSP(bf16, WS_WUKV) + (size_t)l * 768 * 128, A.in[12] + l * 128, 128, 768, 128, 0, 1, r, 0.f, 1.f, 0.f}; break; } r -= I_UKV; \
            if (r < I_PW) { d = TrDesc{A.in[8] + (size_t)l * 256 * 256, WSP(bf16, WS_WPW) + (size_t)l * 256 * 256, nullptr, 256, 256, 256, 0, 0, r, 0.f, 1.f, 0.f}; break; } r -= I_PW; \
            d = TrDesc{A.in[19] + (size_t)l * 1024 * 1024, WSP(bf16, WS_WOUT) + (size_t)l * 1024 * 1024, A.in[18] + l * 64, 1024, 1024, 1024, 0, 2, r, 1.0f - (l == 0 ? LAM_INIT0 : LAM_INIT1), 1.f, 0.f}; break; } \
        r -= 2 * I_LAYER; \
        if (r < I_G) { d = TrDesc{A.in[21], WSP(bf16, WS_WGUD), A.in[20], 1024, 2816, 1024, 3, 1, r, 0.f, 1.f, 0.f}; break; } r -= I_G; \
        if (r < I_G) { d = TrDesc{A.in[22], WSP(bf16, WS_WGUD), A.in[20], 1024, 2816, 1024, 4, 1, r, 0.f, 1.f, 0.f}; break; } r -= I_G; \
        if (r < I_D) { d = TrDesc{A.in[23], WSP(bf16, WS_WDD), nullptr, 2816, 1024, 2816, 0, 0, r, 0.f, 1.f, QS_D}; break; } r -= I_D; \
        { const int e = r / (3 * I_G); r -= e * 3 * I_G; \
          if (r < I_G) { d = TrDesc{A.in[25] + (size_t)e * 1024 * 2816, WSP(bf16, WS_WGUE) + (size_t)e * 5632 * 512, A.in[20] + 1024, 1024, 2816, 1024, 3, 1, r, 0.f, 1.f, QS_GU}; break; } r -= I_G; \
          if (r < I_G) { d = TrDesc{A.in[26] + (size_t)e * 1024 * 2816, WSP(bf16, WS_WGUE) + (size_t)e * 5632 * 512, A.in[20] + 1024, 1024, 2816, 1024, 4, 1, r, 0.f, 1.f, QS_GU}; break; } r -= I_G; \
          d = TrDesc{A.in[27] + (size_t)e * 2816 * 1024, WSP(bf16, WS_WDE) + (size_t)e * 1024 * 1408, nullptr, 2816, 1024, 2816, 0, 0, r, 0.f, 1.f, QS_D}; } } while (0)
    if (gw < NITEMS) {
        TrDesc dc, dn; float vc[32], vn[32];
        TR_DESC(dc, gw); tr_load(dc, F.lane, vc);
        for (int it = gw; it < NITEMS; it += NGW) {
            const bool more = it + NGW < NITEMS;
            if (more) { TR_DESC(dn, it + NGW); tr_load(dn, F.lane, vn); }
            tr_store(dc, F.lane, vc, scr);
            if (more) { dc = dn;
#pragma unroll
                for (int i = 0; i < 32; ++i) vc[i] = vn[i]; }
        }
    }
#undef TR_DESC
    for (int l = 0; l < 2; ++l) {
        zero_rect(WSP(bf16, WS_WIN) + (size_t)l * 2304 * 1024, 1024, C_KR + 32, 96, 0, 1024, gt, ngt);
        zero_rect(WSP(bf16, WS_WIN) + (size_t)l * 2304 * 1024, 1024, 2176, 128, 0, 1024, gt, ngt);
        for (int hh = 0; hh < 6; ++hh) zero_rect(WSP(bf16, WS_WUQ) + (size_t)l * 768 * 256, 256, hh * 128 + 96, 32, 0, 256, gt, ngt);
    }
    for (int i = gt; i < 2048 * 16; i += ngt) { const int pos = i >> 4, fi = i & 15;
        const float freq = exp2f(-(float)fi * (13.287712379549449f / 16.0f)); const float ang = (float)pos * freq;
        const double rev = (double)ang * 0.15915494309189535; const float fr = (float)(rev - floor(rev));
        float* t = WSP(float, WS_ROPE) + (size_t)i * 2; t[0] = __builtin_amdgcn_cosf(fr); t[1] = __builtin_amdgcn_sinf(fr); }
    for (int i = gt; i < 2 * 512; i += ngt) WSP(float, WS_ROPE + BGLU_OFF)[i] = A.in[3][i];
    for (int i = gt; i < 8 * 1024; i += ngt) { const int e = i >> 10, k = i & 1023; WSP(float, WS_WR)[i] = A.in[20][1024 + k] * A.in[24][(size_t)k * 8 + e]; }
    if (gw == 0) {
        for (int l = 0; l < 2; ++l) { const int j = F.lane & 31;
            float a = A.in[14][l * 32 + j] * A.in[15][l * 32 + j], b = A.in[16][l * 32 + j] * A.in[17][l * 32 + j];
            if (F.lane >= 32) { a = 0.f; b = 0.f; }
            a = wave_sum(a); b = wave_sum(b);
            if (F.lane == 0) WSP(float, WS_LAM)[l] = expf(a) - expf(b) + (l == 0 ? LAM_INIT0 : LAM_INIT1); } }
    for (int m = gw * 2; m < M; m += NGW * 2) {
        x_row_prep(A.in[0] + (size_t)m * D, WSP(bf16, WS_XB) + (size_t)m * D, F.lane);
        x_row_prep(A.in[0] + (size_t)(m + 1) * D, WSP(bf16, WS_XB) + (size_t)(m + 1) * D, F.lane); }
}

__device__ __forceinline__ void conv_phase(Frame& F, const Args& A, int l) {
    { int t_ = F.wave * 64 + (int)__builtin_amdgcn_mbcnt_hi(~0u, __builtin_amdgcn_mbcnt_lo(~0u, 0u)); asm volatile("" : "+v"(t_)); F.tid = t_; F.lane = t_ & 63; unsigned long long w_ = (unsigned long long)F.ws; asm volatile("" : "+s"(w_)); F.ws = (unsigned char*)w_; }
    LAS float* U = (LAS float*)(F.lds + RING_OFF);
    const bf16* proj = WSP(bf16, WS_PROJ); bf16* cb = WSP(bf16, WS_CB);
    const float* b_glu = A.in[3] + l * 512; const float* w_dw = A.in[4] + l * 31 * 256; const float* b_dw = A.in[5] + l * 256;
    const float* lng = A.in[6] + l * 256; const float* lnb = A.in[7] + l * 256;
    const int c8 = F.tid & 31, r0 = F.tid >> 5, c = F.tid & 255, hf = F.tid >> 8;
    float w[31];
#pragma unroll
    for (int j = 0; j < 31; ++j) w[j] = w_dw[j * 256 + c];
    const float bd = b_dw[c];
    const f32x4 g4 = *(const f32x4*)(lng + 4 * F.lane), b4 = *(const f32x4*)(lnb + 4 * F.lane);
    v4u a8[6];
#define CONV_LOAD(unit_) do { const int b_ = (unit_) >> 5, t0_ = ((unit_) & 31) * 64; _Pragma("unroll") for (int k = 0; k < 6; ++k) { const int r = r0 + 16 * k, tok = t0_ - 30 + r; a8[k] = (v4u){0u, 0u, 0u, 0u}; \
        if (r < 94 && tok >= 0) { const bf16* rp = proj + (size_t)(b_ * SEQ + tok) * NPROJ + c8 * 8; a8[k] = __builtin_nontemporal_load((const GAS v4u*)rp); } } } while (0)
    if (F.vcu < NBATCH * 32) CONV_LOAD(F.vcu);
    for (int unit = F.vcu; unit < NBATCH * 32; unit += F.G) {
        const int b = unit >> 5, t0 = (unit & 31) * 64;
        {
#pragma unroll
          for (int k = 0; k < 6; ++k) { const int r = r0 + 16 * k, tok = t0 - 30 + r;
              if (r < 94) { f32x4 u0 = (f32x4){0.f, 0.f, 0.f, 0.f}, u1 = u0;
                  if (tok >= 0) { u0 = (f32x4){bf_lo(a8[k].x), bf_hi(a8[k].x), bf_lo(a8[k].y), bf_hi(a8[k].y)}; u1 = (f32x4){bf_lo(a8[k].z), bf_hi(a8[k].z), bf_lo(a8[k].w), bf_hi(a8[k].w)}; }
                  *(LAS f32x4*)(U + r * 256 + c8 * 8) = u0; *(LAS f32x4*)(U + r * 256 + c8 * 8 + 4) = u1; } } }
        __syncthreads();
        if (unit + F.G < NBATCH * 32) CONV_LOAD(unit + F.G);
        { float uw[62], o[32];
#pragma unroll
          for (int j = 0; j < 62; ++j) uw[j] = U[(hf * 32 + j) * 256 + c];
#pragma unroll
          for (int i = 0; i < 32; ++i) { float a = bd;
#pragma unroll
              for (int j = 0; j < 31; ++j) a = __builtin_fmaf(w[j], uw[i + j], a);
              o[i] = a; }
          __syncthreads();
#pragma unroll
          for (int i = 0; i < 32; ++i) U[(hf * 32 + i) * 256 + c] = o[i]; }
        __syncthreads();
        { f32x4 v[8]; float s[8];
#pragma unroll
          for (int k = 0; k < 8; ++k) { v[k] = *(LAS f32x4*)(U + (F.wave * 8 + k) * 256 + 4 * F.lane); s[k] = (v[k][0] + v[k][1]) + (v[k][2] + v[k][3]); }
#pragma unroll
          for (int o = 1; o < 64; o <<= 1)
#pragma unroll
              for (int k = 0; k < 8; ++k) s[k] += __shfl_xor(s[k], o);
#pragma unroll
          for (int k = 0; k < 8; ++k) { v[k] = v[k] - s[k] * (1.0f / 256.0f); s[k] = dot4_(v[k]); }
#pragma unroll
          for (int o = 1; o < 64; o <<= 1)
#pragma unroll
              for (int k = 0; k < 8; ++k) s[k] += __shfl_xor(s[k], o);
#pragma unroll
          for (int k = 0; k < 8; ++k) { const float rstd = __builtin_amdgcn_rsqf(s[k] * (1.0f / 256.0f) + LN_EPS); f32x4 y = v[k] * rstd * g4 + b4;
#pragma unroll
              for (int j = 0; j < 4; ++j) y[j] = y[j] * sigmoidf_(y[j]);
              v2u wv; wv.x = pkbf(y[0], y[1]); wv.y = pkbf(y[2], y[3]);
              *(GAS v2u*)(cb + (size_t)(b * SEQ + t0 + F.wave * 8 + k) * 256 + 4 * F.lane) = wv; } }
        __syncthreads();
    }
#undef CONV_LOAD
}

__device__ __forceinline__ void router_phase(Frame& F, const Args& A) {
    { int t_ = F.wave * 64 + (int)__builtin_amdgcn_mbcnt_hi(~0u, __builtin_amdgcn_mbcnt_lo(~0u, 0u)); asm volatile("" : "+v"(t_)); F.tid = t_; F.lane = t_ & 63; unsigned long long w_ = (unsigned long long)F.ws; asm volatile("" : "+s"(w_)); F.ws = (unsigned char*)w_; }
    LAS int* hist = (LAS int*)(F.lds + RING_OFF);
    LAS int* rec_g = hist + 32;
    LAS int* rec_r = rec_g + 512;
    LAS float* rec_w = (LAS float*)(rec_r + 512);
    const bf16* x = WSP(bf16, WS_XB); const float* wr = WSP(float, WS_WR); float* ssf1 = WSP(float, WS_SSF1);
    int* list = WSP(int, WS_LIST); float* wgt = WSP(float, WS_WGT); bf16* hb3 = WSP(bf16, WS_HB3);
    f32x4 wv[8][4];
#pragma unroll
    for (int e = 0; e < 8; ++e)
#pragma unroll
        for (int j = 0; j < 4; ++j) wv[e][j] = *(const f32x4*)(wr + e * 1024 + 256 * j + 4 * F.lane);
    for (int blk = F.vcu; blk < M / 256; blk += F.G) {
        if (F.tid < 8) hist[F.tid] = 0;
        __syncthreads();
        for (int i = 0; i < 32; i += 2) {
            f32x4 v[2][4];
#pragma unroll
            for (int rr = 0; rr < 2; ++rr) { const int m = blk * 256 + F.wave * 32 + i + rr;
#pragma unroll
                for (int j = 0; j < 4; ++j) { const v2u p = *((const GAS v2u*)(x + (size_t)m * D) + F.lane + 64 * j); v[rr][j] = (f32x4){bf_lo(p.x), bf_hi(p.x), bf_lo(p.y), bf_hi(p.y)}; } }
#pragma unroll
            for (int rr = 0; rr < 2; ++rr) { const int lr = F.wave * 32 + i + rr, m = blk * 256 + lr;
                float ss = 0.f, lg[8];
#pragma unroll
                for (int j = 0; j < 4; ++j) ss += dot4_(v[rr][j]);
                ss = wave_sum(ss);
#pragma unroll
                for (int e = 0; e < 8; ++e) { float a = 0.f;
#pragma unroll
                    for (int j = 0; j < 4; ++j) { const f32x4 p = v[rr][j] * wv[e][j]; a += (p[0] + p[1]) + (p[2] + p[3]); }
                    lg[e] = wave_sum(a); }
                const float rs = 1.0f / sqrtf(ss * (1.0f / 1024.0f) + RMS_EPS);
#pragma unroll
                for (int j = 0; j < 4; ++j) { const f32x4 hv = v[rr][j] * rs; *((GAS unsigned*)(hb3 + (size_t)m * (D / 2)) + F.lane + 64 * j) = pk4f8(hv[0], hv[1], hv[2], hv[3]); }
                int e1 = 0; float v1 = lg[0];
#pragma unroll
                for (int e = 1; e < 8; ++e) if (lg[e] > v1) { v1 = lg[e]; e1 = e; }
                int e2 = -1; float v2 = -INFINITY;
#pragma unroll
                for (int e = 0; e < 8; ++e) if (e != e1 && (e2 < 0 || lg[e] > v2)) { v2 = lg[e]; e2 = e; }
                const float ex = __expf((v2 - v1) * rs), w1 = 1.0f / (1.0f + ex), w2 = ex * w1;
                if (F.lane == 0) { ssf1[m] = ss;
                    rec_g[lr * 2] = e1; rec_g[lr * 2 + 1] = e2; rec_w[lr * 2] = w1; rec_w[lr * 2 + 1] = w2;
                    rec_r[lr * 2] = __hip_atomic_fetch_add(hist + e1, 1, __ATOMIC_RELAXED, __HIP_MEMORY_SCOPE_WORKGROUP);
                    rec_r[lr * 2 + 1] = __hip_atomic_fetch_add(hist + e2, 1, __ATOMIC_RELAXED, __HIP_MEMORY_SCOPE_WORKGROUP); } }
        }
        __syncthreads();
        if (F.tid < 8) hist[16 + F.tid] = (int)__hip_atomic_fetch_add((unsigned*)(F.ctl + CW_CNT + 64 * F.tid), (unsigned)hist[F.tid], RLX_AGENT);
        __syncthreads();
        if (F.tid < 256) {
#pragma unroll
            for (int s = 0; s < 2; ++s) { const int g = rec_g[F.tid * 2 + s], pos = hist[16 + g] + rec_r[F.tid * 2 + s];
                list[(size_t)g * M + pos] = (blk * 256 + F.tid) | (s << 16); wgt[(size_t)g * M + pos] = rec_w[F.tid * 2 + s]; } }
        __syncthreads();
    }
}
__device__ __forceinline__ void moe_prefix(Frame& F) {
    if (F.tid == 0) { int p = 0;
        for (int g = 0; g < 8; ++g) { F.MISC[16 + g] = (unsigned)p; const unsigned c = __hip_atomic_load(F.ctl + CW_CNT + 64 * g, RLX_AGENT); F.MISC[36 + g] = c; p += (int)((c + 255u) >> 8); }
        F.MISC[24] = (unsigned)p; F.MISC[32] = (unsigned)p; }
    __syncthreads();
}
__device__ __forceinline__ void final_phase(Frame& F, const Args& A) {
    { int t_ = F.wave * 64 + (int)__builtin_amdgcn_mbcnt_hi(~0u, __builtin_amdgcn_mbcnt_lo(~0u, 0u)); asm volatile("" : "+v"(t_)); F.tid = t_; F.lane = t_ & 63; unsigned long long w_ = (unsigned long long)F.ws; asm volatile("" : "+s"(w_)); F.ws = (unsigned char*)w_; }
    const int gw = F.vcu * NWAVES + F.wave, NGW = F.G * NWAVES; const float* g = A.in[28];
    f32x4 gv[4];
#pragma unroll
    for (int j = 0; j < 4; ++j) gv[j] = *(const f32x4*)(g + 256 * j + 4 * F.lane);
    const bf16* xb = WSP(bf16, WS_XB); const bf16* y1 = WSP(bf16, WS_Y1);
    for (int m0 = gw * 4; m0 < M; m0 += NGW * 4) {
        f32x4 v[4][4];
#pragma unroll
        for (int rr = 0; rr < 4; ++rr)
#pragma unroll
            for (int j = 0; j < 4; ++j) { const v2u p = __builtin_nontemporal_load((const GAS v2u*)(xb + (size_t)(m0 + rr) * D) + F.lane + 64 * j), q = __builtin_nontemporal_load((const GAS v2u*)(y1 + (size_t)(m0 + rr) * D) + F.lane + 64 * j);
                v[rr][j] = (f32x4){bf_lo(p.x), bf_hi(p.x), bf_lo(p.y), bf_hi(p.y)} + (f32x4){bf_lo(q.x), bf_hi(q.x), bf_lo(q.y), bf_hi(q.y)}; }
#pragma unroll
        for (int rr = 0; rr < 4; ++rr) { float ss = 0.f;
#pragma unroll
            for (int j = 0; j < 4; ++j) ss += dot4_(v[rr][j]);
            ss = wave_sum(ss); const float rs = 1.0f / sqrtf(ss * (1.0f / 1024.0f) + RMS_EPS);
#pragma unroll
            for (int j = 0; j < 4; ++j) __builtin_nontemporal_store(v[rr][j] * rs * gv[j], (GAS f32x4*)(F.out + (size_t)(m0 + rr) * D) + F.lane + 64 * j); }
    }
}

__device__ __forceinline__ void attn_coords(int i, bool contig, int per, int vcu, int G, int& b, int& h, int& qb) {
    const int p = contig ? vcu * per + (i >> 1) : vcu + (i >> 1) * G; const int bh = p >> 2, s = p & 3; b = bh / 6; h = bh - b * 6; qb = (i & 1) ? s : 7 - s;
}
template <int MODE, int PROBE = 0>
__device__ __forceinline__ void attn_phase(Frame& F, int l) {
    static_assert(att::ATT_LDS_BYTES <= RING_BYTES, "attention LDS");
    { unsigned long long w_ = (unsigned long long)F.ws; asm volatile("" : "+s"(w_)); F.ws = (unsigned char*)w_; }
    const att::bf16* proj = (const att::bf16*)WSP(bf16, WS_PROJ); const att::bf16* qb_ = (const att::bf16*)WSP(bf16, WS_Q); const att::bf16* kv = (const att::bf16*)WSP(bf16, WS_KV);
    const att::bf16* kr = (const att::bf16*)WSP(bf16, WS_KR); att::bf16* cat = (att::bf16*)WSP(bf16, WS_CAT);
    const float lam = WSP(float, WS_LAM)[l];
    int tid = F.wave * 64 + (int)__builtin_amdgcn_mbcnt_hi(~0u, __builtin_amdgcn_mbcnt_lo(~0u, 0u)); asm volatile("" : "+v"(tid));
    constexpr int NPAIR = NBATCH * 6 * 4;
    const bool contig = (NPAIR % F.G) == 0; const int per = NPAIR / F.G;
    const int npairs = contig ? per : (F.vcu < NPAIR ? (NPAIR - 1 - F.vcu) / F.G + 1 : 0), nun = 2 * npairs;
    if (F.wave >= 4) __builtin_amdgcn_s_setprio(1);
    att::UnitId U{0, 0, 0, 0}, UN{0, 0, 0, 0};
    if (MODE == 0) {
        if (nun > 0) attn_coords(0, contig, per, F.vcu, F.G, UN.b, UN.h, UN.qb);
        att::bf16x8 qr[6]; const att::MlaT T{qb_, kv, kr, cat};
        for (int i = 0; i < nun; ++i) { U = UN; if (i + 1 < nun) attn_coords(i + 1, contig, per, F.vcu, F.G, UN.b, UN.h, UN.qb);
            att::mla_unit<8, PROBE>(T, U, i == 0, i + 1 < nun, UN, qr, (att::lds_ptr)(F.lds + RING_OFF), tid); }
    } else {
        static constexpr unsigned char TAB[8][6] = {{47, 44, 15, 18, 2, 0}, {39, 36, 14, 10, 41, 9}, {31, 28, 13, 7, 33, 1}, {23, 20, 12, 6, 25, 40},
                                                    {46, 45, 43, 11, 17, 32}, {38, 37, 35, 42, 5, 24}, {30, 29, 27, 34, 4, 16}, {22, 21, 19, 26, 3, 8}};
        const bool tab = (F.G == 256); const int n2 = tab ? 6 : nun;
#define DIFF_ID(D, i) do { if (tab) { const int e_ = TAB[F.vcu & 7][i]; (D).b = F.vcu >> 3; (D).h = e_ >> 3; (D).qb = e_ & 7; } else attn_coords(i, contig, per, F.vcu, F.G, (D).b, (D).h, (D).qb); \
        { const float s2_ = exp2f(-8.0f * (float)((D).h + 1) / 6.0f) * LOG2E; const int z_ = (int)floorf(((float)((D).qb * 256 - 63) - 200.0f / s2_) * (1.0f / 64.0f)) + 1; (D).t0 = z_ > 0 ? (z_ & ~3) : 0; } } while (0)
        if (n2 > 0) DIFF_ID(UN, 0);
        att::bf16x8 qr[4]; const att::DiffT T{proj, cat};
        for (int i = 0; i < n2; ++i) { U = UN; if (i + 1 < n2) DIFF_ID(UN, i + 1);
            att::diff_unit<8>(T, U, i == 0, i + 1 < n2, UN, qr, lam, (att::lds_ptr)(F.lds + RING_OFF), tid); }
#undef DIFF_ID
    }
    __builtin_amdgcn_s_setprio(0);
    asm volatile("s_waitcnt vmcnt(0) lgkmcnt(0)" ::: "memory"); __syncthreads();
}

__global__ void __launch_bounds__(NWAVES * 64, 2) fwd_kernel(Args args) {
    extern __shared__ __attribute__((aligned(16))) unsigned char lds[];
    Frame F;
    F.lds = (LAS unsigned char*)lds;
    F.MISC = (volatile LAS unsigned*)(F.lds + MISC_OFF);
    F.tid = threadIdx.x; F.lane = F.tid & 63; F.wave = __builtin_amdgcn_readfirstlane(F.tid >> 6);
    F.G = gridDim.x; { const int bx = blockIdx.x; F.vcu = (F.G % 8 == 0) ? (bx % 8) * (F.G / 8) + bx / 8 : bx; }
    F.ws = args.ws; F.ctl = (gu32*)(args.ws + WS_CTL); F.out = args.out;
    for (int u = F.tid; u < (LDS_BYTES - LDSCTL_OFF) / 4; u += NWAVES * 64) ((LAS unsigned*)(F.lds + LDSCTL_OFF))[u] = 0u;
    __syncthreads();
    const int lo = args.ph_lo, hi = args.ph_hi;
    XcdBarrier bar = xcd_barrier_post((unsigned*)(F.ctl + CW_BAR), F.MISC + 8);
#ifndef SITE_MASK
#define SITE_MASK 0xffffffffu
#endif
#define EN(n) (((SITE_MASK) >> (n)) & 1u)
#ifndef DUP_MASK
#define DUP_MASK 0u
#endif
#define DUP(n) (((DUP_MASK) >> (n)) & 1u)
#define IN(k) (lo <= (k) && (k) < hi)
#define WS_OPQ() do { unsigned long long w_ = (unsigned long long)F.ws; asm volatile("" : "+s"(w_)); F.ws = (unsigned char*)w_; } while (0)
#ifndef DUP_BAR
#define DUP_BAR 0
#endif
#define SEAM(k) do { if (IN(k) && IN((k) + 1)) { xcd_barrier(bar); if (DUP_BAR) xcd_barrier(bar); } } while (0)
    const int bx = (int)blockIdx.x;

    if (IN(0) && EN(0)) p0_prologue(F, args);
    if (IN(0) && DUP(0)) p0_prologue(F, args);
    SEAM(0);

#define rope WSP(float, WS_ROPE)
#define ss_x (WSP(float, WS_SSX) + (size_t)l * M * 16)
#define ss_cq (WSP(float, WS_SSCQ) + (size_t)l * M * 4)
#define ss_ckv (WSP(float, WS_SSCKV) + (size_t)l * M * 4)
    { constexpr int l = 0;
        const int pb = l == 0 ? 1 : 7;
        for (int rep_ = 0; rep_ < 1 + (int)DUP(1); ++rep_) if (IN(pb) && EN(1)) {
            WS_OPQ(); pg8::Gemm g{WSP(bf16, WS_XB), WSP(bf16, WS_WIN) + (size_t)l * NPROJ * 1024, 1024, 1024}; pg8::StaticOrder S; S.init(M, NPROJ, F.G, bx);
            pg8::EpiProj E{WSP(bf16, WS_PROJ), l == 0 ? nullptr : ss_x, ss_cq, ss_ckv, WSP(bf16, WS_KR), rope, (const LAS float*)(F.lds + RING_OFF + RSBUF_OFF)};
            pg8::gemm_phase<pg8::EpiProj, pg8::StaticOrder, true, true>(F.lds + RING_OFF, g, S, E, F.wave);
        }
        SEAM(pb);
        if (IN(pb + 1)) {
            if (EN(2)) conv_phase(F, args, l);
            if (DUP(2)) conv_phase(F, args, l);
            for (int rep_ = 0; rep_ < 1 + (int)DUP(3); ++rep_) if (EN(3)) { WS_OPQ(); pg8::Gemm g{WSP(bf16, WS_PROJ) + C_CQ, WSP(bf16, WS_WUQ) + (size_t)l * 768 * 256, NPROJ, 256}; pg8::StaticOrder S; S.init(M, 768, F.G, bx);
              pg8::EpiQ E{WSP(bf16, WS_Q), ss_cq, rope, (const LAS float*)(F.lds + RING_OFF + RSBUF_OFF)};
              pg8::gemm_phase<pg8::EpiQ, pg8::StaticOrder, true, true>(F.lds + RING_OFF, g, S, E, F.wave); }
            for (int rep_ = 0; rep_ < 1 + (int)DUP(4); ++rep_) if (EN(4)) { WS_OPQ(); pg8::Gemm g{WSP(bf16, WS_PROJ) + C_CKV, WSP(bf16, WS_WUKV) + (size_t)l * 768 * 128, NPROJ, 128}; pg8::StaticOrder S; S.init(M, 768, F.G, bx);
              pg8::EpiStore E{WSP(bf16, WS_KV), KVW, nullptr, ss_ckv, 4, 1.0f / 128.0f, RMS_EPS, (const LAS float*)(F.lds + RING_OFF + RSBUF_OFF)};
              pg8::gemm_phase<pg8::EpiStore, pg8::StaticOrder, true, true>(F.lds + RING_OFF, g, S, E, F.wave); }
        }
        SEAM(pb + 1);
        if (IN(pb + 2)) {
            if (DUP(21)) attn_phase<0, 1>(F, l);
            if (DUP(22)) attn_phase<0, 4>(F, l);
            if (DUP(23)) attn_phase<0, 5>(F, l);
            if (DUP(24)) attn_phase<0, 6>(F, l);
            if (DUP(25)) attn_phase<0, 7>(F, l);
            if (DUP(5)) attn_phase<0>(F, l);
            if (EN(5)) attn_phase<0>(F, l);
            if (EN(6)) attn_phase<1>(F, l);
            if (DUP(6)) attn_phase<1>(F, l);
            for (int rep_ = 0; rep_ < 1 + (int)DUP(7); ++rep_) if (EN(7)) { WS_OPQ(); pg8::Gemm g{WSP(bf16, WS_CB), WSP(bf16, WS_WPW) + (size_t)l * 256 * 256, 256, 256}; pg8::StaticOrder S; S.init(M, 256, F.G, bx);
              pg8::EpiStore E{WSP(bf16, WS_CAT), D, args.in[9] + l * 256, nullptr, 1, 0.f, 0.f};
              pg8::gemm_phase<pg8::EpiStore, pg8::StaticOrder, true, true>(F.lds + RING_OFF, g, S, E, F.wave); }
        }
        SEAM(pb + 2);
        if (IN(pb + 3) && EN(8)) {
            WS_OPQ(); pg8::Gemm g{WSP(bf16, WS_CAT), WSP(bf16, WS_WOUT) + (size_t)l * 1024 * 1024, 1024, 1024}; pg8::StaticOrder S; S.init(M, D, F.G, bx);
            pg8::EpiResid E{l == 0 ? args.in[0] : nullptr, WSP(bf16, WS_XB), l == 0 ? WSP(float, WS_SSF) : nullptr};
            pg8::gemm_phase<pg8::EpiResid, pg8::StaticOrder, true, true>(F.lds + RING_OFF, g, S, E, F.wave);
            if (DUP(8)) { pg8::EpiResid E2{nullptr, WSP(bf16, WS_PROJ), nullptr};
                pg8::gemm_phase<pg8::EpiResid, pg8::StaticOrder, true, true>(F.lds + RING_OFF, g, S, E2, F.wave); }
        }
        SEAM(pb + 3);
        if (l == 0) {
            if (IN(5) && DUP(16)) { WS_OPQ(); pg8::Gemm g{WSP(bf16, WS_XB), WSP(bf16, WS_WGUD), 1024, 1024}; pg8::StaticOrder S; S.init(M, NGU, F.G, bx);
                pg8::EpiNull E; pg8::gemm_phase<pg8::EpiNull, pg8::StaticOrder, true, true>(F.lds + RING_OFF, g, S, E, F.wave); }
            if (IN(5) && DUP(20)) { WS_OPQ(); pg8::Gemm g{WSP(bf16, WS_XB), WSP(bf16, WS_WGUD), 1024, 1024}; pg8::FixedOrder S; S.init(M, NGU, F.G, bx);
                pg8::EpiNull E; pg8::gemm_phase<pg8::EpiNull, pg8::FixedOrder, true, true>(F.lds + RING_OFF, g, S, E, F.wave); }
            if (IN(5) && DUP(17)) { WS_OPQ(); pg8::Gemm g{WSP(bf16, WS_XB), WSP(bf16, WS_WGUD), 1024, 1024}; pg8::StaticOrder S; S.init(M, NGU, F.G, bx);
                pg8::EpiSwiGLU_<1> E{WSP(bf16, WS_ACT), WSP(float, WS_SSF), 16, 22}; pg8::gemm_phase<pg8::EpiSwiGLU_<1>, pg8::StaticOrder, true, true>(F.lds + RING_OFF, g, S, E, F.wave); }
            if (IN(5) && DUP(18)) { WS_OPQ(); pg8::Gemm g{WSP(bf16, WS_XB), WSP(bf16, WS_WGUD), 1024, 1024}; pg8::StaticOrder S; S.init(M, NGU, F.G, bx);
                pg8::EpiSwiGLU_<2> E{WSP(bf16, WS_ACT), WSP(float, WS_SSF), 16, 22}; pg8::gemm_phase<pg8::EpiSwiGLU_<2>, pg8::StaticOrder, true, true>(F.lds + RING_OFF, g, S, E, F.wave); }
            if (IN(5) && EN(9) && !DUP(19)) {
                WS_OPQ(); pg8::Gemm g{WSP(bf16, WS_XB), WSP(bf16, WS_WGUD), 1024, 1024}; pg8::StaticOrder S; S.init(M, NGU, F.G, bx);
                pg8::EpiSwiGLUd8 E{WSP(bf16, WS_ACT), WSP(float, WS_SSF), 16, 22, (const LAS float*)(F.lds + RING_OFF + RSBUF_OFF)};
                pg8::gemm_phase<pg8::EpiSwiGLUd8, pg8::StaticOrder, true, true>(F.lds + RING_OFF, g, S, E, F.wave);
            }
            if (IN(5) && EN(9) && DUP(19)) {
                WS_OPQ(); pg8::Gemm g{WSP(bf16, WS_XB), WSP(bf16, WS_WGUD), 1024, 1024}; pg8::RangeOrder S; S.init(M, NGU, F.G, bx); S.i0 = 0; S.i1 = 11;
                pg8::EpiSwiGLU E{WSP(bf16, WS_ACT), WSP(float, WS_SSF), 16, 22};
                pg8::gemm_phase<pg8::EpiSwiGLU, pg8::RangeOrder, true, true>(F.lds + RING_OFF, g, S, E, F.wave);
                xcd_barrier(bar);
                S.i0 = 11; S.i1 = 22;
                pg8::gemm_phase<pg8::EpiSwiGLU, pg8::RangeOrder, true, true>(F.lds + RING_OFF, g, S, E, F.wave);
            }
            SEAM(5);
            if (IN(6) && EN(10)) {
                WS_OPQ(); pg8::Gemm g{WSP(bf16, WS_ACT), WSP(bf16, WS_WDD), FF / 2, FF / 2}; pg8::StaticOrder S; S.init(M, D, F.G, bx);
                pg8::EpiResid E{nullptr, WSP(bf16, WS_XB), WSP(float, WS_SSX) + (size_t)M * 16, 1.0f / (QS_ACT * QS_D)};
                pg8::gemm_phase<pg8::EpiResid, pg8::StaticOrder, true, true, false, true>(F.lds + RING_OFF, g, S, E, F.wave);
                if (DUP(10)) { pg8::EpiResid E2{nullptr, WSP(bf16, WS_KV), nullptr};
                    pg8::gemm_phase<pg8::EpiResid, pg8::StaticOrder, true, true>(F.lds + RING_OFF, g, S, E2, F.wave); }
            }
            SEAM(6);
        }
    }
    { constexpr int l = 1;
        const int pb = l == 0 ? 1 : 7;
        for (int rep_ = 0; rep_ < 1 + (int)DUP(1); ++rep_) if (IN(pb) && EN(1)) {
            WS_OPQ(); pg8::Gemm g{WSP(bf16, WS_XB), WSP(bf16, WS_WIN) + (size_t)l * NPROJ * 1024, 1024, 1024}; pg8::StaticOrder S; S.init(M, NPROJ, F.G, bx);
            pg8::EpiProj E{WSP(bf16, WS_PROJ), l == 0 ? nullptr : ss_x, ss_cq, ss_ckv, WSP(bf16, WS_KR), rope, (const LAS float*)(F.lds + RING_OFF + RSBUF_OFF)};
            pg8::gemm_phase<pg8::EpiProj, pg8::StaticOrder, true, true>(F.lds + RING_OFF, g, S, E, F.wave);
        }
        SEAM(pb);
        if (IN(pb + 1)) {
            if (EN(2)) conv_phase(F, args, l);
            if (DUP(2)) conv_phase(F, args, l);
            for (int rep_ = 0; rep_ < 1 + (int)DUP(3); ++rep_) if (EN(3)) { WS_OPQ(); pg8::Gemm g{WSP(bf16, WS_PROJ) + C_CQ, WSP(bf16, WS_WUQ) + (size_t)l * 768 * 256, NPROJ, 256}; pg8::StaticOrder S; S.init(M, 768, F.G, bx);
              pg8::EpiQ E{WSP(bf16, WS_Q), ss_cq, rope, (const LAS float*)(F.lds + RING_OFF + RSBUF_OFF)};
              pg8::gemm_phase<pg8::EpiQ, pg8::StaticOrder, true, true>(F.lds + RING_OFF, g, S, E, F.wave); }
            for (int rep_ = 0; rep_ < 1 + (int)DUP(4); ++rep_) if (EN(4)) { WS_OPQ(); pg8::Gemm g{WSP(bf16, WS_PROJ) + C_CKV, WSP(bf16, WS_WUKV) + (size_t)l * 768 * 128, NPROJ, 128}; pg8::StaticOrder S; S.init(M, 768, F.G, bx);
              pg8::EpiStore E{WSP(bf16, WS_KV), KVW, nullptr, ss_ckv, 4, 1.0f / 128.0f, RMS_EPS, (const LAS float*)(F.lds + RING_OFF + RSBUF_OFF)};
              pg8::gemm_phase<pg8::EpiStore, pg8::StaticOrder, true, true>(F.lds + RING_OFF, g, S, E, F.wave); }
        }
        SEAM(pb + 1);
        if (IN(pb + 2)) {
            if (DUP(21)) attn_phase<0, 1>(F, l);
            if (DUP(22)) attn_phase<0, 4>(F, l);
            if (DUP(23)) attn_phase<0, 5>(F, l);
            if (DUP(24)) attn_phase<0, 6>(F, l);
            if (DUP(25)) attn_phase<0, 7>(F, l);
            if (DUP(5)) attn_phase<0>(F, l);
            if (EN(5)) attn_phase<0>(F, l);
            if (EN(6)) attn_phase<1>(F, l);
            if (DUP(6)) attn_phase<1>(F, l);
            for (int rep_ = 0; rep_ < 1 + (int)DUP(7); ++rep_) if (EN(7)) { WS_OPQ(); pg8::Gemm g{WSP(bf16, WS_CB), WSP(bf16, WS_WPW) + (size_t)l * 256 * 256, 256, 256}; pg8::StaticOrder S; S.init(M, 256, F.G, bx);
              pg8::EpiStore E{WSP(bf16, WS_CAT), D, args.in[9] + l * 256, nullptr, 1, 0.f, 0.f};
              pg8::gemm_phase<pg8::EpiStore, pg8::StaticOrder, true, true>(F.lds + RING_OFF, g, S, E, F.wave); }
        }
        SEAM(pb + 2);
        if (IN(pb + 3) && EN(8)) {
            WS_OPQ(); pg8::Gemm g{WSP(bf16, WS_CAT), WSP(bf16, WS_WOUT) + (size_t)l * 1024 * 1024, 1024, 1024}; pg8::StaticOrder S; S.init(M, D, F.G, bx);
            pg8::EpiResid E{l == 0 ? args.in[0] : nullptr, WSP(bf16, WS_XB), l == 0 ? WSP(float, WS_SSF) : nullptr};
            pg8::gemm_phase<pg8::EpiResid, pg8::StaticOrder, true, true>(F.lds + RING_OFF, g, S, E, F.wave);
            if (DUP(8)) { pg8::EpiResid E2{nullptr, WSP(bf16, WS_PROJ), nullptr};
                pg8::gemm_phase<pg8::EpiResid, pg8::StaticOrder, true, true>(F.lds + RING_OFF, g, S, E2, F.wave); }
        }
        SEAM(pb + 3);
        if (l == 0) {
            if (IN(5) && DUP(16)) { WS_OPQ(); pg8::Gemm g{WSP(bf16, WS_XB), WSP(bf16, WS_WGUD), 1024, 1024}; pg8::StaticOrder S; S.init(M, NGU, F.G, bx);
                pg8::EpiNull E; pg8::gemm_phase<pg8::EpiNull, pg8::StaticOrder, true, true>(F.lds + RING_OFF, g, S, E, F.wave); }
            if (IN(5) && DUP(20)) { WS_OPQ(); pg8::Gemm g{WSP(bf16, WS_XB), WSP(bf16, WS_WGUD), 1024, 1024}; pg8::FixedOrder S; S.init(M, NGU, F.G, bx);
                pg8::EpiNull E; pg8::gemm_phase<pg8::EpiNull, pg8::FixedOrder, true, true>(F.lds + RING_OFF, g, S, E, F.wave); }
            if (IN(5) && DUP(17)) { WS_OPQ(); pg8::Gemm g{WSP(bf16, WS_XB), WSP(bf16, WS_WGUD), 1024, 1024}; pg8::StaticOrder S; S.init(M, NGU, F.G, bx);
                pg8::EpiSwiGLU_<1> E{WSP(bf16, WS_ACT), WSP(float, WS_SSF), 16, 22}; pg8::gemm_phase<pg8::EpiSwiGLU_<1>, pg8::StaticOrder, true, true>(F.lds + RING_OFF, g, S, E, F.wave); }
            if (IN(5) && DUP(18)) { WS_OPQ(); pg8::Gemm g{WSP(bf16, WS_XB), WSP(bf16, WS_WGUD), 1024, 1024}; pg8::StaticOrder S; S.init(M, NGU, F.G, bx);
                pg8::EpiSwiGLU_<2> E{WSP(bf16, WS_ACT), WSP(float, WS_SSF), 16, 22}; pg8::gemm_phase<pg8::EpiSwiGLU_<2>, pg8::StaticOrder, true, true>(F.lds + RING_OFF, g, S, E, F.wave); }
            if (IN(5) && EN(9) && !DUP(19)) {
                WS_OPQ(); pg8::Gemm g{WSP(bf16, WS_XB), WSP(bf16, WS_WGUD), 1024, 1024}; pg8::StaticOrder S; S.init(M, NGU, F.G, bx);
                pg8::EpiSwiGLUd8 E{WSP(bf16, WS_ACT), WSP(float, WS_SSF), 16, 22, (const LAS float*)(F.lds + RING_OFF + RSBUF_OFF)};
                pg8::gemm_phase<pg8::EpiSwiGLUd8, pg8::StaticOrder, true, true>(F.lds + RING_OFF, g, S, E, F.wave);
            }
            if (IN(5) && EN(9) && DUP(19)) {
                WS_OPQ(); pg8::Gemm g{WSP(bf16, WS_XB), WSP(bf16, WS_WGUD), 1024, 1024}; pg8::RangeOrder S; S.init(M, NGU, F.G, bx); S.i0 = 0; S.i1 = 11;
                pg8::EpiSwiGLU E{WSP(bf16, WS_ACT), WSP(float, WS_SSF), 16, 22};
                pg8::gemm_phase<pg8::EpiSwiGLU, pg8::RangeOrder, true, true>(F.lds + RING_OFF, g, S, E, F.wave);
                xcd_barrier(bar);
                S.i0 = 11; S.i1 = 22;
                pg8::gemm_phase<pg8::EpiSwiGLU, pg8::RangeOrder, true, true>(F.lds + RING_OFF, g, S, E, F.wave);
            }
            SEAM(5);
            if (IN(6) && EN(10)) {
                WS_OPQ(); pg8::Gemm g{WSP(bf16, WS_ACT), WSP(bf16, WS_WDD), FF / 2, FF / 2}; pg8::StaticOrder S; S.init(M, D, F.G, bx);
                pg8::EpiResid E{nullptr, WSP(bf16, WS_XB), WSP(float, WS_SSX) + (size_t)M * 16, 1.0f / (QS_ACT * QS_D)};
                pg8::gemm_phase<pg8::EpiResid, pg8::StaticOrder, true, true, false, true>(F.lds + RING_OFF, g, S, E, F.wave);
                if (DUP(10)) { pg8::EpiResid E2{nullptr, WSP(bf16, WS_KV), nullptr};
                    pg8::gemm_phase<pg8::EpiResid, pg8::StaticOrder, true, true>(F.lds + RING_OFF, g, S, E2, F.wave); }
            }
            SEAM(6);
        }
    }
    if (IN(11) && EN(11)) router_phase(F, args);
    SEAM(11);
    for (int k = 0; k < 6; ++k) {
        const int ph = 12 + k;
        if (IN(ph)) {
            moe_prefix(F);
            const int TT = (int)F.MISC[32];
            if (k >= 1 && EN(14)) { const int c = k - 1, ta = c * 128 < TT ? c * 128 : TT, tb = (c + 1) * 128 < TT ? (c + 1) * 128 : TT;
                WS_OPQ(); pg8::Gemm g{WSP(bf16, (c & 1) ? WS_ACT1 : WS_ACT0), WSP(bf16, WS_WDE), FF / 2, FF / 2};
                pg8::MoeOrder S{tb - ta, 4, ta, F.G, bx, (const PG8_LAS int*)(F.lds + MISC_OFF + 64), WSP(int, WS_LIST)};
                pg8::EpiScatter E{WSP(bf16, WS_XB), WSP(bf16, WS_Y1), WSP(int, WS_LIST), WSP(float, WS_WGT), 1.0f / (QS_ACT * QS_D)};
                pg8::gemm_phase<pg8::EpiScatter, pg8::MoeOrder, true, true, false, true>(F.lds + RING_OFF, g, S, E, F.wave); }
            if (k <= 4 && EN(13)) { const int c = k, ta = c * 128 < TT ? c * 128 : TT, tb = (c + 1) * 128 < TT ? (c + 1) * 128 : TT;
                WS_OPQ(); pg8::Gemm g{WSP(bf16, WS_HB3), WSP(bf16, WS_WGUE), 512, 512};
                pg8::MoeOrder S{tb - ta, 22, ta, F.G, bx, (const PG8_LAS int*)(F.lds + MISC_OFF + 64), WSP(int, WS_LIST)};
                pg8::EpiSwiGLU8 E{WSP(bf16, (c & 1) ? WS_ACT1 : WS_ACT0), nullptr, 1, 22};
                pg8::gemm_phase<pg8::EpiSwiGLU8, pg8::MoeOrder, true, true, true, true>(F.lds + RING_OFF, g, S, E, F.wave);
                if (DUP(13)) pg8::gemm_phase<pg8::EpiSwiGLU8, pg8::MoeOrder, true, true, true, true>(F.lds + RING_OFF, g, S, E, F.wave);
                if (DUP(19)) { pg8::EpiNull E0; pg8::gemm_phase<pg8::EpiNull, pg8::MoeOrder, true, true, true, true>(F.lds + RING_OFF, g, S, E0, F.wave); } }
        }
        SEAM(ph);
    }
    if (IN(18) && EN(15)) final_phase(F, args);
#undef rope
#undef ss_x
#undef ss_cq
#undef ss_ckv
#undef IN
#undef SEAM
}

#ifndef MK_N_LAUNCHES
#define MK_N_LAUNCHES 1
#endif
extern "C" void kernel_launch(void* const* d_in, const int* in_sizes, int n_in, void* d_out, int out_size, void* d_ws, size_t ws_size, hipStream_t stream) {
    static int grid = 0;
    if (grid == 0) {
        if (n_in != 29 || in_sizes[0] != M * D || out_size != M * D || ws_size < WS_END) { fprintf(stderr, "kernel_launch: unexpected sizes: n_in %d in0 %d out %d ws %zu (need %zu)\n", n_in, n_in > 0 ? in_sizes[0] : -1, out_size, ws_size, (size_t)WS_END); grid = -1; return; }
        int dev = 0, cus = 0, per_cu = 0;
        if (hipGetDevice(&dev) != hipSuccess || hipDeviceGetAttribute(&cus, hipDeviceAttributeMultiprocessorCount, dev) != hipSuccess) { grid = -1; return; }
        if (hipFuncSetAttribute((const void*)fwd_kernel, hipFuncAttributeMaxDynamicSharedMemorySize, LDS_BYTES) != hipSuccess) { fprintf(stderr, "kernel_launch: hipFuncSetAttribute failed\n"); grid = -1; return; }
        if (hipOccupancyMaxActiveBlocksPerMultiprocessor(&per_cu, (const void*)fwd_kernel, NWAVES * 64, LDS_BYTES) != hipSuccess || per_cu < 1)
            fprintf(stderr, "kernel_launch: note: occupancy query reports %d workgroups per CU\n", per_cu);
        (void)hipGetLastError();
        grid = cus;
    }
    if (grid < 0) return;
    if (hipMemsetAsync((char*)d_ws + WS_CTL, 0, CTL_ZERO_BYTES, stream) != hipSuccess) return;
    Args a{};
    for (int i = 0; i < 29; ++i) a.in[i] = (const float*)d_in[i];
    a.out = (float*)d_out; a.ws = (unsigned char*)d_ws;
#if MK_N_LAUNCHES == 1
    a.ph_lo = 0; a.ph_hi = NPHASE;
    hipLaunchKernelGGL(fwd_kernel, dim3(grid), dim3(NWAVES * 64), LDS_BYTES, stream, a);
#else
    for (int p = 0; p < NPHASE; ++p) { a.ph_lo = p; a.ph_hi = p + 1; hipLaunchKernelGGL(fwd_kernel, dim3(grid), dim3(NWAVES * 64), LDS_BYTES, stream, a); }
#endif
}
```
